# Optimizing an MI355X kernel written in HIP

```python
import jax, jax.numpy as jnp
from jax import lax
import numpy as np

D_MODEL = 1024
BATCH = 4
SEQ = 8192
DEPTH = 2

N_MIXERS = 2
GRID_W = 64
N_FOURIER_GROUPS = 4
FOURIER_GROUP_DIM = D_MODEL // N_FOURIER_GROUPS
N_HEADS = 16
HEAD_DIM = D_MODEL // N_HEADS
WIN_ROWS = 8
WIN_COLS = 16
N_EXPERTS = 32
N_GROUPS = 4
EXPERTS_PER_GROUP = N_EXPERTS // N_GROUPS
TOP_K = 2
D_EXPERT = D_MODEL // 2
ROUTE_BLOCK = 256
DEEPNORM_ALPHA = (2 * DEPTH) ** 0.25
DEEPNORM_BETA = (8 * DEPTH) ** -0.25
LN_EPS = 1e-5
N_FOURIER_LAYERS = (DEPTH + N_MIXERS - 1) // N_MIXERS
N_NA_LAYERS = DEPTH // N_MIXERS

kernel_name = 'hybrid_fnet_natten_grouped_moe_deepnorm'


def layer_norm(x, g, b):
    xf = x.astype(jnp.float32)
    mu = xf.mean(-1, keepdims=True)
    var = jnp.square(xf - mu).mean(-1, keepdims=True)
    y = (xf - mu) * lax.rsqrt(var + LN_EPS) * g.astype(jnp.float32) + b.astype(jnp.float32)
    return y.astype(x.dtype)


def fourier_mixer(x, w_in, w_out):
    B, S, _ = x.shape
    u = (x @ w_in).reshape(B, S, N_FOURIER_GROUPS, FOURIER_GROUP_DIM)
    f = jnp.fft.fft2(u.astype(jnp.float32), axes=(1, 3), norm='ortho').real
    return f.reshape(B, S, D_MODEL).astype(x.dtype) @ w_out


def neighbourhood_attention_mixer(x, w_qkv, rpb, w_out):
    B, S, _ = x.shape
    rows = S // GRID_W
    kr = min(WIN_ROWS, rows)
    kc = min(WIN_COLS, GRID_W)
    qkv = (x @ w_qkv).reshape(B, S, 3, N_HEADS, HEAD_DIM)
    q = qkv[:, :, 0] * (HEAD_DIM ** -0.5)
    k = qkv[:, :, 1]
    v = qkv[:, :, 2]
    row_start = jnp.clip(jnp.arange(rows) - kr // 2, 0, rows - kr)
    cols = jnp.arange(GRID_W)
    col_start = jnp.clip(cols - kc // 2, 0, GRID_W - kc)
    col_mask = (cols[None, :] >= col_start[:, None]) & (cols[None, :] < col_start[:, None] + kc)
    mask = jnp.broadcast_to(col_mask[:, None, :], (GRID_W, kr, GRID_W)).reshape(GRID_W, kr * GRID_W)
    col_idx = jnp.clip(cols[None, :] - cols[:, None] + WIN_COLS - 1, 0, 2 * WIN_COLS - 2)

    def one_row(r):
        rs = row_start[r]
        q_r = lax.dynamic_slice_in_dim(q, r * GRID_W, GRID_W, axis=1)
        k_r = lax.dynamic_slice_in_dim(k, rs * GRID_W, kr * GRID_W, axis=1)
        v_r = lax.dynamic_slice_in_dim(v, rs * GRID_W, kr * GRID_W, axis=1)
        s = jnp.einsum('bqhd,bkhd->bhqk', q_r, k_r).astype(jnp.float32)
        row_idx = rs + jnp.arange(kr) - r + WIN_ROWS - 1
        bias = rpb[:, row_idx][:, :, col_idx]
        bias = bias.transpose(0, 2, 1, 3).reshape(N_HEADS, GRID_W, kr * GRID_W)
        s = jnp.where(mask, s + bias.astype(jnp.float32), -jnp.inf)
        p = jax.nn.softmax(s, axis=-1).astype(v.dtype)
        return jnp.einsum('bhqk,bkhd->bqhd', p, v_r)

    o = lax.map(one_row, jnp.arange(rows))
    o = o.transpose(1, 0, 2, 3, 4).reshape(B, S, D_MODEL)
    return o @ w_out


def grouped_moe(h, w_router, b_router, w_gate, w_up, w_down):
    B, S, D = h.shape
    T = B * S
    xt = h.reshape(T, D)
    scores = jax.nn.sigmoid((xt @ w_router).astype(jnp.float32))
    sel = (scores + b_router.astype(jnp.float32)).reshape(T, N_GROUPS, EXPERTS_PER_GROUP)
    group_score = lax.top_k(sel, TOP_K)[0].sum(-1)
    group = jnp.argmax(group_score, axis=-1)
    in_group = jnp.take_along_axis(sel, group[:, None, None], axis=1)[:, 0]
    _, local = lax.top_k(in_group, TOP_K)
    expert_idx = group[:, None] * EXPERTS_PER_GROUP + local
    gate = jnp.take_along_axis(scores, expert_idx, axis=1)
    gate = gate / gate.sum(-1, keepdims=True)
    A = T * TOP_K
    flat_e = expert_idx.reshape(A)
    order = jnp.argsort(flat_e, stable=True)
    sorted_e = flat_e[order]
    sorted_tok = order // TOP_K
    sorted_gate = gate.reshape(A)[order]
    counts = jnp.bincount(flat_e, length=N_EXPERTS)
    padded = (counts + ROUTE_BLOCK - 1) // ROUTE_BLOCK * ROUTE_BLOCK
    pad_end = jnp.cumsum(padded)
    pad_start = pad_end - padded
    seg_start = jnp.cumsum(counts) - counts
    dest = pad_start[sorted_e] + jnp.arange(A) - seg_start[sorted_e]
    n_blocks = -(-A // ROUTE_BLOCK) + N_EXPERTS
    P = n_blocks * ROUTE_BLOCK
    slot_tok = jnp.full((P,), T, jnp.int32).at[dest].set(sorted_tok.astype(jnp.int32))
    x_pad = jnp.concatenate([xt, jnp.zeros((1, D), xt.dtype)], axis=0)
    xs = x_pad[slot_tok].reshape(n_blocks, ROUTE_BLOCK, D)
    block_expert = jnp.minimum(
        jnp.searchsorted(pad_end, jnp.arange(n_blocks) * ROUTE_BLOCK, side='right'), N_EXPERTS - 1)

    def expert_block(args):
        xb, e = args
        hb = jax.nn.silu(xb @ w_gate[e]) * (xb @ w_up[e])
        return hb @ w_down[e]

    ys = lax.map(expert_block, (xs, block_expert)).reshape(P, D)
    contrib = ys[dest] * sorted_gate[:, None].astype(ys.dtype)
    out = jax.ops.segment_sum(contrib, sorted_tok, num_segments=T)
    return out.reshape(B, S, D)


def setup_inputs(seed: int = 0) -> dict:
    key = jax.random.key(seed)
    ks = jax.random.split(key, 14)
    f32 = jnp.float32

    def nrm(k, shape, scale):
        return jax.random.normal(k, shape, f32) * scale

    d_inv = D_MODEL ** -0.5
    return {
        'x': nrm(ks[0], (BATCH, SEQ, D_MODEL), 1.0),
        'fourier_w_in': nrm(ks[1], (N_FOURIER_LAYERS, D_MODEL, D_MODEL), d_inv),
        'fourier_w_out': nrm(ks[2], (N_FOURIER_LAYERS, D_MODEL, D_MODEL), d_inv * DEEPNORM_BETA),
        'na_w_qkv': nrm(ks[3], (N_NA_LAYERS, D_MODEL, 3 * D_MODEL), d_inv),
        'na_rpb': nrm(ks[4], (N_NA_LAYERS, N_HEADS, 2 * WIN_ROWS - 1, 2 * WIN_COLS - 1), 0.02),
        'na_w_out': nrm(ks[5], (N_NA_LAYERS, D_MODEL, D_MODEL), d_inv * DEEPNORM_BETA),
        'router_w': nrm(ks[6], (D_MODEL, N_EXPERTS), d_inv),
        'router_b': nrm(ks[7], (N_EXPERTS,), 0.01),
        'expert_w_gate': nrm(ks[8], (DEPTH, N_EXPERTS, D_MODEL, D_EXPERT), d_inv),
        'expert_w_up': nrm(ks[9], (DEPTH, N_EXPERTS, D_MODEL, D_EXPERT), d_inv),
        'expert_w_down': nrm(ks[10], (DEPTH, N_EXPERTS, D_EXPERT, D_MODEL), D_EXPERT ** -0.5 * DEEPNORM_BETA),
        'ln_g': 1.0 + nrm(ks[11], (DEPTH, 2, D_MODEL), 0.02),
        'ln_b': nrm(ks[12], (DEPTH, 2, D_MODEL), 0.02),
    }


def reference(x, fourier_w_in, fourier_w_out, na_w_qkv, na_rpb, na_w_out, router_w, router_b,
              expert_w_gate, expert_w_up, expert_w_down, ln_g, ln_b):
    for i in range(DEPTH):
        j = i // N_MIXERS
        if i % N_MIXERS == 0:
            y = fourier_mixer(x, fourier_w_in[j], fourier_w_out[j])
        else:
            y = neighbourhood_attention_mixer(x, na_w_qkv[j], na_rpb[j], na_w_out[j])
        x = layer_norm(DEEPNORM_ALPHA * x + y, ln_g[i, 0], ln_b[i, 0])
        y = grouped_moe(x, router_w, router_b, expert_w_gate[i], expert_w_up[i], expert_w_down[i])
        x = layer_norm(DEEPNORM_ALPHA * x + y, ln_g[i, 1], ln_b[i, 1])
    return x
```

```cpp
#include <hip/hip_runtime.h>
#include <cstdio>
#include <cstdint>

#ifndef MK_N_LAUNCHES
#define MK_N_LAUNCHES 16
#endif

#define LAS __attribute__((address_space(3)))
typedef unsigned short bf16_t;
typedef short bf16x8 __attribute__((ext_vector_type(8)));
typedef short bf16x4 __attribute__((ext_vector_type(4)));
typedef float f32x4 __attribute__((ext_vector_type(4)));
typedef float f32x2 __attribute__((ext_vector_type(2)));
typedef unsigned u32x4 __attribute__((ext_vector_type(4)));
typedef unsigned u32x2 __attribute__((ext_vector_type(2)));

constexpr int T = 32768, DM = 1024, SEQ = 8192, NBATCH = 4, NE = 32, DEX = 512, NASG = 65536, NPH = 16;
constexpr float ALPHA = 1.41421356237309515f;
constexpr float LN_EPS = 1e-5f;
constexpr size_t MiB = (size_t)1 << 20;
constexpr size_t WS_CTL = 0, WS_GATE = 1 * MiB, WS_LIST = 2 * MiB, WS_WIN = 10 * MiB, WS_W2 = 12 * MiB, WS_F1 = 16 * MiB, WS_F2 = 17 * MiB, WS_WQKV = 21 * MiB, WS_WO = 27 * MiB,
                 WS_WGU = 30 * MiB, WS_WD = 158 * MiB, WS_S0 = 222 * MiB, WS_S1 = 286 * MiB, WS_S2 = 350 * MiB, WS_S3 = 414 * MiB, WS_END = 478 * MiB;
constexpr size_t CTL_ZERO_BYTES = 65536;
constexpr int CNT_WORD0 = 4096;
constexpr int LDS_BYTES = 149504;
constexpr int LDS_IDX = 131072, LDS_MISC = 131072 + 16384, LDS_BARW = LDS_BYTES - 16;

#define XB_TMO      128
#define XB_XCNT(j)  (256  + 64 * (j))
#define XB_XSUB(j)  (1280 + 64 * (j))
#define XB_XGEN(j)  (2304 + 64 * (j))
#define XB_TOP      3328
#define XB_TOPGEN   3392
#define XCD_BAR_WORDS 3456
#define XB_SPIN_CAP (1u << 18)

__device__ __forceinline__ unsigned xb_ld(unsigned* p)              { return __hip_atomic_load(p, __ATOMIC_RELAXED, __HIP_MEMORY_SCOPE_AGENT); }
__device__ __forceinline__ unsigned xb_add(unsigned* p, unsigned v) { return __hip_atomic_fetch_add(p, v, __ATOMIC_RELAXED, __HIP_MEMORY_SCOPE_AGENT); }
__device__ __forceinline__ unsigned xb_xcc_id() { return (unsigned)__builtin_amdgcn_s_getreg((3 << 11) | 20) & 0xFu; }
#define XB_SPIN(cond, bar) do { unsigned _sp = 0; while (cond) { __builtin_amdgcn_s_sleep(1); \
    if ((++_sp & 255u) == 0u) { if (xb_ld(&(bar)[XB_TMO])) break; if (_sp > XB_SPIN_CAP) { atomicAdd(&(bar)[XB_TMO], 1u); break; } } } } while (0)

struct XcdBarrier { unsigned* bar; unsigned x; volatile LAS unsigned* st; };

__device__ __forceinline__ XcdBarrier xcd_barrier_post(unsigned* bar, volatile LAS unsigned* st) {
    XcdBarrier b; b.bar = bar; b.x = xb_xcc_id(); b.st = st;
    if (threadIdx.x == 0) (void)xb_add(&bar[XB_XCNT(b.x)], 1u);
    return b;
}
__device__ __forceinline__ void xcd_barrier_complete(unsigned* bar, unsigned x, unsigned& nloc, unsigned& nx) {
    const unsigned G = gridDim.x * gridDim.y * gridDim.z;
    unsigned sum, cnt, mine, sp = 0u;
    for (;;) {
        sum = 0u; cnt = 0u; mine = 0u;
#pragma unroll
        for (unsigned j = 0; j < 16; ++j) { const unsigned c = xb_ld(&bar[XB_XCNT(j)]); sum += c; cnt += (c > 0u) ? 1u : 0u; mine = (j == x) ? c : mine; }
        if (sum == G) break;
        __builtin_amdgcn_s_sleep(1);
        if ((++sp & 255u) == 0u) { if (xb_ld(&bar[XB_TMO])) break; if (sp > XB_SPIN_CAP) { atomicAdd(&bar[XB_TMO], 1u); break; } }
    }
    nloc = mine > 0u ? mine : 1u; nx = cnt > 0u ? cnt : 1u;
}
__device__ __forceinline__ void xcd_barrier(const XcdBarrier& b) {
    asm volatile("s_waitcnt vmcnt(0)" ::: "memory");
    __syncthreads();
    if (threadIdx.x == 0) {
        unsigned* bar = b.bar;
        __builtin_amdgcn_s_waitcnt(0);
        unsigned nloc = b.st[0], nx = b.st[1];
        if (nloc == 0u) { xcd_barrier_complete(bar, b.x, nloc, nx); b.st[0] = nloc; b.st[1] = nx; }
        const unsigned old = xb_add(&bar[XB_XSUB(b.x)], 1u);
        const unsigned gen = old / nloc;
        if (old + 1u == (gen + 1u) * nloc) {
            __builtin_amdgcn_fence(__ATOMIC_RELEASE, "agent");
            asm volatile("s_waitcnt vmcnt(0)" ::: "memory");
            const unsigned og = xb_add(&bar[XB_TOP], 1u);
            const unsigned tg = og / nx;
            if (og + 1u == (tg + 1u) * nx) xb_add(&bar[XB_TOPGEN], 1u);
            else XB_SPIN(xb_ld(&bar[XB_TOPGEN]) == tg, bar);
            __builtin_amdgcn_fence(__ATOMIC_ACQUIRE, "agent");
            xb_add(&bar[XB_XGEN(b.x)], 1u);
            asm volatile("s_waitcnt vmcnt(0)" ::: "memory");
        } else {
            XB_SPIN(xb_ld(&bar[XB_XGEN(b.x)]) == gen, bar);
            __builtin_amdgcn_fence(__ATOMIC_ACQUIRE, "agent");
            asm volatile("s_waitcnt vmcnt(0)" ::: "memory");
        }
    }
    __syncthreads();
}

__device__ __forceinline__ unsigned cvt_pk_bf16(float lo, float hi) { unsigned r; asm volatile("v_cvt_pk_bf16_f32 %0, %1, %2" : "=v"(r) : "v"(lo), "v"(hi)); return r; }
__device__ __forceinline__ float bf_lo(unsigned w) { return __uint_as_float(w << 16); }
__device__ __forceinline__ float bf_hi(unsigned w) { return __uint_as_float(w & 0xffff0000u); }
__device__ __forceinline__ u32x4 pack8(const f32x4 a, const f32x4 b) { u32x4 w; w.x = cvt_pk_bf16(a[0], a[1]); w.y = cvt_pk_bf16(a[2], a[3]); w.z = cvt_pk_bf16(b[0], b[1]); w.w = cvt_pk_bf16(b[2], b[3]); return w; }
__device__ __forceinline__ int tid_fresh() { int t = threadIdx.x; asm volatile("" : "+v"(t)); return t; }
__device__ __forceinline__ float wave_sum(float v) {
#pragma unroll
    for (int o = 32; o >= 1; o >>= 1) v += __shfl_xor(v, o);
    return v;
}

namespace gm {
constexpr int BM = 256, BK = 64, HALF = 128, HTB = HALF * BK * 2, STAGE_BYTES = 8 * HTB, NXCD = 8, WGM = 8;
__device__ __forceinline__ int lds_byte(int r, int c) { const int st = (r >> 4) * 2 + (c >> 5), rr = r & 15, cc = c & 31, ob = rr * 64 + cc * 2; return st * 1024 + (ob ^ (((ob >> 9) & 1) << 5)); }
__device__ __forceinline__ void stage_rc(int b, int& R, int& C) { const int st = b / 1024, sb = b % 1024, swz = sb ^ (((sb >> 9) & 1) << 5); R = (st >> 1) * 16 + swz / 64; C = (st & 1) * 32 + (swz % 64) / 2; }
__device__ __forceinline__ int perm32(int rho) { const int n = rho >> 4, i = rho & 15; return 8 * (i >> 2) + 4 * n + (i & 3); }

__device__ __forceinline__ void glds16(const char* sbase, unsigned voff, unsigned lds_dst) {
    unsigned keep;
    asm volatile("s_mov_b32 %0, m0\n\ts_mov_b32 m0, %3\n\ts_nop 0\n\tglobal_load_lds_dwordx4 %1, %2\n\ts_mov_b32 m0, %0" : "=&s"(keep) : "v"(voff), "s"(sbase), "s"(lds_dst) : "memory");
}
struct Unit { const char* A; const char* B; unsigned hsA, hsB; int pm, pn, x0, x1; };

struct GridOrder {
    int nM, nN, nwg, G, c;
    __device__ __forceinline__ void init(int nM_, int nN_, int G_, int c_) { nM = nM_; nN = nN_; nwg = nM * nN; G = G_; c = c_; }
    __device__ __forceinline__ bool mn(int i, int& pm, int& pn) const {
        const long L = (long)i * G + c; if (L >= nwg) return false;
        int wgid = (int)L; { const int q = nwg / NXCD, r = nwg % NXCD, xcd = wgid % NXCD, off = wgid / NXCD; wgid = (xcd < r ? xcd * (q + 1) : r * (q + 1) + (xcd - r) * q) + off; }
        const int nig = WGM * nN, gid = wgid / nig, fm = gid * WGM, gsz = (nM - fm) < WGM ? (nM - fm) : WGM;
        pm = fm + ((wgid % nig) % gsz); pn = (wgid % nig) / gsz; return true;
    }
};

template <class Epi, class Sched, bool GATHER>
__device__ __forceinline__ void gemm_phase(LAS unsigned char* lds, const int K, const unsigned ldA, const unsigned ldB, const Sched& S, const Epi& E, const LAS int* idxsrc) {
    const int tid = tid_fresh(), wid = __builtin_amdgcn_readfirstlane(tid >> 6), lane = tid & 63, wr = wid >> 2, wc = wid & 3, fr = lane & 15, fq = lane >> 4;
    const int nt = K / BK;
    unsigned voffA[2][2], voffB[2]; int RA[2]; unsigned CA2[2];
#pragma unroll
    for (int i = 0; i < 2; ++i) { int R, C; stage_rc(tid * 16 + i * 8192, R, C); const int Rb = Epi::PERM ? ((R & ~31) + perm32(R & 31)) : R;
        RA[i] = R; CA2[i] = (unsigned)C * 2u; voffA[0][i] = (unsigned)R * ldA + (unsigned)C * 2u; voffA[1][i] = voffA[0][i]; voffB[i] = (unsigned)Rb * ldB + (unsigned)C * 2u; }
    const size_t kstep = (size_t)(BK * 2);
    const unsigned ldsw = (unsigned)wid * 1024u;
    const unsigned lds0 = (unsigned)(__UINTPTR_TYPE__)lds;
    const int aoff = lds_byte(wr * 64 + fr, fq * 8), boff = lds_byte(wc * 32 + fr, fq * 8);
#define PG8_SA(b, h) (((b) * 2 + (h)) * HTB)
#define PG8_SB(b, h) ((4 + (b) * 2 + (h)) * HTB)
#define PG8_STAGE(bufoff, gbase, voff) do { _Pragma("unroll") for (int _i = 0; _i < 2; ++_i) glds16((const char*)(gbase), (voff)[_i], lds0 + (unsigned)(bufoff) + ldsw + _i * 8192u); } while (0)
#define PG8_LDA(dst, b, h) do { _Pragma("unroll") for (int m = 0; m < 4; ++m) _Pragma("unroll") for (int k = 0; k < 2; ++k) dst[m][k] = *(const LAS bf16x8*)(lds + PG8_SA(b, h) + aoff + m * 2048 + k * 1024); } while (0)
#define PG8_LDB(dst, b, h) do { _Pragma("unroll") for (int n = 0; n < 2; ++n) _Pragma("unroll") for (int k = 0; k < 2; ++k) dst[n][k] = *(const LAS bf16x8*)(lds + PG8_SB(b, h) + boff + n * 2048 + k * 1024); } while (0)
#define PG8_MMA(ai, bj, At, Bt) do { __builtin_amdgcn_s_setprio(1); _Pragma("unroll") for (int m = 0; m < 4; ++m) _Pragma("unroll") for (int n = 0; n < 2; ++n) _Pragma("unroll") for (int k = 0; k < 2; ++k) \
        acc[ai][bj][m][n] = __builtin_amdgcn_mfma_f32_16x16x32_bf16(Bt[n][k], At[m][k], acc[ai][bj][m][n], 0, 0, 0); __builtin_amdgcn_s_setprio(0); } while (0)
#define PG8_WAIT_V(n) asm volatile("s_waitcnt vmcnt(" #n ")" ::: "memory")
#define PG8_WAIT_L(n) asm volatile("s_waitcnt lgkmcnt(" #n ")" ::: "memory")
#define PG8_BAR __builtin_amdgcn_s_barrier()
#define PG8_SCHED __builtin_amdgcn_sched_barrier(0)
#define PG8_VA(h) voffA[GATHER ? (h) : 0]
    Unit cur, nxt; int ui = 0;
    if (!S.next(0, cur)) return;
    if constexpr (GATHER) {
#pragma unroll
        for (int h = 0; h < 2; ++h)
#pragma unroll
            for (int i = 0; i < 2; ++i) voffA[h][i] = (unsigned)idxsrc[h * 128 + RA[i]] * ldA + CA2[i];
    }
    f32x4 acc[2][2][4][2];
#pragma unroll
    for (int a = 0; a < 2; ++a)
#pragma unroll
        for (int b = 0; b < 2; ++b)
#pragma unroll
            for (int m = 0; m < 4; ++m)
#pragma unroll
                for (int n = 0; n < 2; ++n) acc[a][b][m][n] = (f32x4){0.f, 0.f, 0.f, 0.f};
    bf16x8 At[4][2], B0[2][2], B1[2][2];
    const char* cA = cur.A; const char* cB = cur.B; unsigned chA = cur.hsA, chB = cur.hsB;
    PG8_STAGE(PG8_SB(0, 0), cB, voffB); PG8_STAGE(PG8_SA(0, 0), cA, PG8_VA(0)); PG8_STAGE(PG8_SB(0, 1), cB + chB, voffB); PG8_STAGE(PG8_SA(0, 1), cA + chA, PG8_VA(1));
    if (wr == 1) PG8_BAR;
    PG8_WAIT_V(4); PG8_BAR;
    PG8_STAGE(PG8_SB(1, 0), cB + kstep, voffB); PG8_STAGE(PG8_SA(1, 0), cA + kstep, PG8_VA(0)); PG8_STAGE(PG8_SB(1, 1), cB + chB + kstep, voffB);
    PG8_WAIT_V(6); PG8_BAR;
    for (;;) {
        const bool has_next = S.next(ui + 1, nxt);
        const char* nA = has_next ? nxt.A : cA; const char* nB = has_next ? nxt.B : cB; const unsigned nhA = has_next ? nxt.hsA : chA, nhB = has_next ? nxt.hsB : chB;
        for (int t = 0; t < nt; t += 2) {
            const bool last = (t == nt - 2);
            const char* a1 = cA + (size_t)(t + 1) * kstep;
            const char* a2 = last ? nA : cA + (size_t)(t + 2) * kstep; const char* b2 = last ? nB : cB + (size_t)(t + 2) * kstep;
            const unsigned hA2 = last ? nhA : chA, hB2 = last ? nhB : chB;
            const char* a3 = a2 + kstep; const char* b3 = b2 + kstep;
            const bool sw = GATHER && last && has_next;
            int gi[2][2];
            PG8_LDB(B0, 0, 0); PG8_SCHED; PG8_LDA(At, 0, 0); PG8_STAGE(PG8_SA(1, 1), a1 + chA, PG8_VA(1));
            PG8_WAIT_L(8); PG8_BAR; PG8_WAIT_L(0); PG8_MMA(0, 0, At, B0); PG8_BAR; PG8_SCHED;
            if constexpr (GATHER) { if (sw) {
#pragma unroll
                for (int h = 0; h < 2; ++h)
#pragma unroll
                    for (int i = 0; i < 2; ++i) gi[h][i] = idxsrc[(ui + 1) * 256 + h * 128 + RA[i]]; } }
            PG8_LDB(B1, 0, 1); PG8_STAGE(PG8_SB(0, 0), b2, voffB);
            PG8_BAR; PG8_WAIT_L(0); PG8_MMA(0, 1, At, B1); PG8_BAR;
            if constexpr (GATHER) { if (sw) {
#pragma unroll
                for (int h = 0; h < 2; ++h)
#pragma unroll
                    for (int i = 0; i < 2; ++i) voffA[h][i] = (unsigned)gi[h][i] * ldA + CA2[i]; } }
            PG8_LDA(At, 0, 1); PG8_STAGE(PG8_SA(0, 0), a2, PG8_VA(0));
            PG8_BAR; PG8_WAIT_L(0); PG8_MMA(1, 0, At, B0); PG8_BAR; PG8_SCHED;
            PG8_STAGE(PG8_SB(0, 1), b2 + hB2, voffB);
            PG8_WAIT_V(6); PG8_BAR; PG8_MMA(1, 1, At, B1); PG8_BAR;
            PG8_LDB(B0, 1, 0); PG8_SCHED; PG8_LDA(At, 1, 0); PG8_STAGE(PG8_SA(0, 1), a2 + hA2, PG8_VA(1));
            PG8_WAIT_L(8); PG8_BAR; PG8_WAIT_L(0); PG8_MMA(0, 0, At, B0); PG8_BAR; PG8_SCHED;
            PG8_LDB(B1, 1, 1); PG8_STAGE(PG8_SB(1, 0), b3, voffB);
            PG8_BAR; PG8_WAIT_L(0); PG8_MMA(0, 1, At, B1); PG8_BAR;
            PG8_LDA(At, 1, 1); PG8_STAGE(PG8_SA(1, 0), a3, PG8_VA(0));
            PG8_BAR; PG8_WAIT_L(0); PG8_MMA(1, 0, At, B0); PG8_BAR; PG8_SCHED;
            PG8_STAGE(PG8_SB(1, 1), b3 + hB2, voffB);
            PG8_WAIT_V(6); PG8_BAR; PG8_MMA(1, 1, At, B1); PG8_BAR;
        }
        E(acc, cur, ui, wr, wc, fr, fq);
        if (!has_next) break;
#pragma unroll
        for (int a = 0; a < 2; ++a)
#pragma unroll
            for (int b = 0; b < 2; ++b)
#pragma unroll
                for (int m = 0; m < 4; ++m)
#pragma unroll
                    for (int n = 0; n < 2; ++n) acc[a][b][m][n] = (f32x4){0.f, 0.f, 0.f, 0.f};
        cur = nxt; cA = nA; cB = nB; chA = nhA; chB = nhB; ++ui;
    }
    PG8_WAIT_V(0);
    if (wr == 0) PG8_BAR;
    PG8_BAR;
#undef PG8_SA
#undef PG8_SB
#undef PG8_STAGE
#undef PG8_LDA
#undef PG8_LDB
#undef PG8_MMA
#undef PG8_WAIT_V
#undef PG8_WAIT_L
#undef PG8_BAR
#undef PG8_SCHED
#undef PG8_VA
}
}
using gm::Unit;

struct Params { const float* in[13]; float* out; unsigned char* ws; int ph_lo, ph_hi; };

struct SchedPlain {
    gm::GridOrder o; const char* A; const char* B; unsigned ldA, ldB;
    __device__ __forceinline__ bool next(int i, Unit& u) const { int pm, pn; if (!o.mn(i, pm, pn)) return false;
        u.pm = pm; u.pn = pn; u.x0 = 0; u.x1 = 0; u.A = A + (size_t)pm * 256 * ldA; u.hsA = 128u * ldA; u.B = B + (size_t)pn * 256 * ldB; u.hsB = 128u * ldB; return true; }
};
struct SchedG1 {
    gm::GridOrder o; const char* WinT; const char* xb;
    __device__ __forceinline__ bool next(int i, Unit& u) const { int pm, pn; if (!o.mn(i, pm, pn)) return false;
        const int b = pn >> 5, j = pn & 31; u.pm = pm; u.pn = pn; u.x0 = b; u.x1 = j;
        u.A = WinT + (size_t)pm * 256 * 2048; u.hsA = 128u * 2048u; u.B = xb + ((size_t)(b * SEQ + 2 * j)) * 2048; u.hsB = 2048u; return true; }
};
struct SchedS1 {
    int G, c; const char* F1; const char* Ut;
    __device__ __forceinline__ bool next(int i, Unit& u) const { const int L = i * G + c; if (L >= 1024) return false;
        u.pm = 0; u.pn = L; u.x0 = 0; u.x1 = 0; u.A = F1; u.hsA = 128u * 256u; u.B = Ut + (size_t)L * 256 * 256; u.hsB = 128u * 256u; return true; }
};
struct SchedS2 {
    gm::GridOrder o; const char* F2; const char* A1;
    __device__ __forceinline__ bool next(int i, Unit& u) const { int pm, pn; if (!o.mn(i, pm, pn)) return false;
        const int g = pm, b = pn >> 2, ct = pn & 3; u.pm = g; u.pn = ct; u.x0 = b; u.x1 = g;
        u.A = F2 + (size_t)g * 256 * 256; u.hsA = 128u * 256u; u.B = A1 + ((size_t)((b * 64 + g) * 1024 + ct * 256)) * 256; u.hsB = 128u * 256u; return true; }
};
struct SchedMoe {
    gm::GridOrder o; const LAS int* ts; const char* A; const char* W; size_t wstride; unsigned ldB;
    __device__ __forceinline__ bool next(int i, Unit& u) const { int pm, pn; if (!o.mn(i, pm, pn)) return false;
        int e = 0;
#pragma unroll 1
        for (int k = 1; k < NE; ++k) e += (ts[k] <= pm) ? 1 : 0;
        u.pm = pm; u.pn = pn; u.x0 = e; u.x1 = pm - ts[e]; u.A = A; u.hsA = 0u; u.B = W + (size_t)e * wstride + (size_t)pn * 256 * ldB; u.hsB = 128u * ldB; return true; }
};

typedef f32x4 Acc[2][2][4][2];
struct EpiRow {
    static constexpr bool PERM = true;
    bf16_t* O; size_t ld; int split_tiles; size_t split_stride; float scale0;
    __device__ __forceinline__ void operator()(const Acc& acc, const Unit& u, int, int wr, int wc, int fr, int fq) const {
        int pn = u.pn; bf16_t* base = O; float sc = 1.f;
        if (split_tiles) { const int t = pn / split_tiles; base += (size_t)t * split_stride; pn -= t * split_tiles; if (t == 0) sc = scale0; }
        const size_t row0 = (size_t)u.pm * 256 + wr * 64 + fr; const int col0 = pn * 256 + wc * 32 + 8 * fq;
#pragma unroll
        for (int ai = 0; ai < 2; ++ai)
#pragma unroll
            for (int m = 0; m < 4; ++m) { bf16_t* rowp = base + (row0 + ai * 128 + m * 16) * ld + col0;
#pragma unroll
                for (int bj = 0; bj < 2; ++bj) *(u32x4*)(rowp + bj * 128) = pack8(acc[ai][bj][m][0] * sc, acc[ai][bj][m][1] * sc); }
    }
};
struct EpiG1 {
    static constexpr bool PERM = true;
    bf16_t* Ut;
    __device__ __forceinline__ void operator()(const Acc& acc, const Unit& u, int, int wr, int wc, int fr, int fq) const {
#pragma unroll
        for (int ai = 0; ai < 2; ++ai)
#pragma unroll
            for (int m = 0; m < 4; ++m) { const int c = u.pm * 256 + ai * 128 + wr * 64 + m * 16 + fr;
#pragma unroll
                for (int bj = 0; bj < 2; ++bj) { const int s2 = 2 * u.x1 + bj;
                    *(u32x4*)(Ut + (((size_t)(u.x0 * 1024 + c) * 64 + s2) * 128 + wc * 32 + 8 * fq)) = pack8(acc[ai][bj][m][0], acc[ai][bj][m][1]); } }
    }
};
struct EpiS1 {
    static constexpr bool PERM = true;
    bf16_t* A1;
    __device__ __forceinline__ void operator()(const Acc& acc, const Unit& u, int, int wr, int wc, int fr, int fq) const {
#pragma unroll
        for (int m = 0; m < 4; ++m) { const int m1 = wr * 64 + m * 16 + fr, g = m1 >> 1, ri = m1 & 1;
#pragma unroll
            for (int bj = 0; bj < 2; ++bj) { const int nrow = u.pn * 256 + bj * 128 + wc * 32 + 8 * fq, s2 = nrow & 63, c = (nrow >> 6) & 1023, b = nrow >> 16;
                *(u32x4*)(A1 + ((size_t)((b * 64 + g) * 1024 + c) * 128 + ri * 64 + s2)) = pack8(acc[0][bj][m][0], acc[0][bj][m][1]); } }
    }
};
struct EpiS2 {
    static constexpr bool PERM = true;
    bf16_t* Y;
    __device__ __forceinline__ void operator()(const Acc& acc, const Unit& u, int, int wr, int wc, int fr, int fq) const {
        const int g = u.x1, b = u.x0;
#pragma unroll
        for (int ai = 0; ai < 2; ++ai)
#pragma unroll
            for (int m = 0; m < 4; ++m) { const int mm = wr * 64 + m * 16 + fr, k2 = mm >> 1, rip = mm & 1;
                const int k1 = ai ? (g ? 128 - g : 64) : g, k = k1 + 128 * k2;
#pragma unroll
                for (int bj = 0; bj < 2; ++bj) { const int c = u.pn * 256 + bj * 128 + wc * 32 + 8 * fq;
                    *(u32x4*)(Y + ((size_t)(b * SEQ + k) * 2048 + rip * 1024 + c)) = pack8(acc[ai][bj][m][0], acc[ai][bj][m][1]); } }
    }
};
__device__ __forceinline__ float silu_mul(float g, float up) { return g * __builtin_amdgcn_rcpf(1.0f + __expf(-g)) * up; }
struct EpiGU {
    static constexpr bool PERM = true;
    bf16_t* Hb; const LAS int* idxdst;
    __device__ __forceinline__ void operator()(const Acc& acc, const Unit& u, int ui, int wr, int wc, int fr, int fq) const {
#pragma unroll
        for (int ai = 0; ai < 2; ++ai)
#pragma unroll
            for (int m = 0; m < 4; ++m) { const int a = idxdst[ui * 256 + ai * 128 + wr * 64 + m * 16 + fr];
                if (a >= 0) { f32x4 h0, h1;
#pragma unroll
                    for (int j = 0; j < 4; ++j) { h0[j] = silu_mul(acc[ai][0][m][0][j], acc[ai][1][m][0][j]); h1[j] = silu_mul(acc[ai][0][m][1][j], acc[ai][1][m][1][j]); }
                    *(u32x4*)(Hb + ((size_t)a * DEX + u.pn * 128 + wc * 32 + 8 * fq)) = pack8(h0, h1); } }
    }
};
struct EpiDown {
    static constexpr bool PERM = true;
    bf16_t* ys; const LAS int* idxdst;
    __device__ __forceinline__ void operator()(const Acc& acc, const Unit& u, int ui, int wr, int wc, int fr, int fq) const {
#pragma unroll
        for (int ai = 0; ai < 2; ++ai)
#pragma unroll
            for (int m = 0; m < 4; ++m) { const int a = idxdst[ui * 256 + ai * 128 + wr * 64 + m * 16 + fr];
                if (a >= 0) {
#pragma unroll
                    for (int bj = 0; bj < 2; ++bj) *(u32x4*)(ys + ((size_t)a * DM + u.pn * 256 + bj * 128 + wc * 32 + 8 * fq)) = pack8(acc[ai][bj][m][0], acc[ai][bj][m][1]); } }
    }
};

__device__ __forceinline__ void transpose_tile(const Params& p, LAS unsigned char* lds, int tt) {
    const int tid = tid_fresh();
    const float* src; int C, r0, c0, dld, kind = -1; bf16_t* dst;
    unsigned char* ws = p.ws;
    if (tt < 256) { src = p.in[1]; C = 1024; r0 = (tt >> 4) * 64; c0 = (tt & 15) * 64; dst = (bf16_t*)(ws + WS_WIN); dld = 1024; }
    else if (tt < 1024) { const int t2 = tt - 256; src = p.in[3]; C = 3072; r0 = (t2 / 48) * 64; c0 = (t2 % 48) * 64; dst = (bf16_t*)(ws + WS_WQKV); dld = 1024; }
    else if (tt < 1280) { const int t2 = tt - 1024; src = p.in[5]; C = 1024; r0 = (t2 >> 4) * 64; c0 = (t2 & 15) * 64; dst = (bf16_t*)(ws + WS_WO); dld = 1024; }
    else { const int t3 = tt - 1280, ee = t3 >> 7, tl = t3 & 127, mat = ee & 63; kind = ee >> 6;
        if (kind < 2) { src = p.in[8 + kind] + (size_t)mat * 1024 * 512; C = 512; r0 = (tl >> 3) * 64; c0 = (tl & 7) * 64; dst = (bf16_t*)(ws + WS_WGU) + (size_t)mat * 1024 * 1024; dld = 1024; }
        else { src = p.in[10] + (size_t)mat * 512 * 1024; C = 1024; r0 = (tl >> 4) * 64; c0 = (tl & 15) * 64; dst = (bf16_t*)(ws + WS_WD) + (size_t)mat * 1024 * 512; dld = 512; } }
    LAS float* tile = (LAS float*)lds;
#pragma unroll
    for (int ps = 0; ps < 2; ++ps) { const int row = (tid >> 4) + 32 * ps, col4 = (tid & 15) * 4; const f32x4 v = *(const f32x4*)(src + (size_t)(r0 + row) * C + c0 + col4);
        tile[row * 65 + col4 + 0] = v[0]; tile[row * 65 + col4 + 1] = v[1]; tile[row * 65 + col4 + 2] = v[2]; tile[row * 65 + col4 + 3] = v[3]; }
    __syncthreads();
    { const int n = tid >> 3, kc = (tid & 7) * 8; f32x4 a, b;
#pragma unroll
        for (int j = 0; j < 4; ++j) { a[j] = tile[(kc + j) * 65 + n]; b[j] = tile[(kc + 4 + j) * 65 + n]; }
        const int nn = c0 + n; const int drow = (kind == 0 || kind == 1) ? (256 * (nn >> 7) + (nn & 127) + 128 * kind) : nn;
        *(u32x4*)(dst + (size_t)drow * dld + r0 + kc) = pack8(a, b); }
    __syncthreads();
}

__device__ __forceinline__ void phase_prologue(const Params& p, LAS unsigned char* lds) {
    const int tid = tid_fresh(); unsigned char* ws = p.ws;
    { const float* x = p.in[0]; bf16_t* xb = (bf16_t*)(ws + WS_S0);
      for (size_t i = ((size_t)blockIdx.x * 512 + tid) * 8; i < (size_t)T * DM; i += (size_t)gridDim.x * 512 * 8) { const f32x4 a = *(const f32x4*)(x + i), b = *(const f32x4*)(x + i + 4); *(u32x4*)(xb + i) = pack8(a, b); } }
    for (int tt = blockIdx.x; tt < 1280 + 192 * 128; tt += gridDim.x) transpose_tile(p, lds, tt);
    { bf16_t* F1 = (bf16_t*)(ws + WS_F1); bf16_t* F2 = (bf16_t*)(ws + WS_F2);
      for (int idx = blockIdx.x * 512 + tid; idx < 256 * 128; idx += gridDim.x * 512) { const int m1 = idx >> 7, s1 = idx & 127; float v = 0.f;
          if (m1 < 128) { const int g = m1 >> 1, ri = m1 & 1;
              if (g == 0) v = ri ? ((s1 & 1) ? -1.f : 1.f) : 1.f;
              else { const float ph = (float)((s1 * g) & 127) * (1.0f / 128.0f); v = ri ? -__builtin_amdgcn_sinf(ph) : __builtin_amdgcn_cosf(ph); } }
          F1[idx] = (bf16_t)(cvt_pk_bf16(v, 0.f) & 0xffffu); }
      const float sc = 0.011048543456039806f;
      for (int idx = blockIdx.x * 512 + tid; idx < 64 * 256 * 128; idx += gridDim.x * 512) { const int g = idx >> 15, m2 = (idx >> 7) & 255, kk = idx & 127;
          const int hsel = m2 >> 7, k2 = (m2 & 127) >> 1, rip = m2 & 1, slot = kk >> 6, s2 = kk & 63;
          const int k1 = hsel ? (g ? 128 - g : 64) : g, k = k1 + 128 * k2;
          const float ph = (float)((s2 * k) & 8191) * (1.0f / 8192.0f); const float cs = __builtin_amdgcn_cosf(ph), sn = __builtin_amdgcn_sinf(ph);
          float v;
          if (g == 0) { v = (slot == hsel) ? (rip ? -sn : cs) : 0.f; }
          else if (hsel == 0) { v = rip ? (slot ? cs : -sn) : (slot ? sn : cs); }
          else { v = rip ? (slot ? -cs : -sn) : (slot ? -sn : cs); }
          F2[idx] = (bf16_t)(cvt_pk_bf16(v * sc, 0.f) & 0xffffu); } }
    { LAS float* ctab = (LAS float*)lds; LAS float* stab = ctab + 256; const float* wout = p.in[2]; bf16_t* W2 = (bf16_t*)(ws + WS_W2);
      __syncthreads();
      if (tid < 256) { const float ph = (float)tid * (1.0f / 256.0f); ctab[tid] = __builtin_amdgcn_cosf(ph); stab[tid] = __builtin_amdgcn_sinf(ph); }
      __syncthreads();
      for (int item = blockIdx.x; item < 256; item += gridDim.x) { const int gp = item >> 6, cch = (item >> 1) & 31, n = (item & 1) * 512 + tid;
          float ac[8], as[8];
#pragma unroll
          for (int j = 0; j < 8; ++j) { ac[j] = 0.f; as[j] = 0.f; }
          for (int k2 = 0; k2 < 256; ++k2) { const float w = wout[(size_t)(gp * 256 + k2) * 1024 + n];
#pragma unroll
              for (int j = 0; j < 8; ++j) { const int ix = ((cch * 8 + j) * k2) & 255; ac[j] += ctab[ix] * w; as[j] += stab[ix] * w; } }
          f32x4 a0, a1, s0, s1;
#pragma unroll
          for (int j = 0; j < 4; ++j) { a0[j] = ac[j] * 0.0625f; a1[j] = ac[4 + j] * 0.0625f; s0[j] = as[j] * 0.0625f; s1[j] = as[4 + j] * 0.0625f; }
          *(u32x4*)(W2 + (size_t)n * 2048 + gp * 256 + cch * 8) = pack8(a0, a1);
          *(u32x4*)(W2 + (size_t)n * 2048 + 1024 + gp * 256 + cch * 8) = pack8(s0, s1); }
      __syncthreads(); }
}

__device__ __forceinline__ float reduce32(float (&v)[32], int lane) {
    float a[16], b[8], c[4], d[2], e;
    { const bool hi = (lane & 32) != 0;
#pragma unroll
      for (int j = 0; j < 16; ++j) { const float send = hi ? v[j] : v[j + 16], keep = hi ? v[j + 16] : v[j]; a[j] = keep + __shfl_xor(send, 32); } }
    { const bool hi = (lane & 16) != 0;
#pragma unroll
      for (int j = 0; j < 8; ++j) { const float send = hi ? a[j] : a[j + 8], keep = hi ? a[j + 8] : a[j]; b[j] = keep + __shfl_xor(send, 16); } }
    { const bool hi = (lane & 8) != 0;
#pragma unroll
      for (int j = 0; j < 4; ++j) { const float send = hi ? b[j] : b[j + 4], keep = hi ? b[j + 4] : b[j]; c[j] = keep + __shfl_xor(send, 8); } }
    { const bool hi = (lane & 4) != 0;
#pragma unroll
      for (int j = 0; j < 2; ++j) { const float send = hi ? c[j] : c[j + 2], keep = hi ? c[j + 2] : c[j]; d[j] = keep + __shfl_xor(send, 4); } }
    { const bool hi = (lane & 2) != 0; const float send = hi ? d[0] : d[1], keep = hi ? d[1] : d[0]; e = keep + __shfl_xor(send, 2); }
    e += __shfl_xor(e, 1);
    return e;
}

constexpr int TPP = 2;
__device__ __forceinline__ void phase_lnA(const Params& p, LAS unsigned char* lds, const int L, const float* res, const bf16_t* ybuf, float* hout, bf16_t* hb) {
    const int tid = tid_fresh(), lane = tid & 63, wid = tid >> 6;
    unsigned char* ws = p.ws;
    LAS float* wl = (LAS float*)lds;
    { const float* wrg = p.in[6];
      for (int idx = tid; idx < 1024 * 8; idx += 512) { const int c = idx >> 3, q = idx & 7; const f32x4 v = *(const f32x4*)(wrg + c * 32 + q * 4);
          const int rho = (c & ~255) | ((c & 3) << 6) | ((c >> 2) & 63), s = (rho >> 1) & 7; *(LAS f32x4*)(wl + rho * 32 + ((q ^ s) << 2)) = v; } }
    LAS float* scr = (LAS float*)(lds + 131072) + wid * 256;
    LAS int* asgE = (LAS int*)(lds + 131072 + 8192);
    LAS int* misc = asgE + 256;
    __syncthreads();
    const float* lg = p.in[11] + (L * 2 + 0) * 1024; const float* lb = p.in[12] + (L * 2 + 0) * 1024;
    f32x4 gv[4], bv[4];
#pragma unroll
    for (int j = 0; j < 4; ++j) { gv[j] = *(const f32x4*)(lg + 256 * j + 4 * lane); bv[j] = *(const f32x4*)(lb + 256 * j + 4 * lane); }
    const float br = p.in[7][lane >> 1];
    float* gates = (float*)(ws + WS_GATE);
    const int tok0 = blockIdx.x * 128 + wid * 16;
#pragma unroll 1
    for (int pass = 0; pass < 16 / TPP; ++pass) {
        const int t0 = tok0 + pass * TPP;
        f32x4 hv[TPP][4];
#pragma unroll
        for (int tk = 0; tk < TPP; ++tk) { const size_t rowo = (size_t)(t0 + tk) * DM;
            float s = 0.f;
#pragma unroll
            for (int j = 0; j < 4; ++j) { const f32x4 xv = *(const f32x4*)(res + rowo + 256 * j + 4 * lane); const u32x2 yw = *(const u32x2*)(ybuf + rowo + 256 * j + 4 * lane);
                f32x4 v; v[0] = ALPHA * xv[0] + bf_lo(yw.x); v[1] = ALPHA * xv[1] + bf_hi(yw.x); v[2] = ALPHA * xv[2] + bf_lo(yw.y); v[3] = ALPHA * xv[3] + bf_hi(yw.y);
                hv[tk][j] = v; s += (v[0] + v[1]) + (v[2] + v[3]); }
            const float mean = wave_sum(s) * (1.0f / 1024.0f); float q = 0.f;
#pragma unroll
            for (int j = 0; j < 4; ++j) { const f32x4 d = hv[tk][j] - mean; q += (d[0] * d[0] + d[1] * d[1]) + (d[2] * d[2] + d[3] * d[3]); }
            const float rstd = 1.0f / sqrtf(wave_sum(q) * (1.0f / 1024.0f) + LN_EPS);
#pragma unroll
            for (int j = 0; j < 4; ++j) { const f32x4 h = (hv[tk][j] - mean) * rstd * gv[j] + bv[j]; hv[tk][j] = h;
                *(f32x4*)(hout + rowo + 256 * j + 4 * lane) = h; u32x2 w; w.x = cvt_pk_bf16(h[0], h[1]); w.y = cvt_pk_bf16(h[2], h[3]); *(u32x2*)(hb + rowo + 256 * j + 4 * lane) = w; } }
        f32x2 part[32];
#pragma unroll
        for (int e = 0; e < 32; ++e) part[e] = (f32x2){0.f, 0.f};
        const int sw = (lane >> 1) & 7;
#pragma unroll
        for (int j = 0; j < 4; ++j)
#pragma unroll
            for (int qp = 0; qp < 4; ++qp) { const LAS float* wrow = wl + (256 * j + 64 * qp + lane) * 32; const f32x2 hp = (f32x2){hv[0][j][qp], hv[1][j][qp]};
#pragma unroll
                for (int q = 0; q < 8; ++q) { const f32x4 w4 = *(const LAS f32x4*)(wrow + ((q ^ sw) << 2));
#pragma unroll
                    for (int e = 0; e < 4; ++e) part[4 * q + e] += hp * w4[e]; }
                __builtin_amdgcn_sched_barrier(0); }
        { float p0[32], p1[32];
#pragma unroll
          for (int e = 0; e < 32; ++e) { p0[e] = part[e].x; p1[e] = part[e].y; }
          const float l0 = reduce32(p0, lane), l1 = reduce32(p1, lane);
          const float sc0 = 1.0f / (1.0f + __expf(-l0)), sc1 = 1.0f / (1.0f + __expf(-l1));
          if ((lane & 1) == 0) { scr[(lane >> 1)] = sc0 + br; scr[128 + (lane >> 1)] = sc0; scr[32 + (lane >> 1)] = sc1 + br; scr[128 + 32 + (lane >> 1)] = sc1; } }
        asm volatile("s_waitcnt lgkmcnt(0)" ::: "memory");
        if (lane < TPP) { const LAS float* sel = scr + lane * 32; float best = -3.0e38f; int bg = 0, b1 = 0, b2 = 0;
#pragma unroll 1
            for (int g = 0; g < 4; ++g) { float m1 = -3.0e38f, m2 = -3.0e38f; int i1 = 0, i2 = 0;
#pragma unroll 1
                for (int j = 0; j < 8; ++j) { const float v = sel[g * 8 + j]; if (v > m1) { m2 = m1; i2 = i1; m1 = v; i1 = j; } else if (v > m2) { m2 = v; i2 = j; } }
                const float gs = m1 + m2; if (gs > best) { best = gs; bg = g; b1 = i1; b2 = i2; } }
            const int e1 = bg * 8 + b1, e2 = bg * 8 + b2; const float s1 = scr[128 + lane * 32 + e1], s2 = scr[128 + lane * 32 + e2], inv = 1.0f / (s1 + s2);
            const int tl = wid * 16 + pass * TPP + lane; asgE[2 * tl] = e1; asgE[2 * tl + 1] = e2;
            const int t = t0 + lane; gates[2 * t] = s1 * inv; gates[2 * t + 1] = s2 * inv; }
        asm volatile("s_waitcnt lgkmcnt(0)" ::: "memory");
    }
    __syncthreads();
    int my_e = 0, my_rank = 0;
    if (tid < 256) { my_e = asgE[tid];
#pragma unroll 1
        for (int j = 0; j < tid; ++j) my_rank += (asgE[j] == my_e) ? 1 : 0; }
    if (tid < 32) { int c = 0;
#pragma unroll 1
        for (int j = 0; j < 256; ++j) c += (asgE[j] == tid) ? 1 : 0;
        unsigned* cnt = (unsigned*)(ws + WS_CTL) + CNT_WORD0 + (L * 32 + tid) * 64;
        misc[tid] = (int)__hip_atomic_fetch_add(cnt, (unsigned)c, __ATOMIC_RELAXED, __HIP_MEMORY_SCOPE_AGENT); }
    __syncthreads();
    if (tid < 256) { int* list = (int*)(ws + WS_LIST); list[(size_t)my_e * NASG + misc[my_e] + my_rank] = blockIdx.x * 256 + tid; }
    __syncthreads();
}

__device__ __forceinline__ void phase_lnB(const Params& p, const int L, float* hio, const bf16_t* ys, bf16_t* xb_out) {
    const int tid = tid_fresh(), lane = tid & 63, wid = tid >> 6;
    const float* lg = p.in[11] + (L * 2 + 1) * 1024; const float* lb = p.in[12] + (L * 2 + 1) * 1024;
    const float* gates = (const float*)(p.ws + WS_GATE);
    f32x4 gv[4], bv[4];
#pragma unroll
    for (int j = 0; j < 4; ++j) { gv[j] = *(const f32x4*)(lg + 256 * j + 4 * lane); bv[j] = *(const f32x4*)(lb + 256 * j + 4 * lane); }
    const int tok0 = blockIdx.x * 128 + wid * 16;
#pragma unroll 2
    for (int tk = 0; tk < 16; ++tk) { const int t = tok0 + tk; const size_t rowo = (size_t)t * DM; const float g0 = gates[2 * t], g1 = gates[2 * t + 1];
        f32x4 v[4]; float s = 0.f;
#pragma unroll
        for (int j = 0; j < 4; ++j) { const f32x4 hv = *(const f32x4*)(hio + rowo + 256 * j + 4 * lane);
            const u32x2 y0 = *(const u32x2*)(ys + (size_t)(2 * t) * DM + 256 * j + 4 * lane), y1 = *(const u32x2*)(ys + (size_t)(2 * t + 1) * DM + 256 * j + 4 * lane);
            f32x4 w; w[0] = ALPHA * hv[0] + g0 * bf_lo(y0.x) + g1 * bf_lo(y1.x); w[1] = ALPHA * hv[1] + g0 * bf_hi(y0.x) + g1 * bf_hi(y1.x);
            w[2] = ALPHA * hv[2] + g0 * bf_lo(y0.y) + g1 * bf_lo(y1.y); w[3] = ALPHA * hv[3] + g0 * bf_hi(y0.y) + g1 * bf_hi(y1.y);
            v[j] = w; s += (w[0] + w[1]) + (w[2] + w[3]); }
        const float mean = wave_sum(s) * (1.0f / 1024.0f); float q = 0.f;
#pragma unroll
        for (int j = 0; j < 4; ++j) { const f32x4 d = v[j] - mean; q += (d[0] * d[0] + d[1] * d[1]) + (d[2] * d[2] + d[3] * d[3]); }
        const float rstd = 1.0f / sqrtf(wave_sum(q) * (1.0f / 1024.0f) + LN_EPS);
#pragma unroll
        for (int j = 0; j < 4; ++j) { const f32x4 o = (v[j] - mean) * rstd * gv[j] + bv[j]; *(f32x4*)(hio + rowo + 256 * j + 4 * lane) = o;
            if (xb_out) { u32x2 w; w.x = cvt_pk_bf16(o[0], o[1]); w.y = cvt_pk_bf16(o[2], o[3]); *(u32x2*)(xb_out + rowo + 256 * j + 4 * lane) = w; } } }
}

__device__ __forceinline__ void phase_attn(const Params& p, LAS unsigned char* lds, const bf16_t* qb, const bf16_t* kb, const bf16_t* vt, bf16_t* ob) {
    const int tid = tid_fresh(), lane = tid & 63, wid = tid >> 6, fr = lane & 15, fq = lane >> 4;
    LAS float* rp = (LAS float*)lds;
    for (int idx = tid; idx < 16 * 15 * 31; idx += 512) rp[idx] = p.in[4][idx];
    __syncthreads();
#pragma unroll 1
    for (int it = 0; it < 16; ++it) {
        const int pair = it >> 3, hh = (it >> 2) & 1, jq = it & 3;
        const int brow = blockIdx.x * 2 + pair, b = brow >> 7, r = brow & 127, h = wid * 2 + hh;
        const int rs = min(max(r - 4, 0), 120), c0 = min(max(16 * jq - 8, 0), 32);
        const size_t tokq = (size_t)b * SEQ + r * 64 + 16 * jq + fr;
        bf16x8 qf[2];
#pragma unroll
        for (int ks = 0; ks < 2; ++ks) qf[ks] = *(const bf16x8*)(qb + tokq * DM + h * 64 + 32 * ks + 8 * fq);
        f32x4 s[16];
#pragma unroll
        for (int kbi = 0; kbi < 16; ++kbi) { const int i = kbi >> 1, half = kbi & 1; const size_t tokk = (size_t)b * SEQ + (rs + i) * 64 + c0 + 16 * half + fr;
            const bf16x8 k0 = *(const bf16x8*)(kb + tokk * DM + h * 64 + 8 * fq), k1 = *(const bf16x8*)(kb + tokk * DM + h * 64 + 32 + 8 * fq);
            f32x4 a = (f32x4){0.f, 0.f, 0.f, 0.f};
            a = __builtin_amdgcn_mfma_f32_16x16x32_bf16(k0, qf[0], a, 0, 0, 0); a = __builtin_amdgcn_mfma_f32_16x16x32_bf16(k1, qf[1], a, 0, 0, 0); s[kbi] = a; }
        const int qc = 16 * jq + fr, cs = min(max(qc - 8, 0), 48);
        float mx = -3.0e38f;
#pragma unroll
        for (int kbi = 0; kbi < 16; ++kbi) { const int i = kbi >> 1, half = kbi & 1; const int ri = rs + i - r + 7;
#pragma unroll
            for (int j = 0; j < 4; ++j) { const int kc = c0 + 16 * half + 4 * fq + j; const bool valid = (kc >= cs) && (kc < cs + 16); const int ci = min(max(kc - qc + 15, 0), 30);
                const float v = valid ? s[kbi][j] + rp[(h * 15 + ri) * 31 + ci] : -3.0e38f; s[kbi][j] = v; mx = fmaxf(mx, v); } }
        mx = fmaxf(mx, __shfl_xor(mx, 16)); mx = fmaxf(mx, __shfl_xor(mx, 32));
        float sum = 0.f;
#pragma unroll
        for (int kbi = 0; kbi < 16; ++kbi)
#pragma unroll
            for (int j = 0; j < 4; ++j) { const float e = __expf(s[kbi][j] - mx); s[kbi][j] = e; sum += e; }
        sum += __shfl_xor(sum, 16); sum += __shfl_xor(sum, 32);
        f32x4 oacc[4];
#pragma unroll
        for (int db = 0; db < 4; ++db) oacc[db] = (f32x4){0.f, 0.f, 0.f, 0.f};
#pragma unroll
        for (int i = 0; i < 8; ++i) { const u32x4 pw = pack8(s[2 * i], s[2 * i + 1]); bf16x8 pf; __builtin_memcpy(&pf, &pw, 16);
#pragma unroll
            for (int db = 0; db < 4; ++db) { const bf16_t* vrow = vt + (size_t)(h * 64 + 16 * db + fr) * T + (size_t)b * SEQ + (rs + i) * 64 + c0 + 4 * fq;
                const u32x2 lo = *(const u32x2*)vrow, hi = *(const u32x2*)(vrow + 16); u32x4 vw; vw.x = lo.x; vw.y = lo.y; vw.z = hi.x; vw.w = hi.y; bf16x8 vf; __builtin_memcpy(&vf, &vw, 16);
                oacc[db] = __builtin_amdgcn_mfma_f32_16x16x32_bf16(vf, pf, oacc[db], 0, 0, 0); } }
        const float inv = 1.0f / sum;
#pragma unroll
        for (int db = 0; db < 4; ++db) { u32x2 w; w.x = cvt_pk_bf16(oacc[db][0] * inv, oacc[db][1] * inv); w.y = cvt_pk_bf16(oacc[db][2] * inv, oacc[db][3] * inv);
            *(u32x2*)(ob + tokq * DM + h * 64 + 16 * db + 4 * fq) = w; }
    }
    __syncthreads();
}

template <int SRC_SHIFT>
__device__ __forceinline__ int moe_setup(const Params& p, LAS unsigned char* lds, const int L, LAS int* ts, LAS int* idxsrc, LAS int* idxdst) {
    const int tid = tid_fresh(); unsigned char* ws = p.ws;
    LAS int* cn = ts + 40;
    if (tid < 32) cn[tid] = (int)__hip_atomic_load((unsigned*)(ws + WS_CTL) + CNT_WORD0 + (L * 32 + tid) * 64, __ATOMIC_RELAXED, __HIP_MEMORY_SCOPE_AGENT);
    __syncthreads();
    if (tid == 0) { int acc = 0; for (int e = 0; e < NE; ++e) { ts[e] = acc; acc += (cn[e] + 255) >> 8; } ts[NE] = acc; }
    __syncthreads();
    const int ntile = ts[NE];
    gm::GridOrder o; o.init(ntile, 4, gridDim.x, blockIdx.x);
    const int* list = (const int*)(ws + WS_LIST);
    for (int ui = 0; ui < 8; ++ui) { int pm, pn; if (!o.mn(ui, pm, pn)) break;
        int e = 0; for (int k = 1; k < NE; ++k) e += (ts[k] <= pm) ? 1 : 0;
        const int j = pm - ts[e], ce = cn[e];
        if (tid < 256) { const int pos = j * 256 + tid; const bool ok = pos < ce; const int a = list[(size_t)e * NASG + (ok ? pos : j * 256)];
            idxsrc[ui * 256 + tid] = a >> SRC_SHIFT; idxdst[ui * 256 + tid] = ok ? a : -1; } }
    __syncthreads();
    return ntile;
}

__global__ void __launch_bounds__(512, 2) k_fwd(Params p) {
    extern __shared__ __attribute__((aligned(16))) unsigned char lds_raw[];
    LAS unsigned char* lds = (LAS unsigned char*)lds_raw;
    unsigned char* ws = p.ws;
    const int tid = tid_fresh(), G = gridDim.x, cb = blockIdx.x;
    if (tid < 4) ((LAS unsigned*)(lds + LDS_BARW))[tid] = 0u;
    __syncthreads();
    XcdBarrier bar; bar.bar = (unsigned*)(ws + WS_CTL); bar.x = 0; bar.st = nullptr;
    const int lo = p.ph_lo, hi = p.ph_hi;
    if (hi - lo > 1) bar = xcd_barrier_post((unsigned*)(ws + WS_CTL), (volatile LAS unsigned*)(lds + LDS_BARW));
#ifndef PHMASK
#define PHMASK 0xffff
#endif
#define IN(k) (((PHMASK >> ((k) > 8 ? (k) : (k))) & 1) && lo <= (k) && (k) < hi)
#define SEAM(k) do { if (IN((k) + 1)) xcd_barrier(bar); } while (0)
    bf16_t* S0 = (bf16_t*)(ws + WS_S0); bf16_t* S1 = (bf16_t*)(ws + WS_S1); bf16_t* S2 = (bf16_t*)(ws + WS_S2); bf16_t* S3 = (bf16_t*)(ws + WS_S3);
    LAS int* idxsrc = (LAS int*)(lds + LDS_IDX); LAS int* idxdst = idxsrc + 8 * 256; LAS int* tsm = (LAS int*)(lds + LDS_MISC);

    if (IN(0)) { phase_prologue(p, lds); SEAM(0); }

#pragma unroll 1
    for (int L = 0; L < 2; ++L) {
        const int pb = 7 * L;
        if (L == 0) {
            if (IN(1)) {
                SchedG1 S; S.o.init(4, 128, G, cb); S.WinT = (const char*)(ws + WS_WIN); S.xb = (const char*)S0; EpiG1 E{S1};
                gm::gemm_phase<EpiG1, SchedG1, false>(lds, 1024, 2048u, 64u * 2048u, S, E, nullptr); SEAM(1); }
            if (IN(2)) {
                SchedS1 S{G, cb, (const char*)(ws + WS_F1), (const char*)S1}; EpiS1 E{S0};
                gm::gemm_phase<EpiS1, SchedS1, false>(lds, 128, 256u, 256u, S, E, nullptr); SEAM(2); }
            if (IN(3)) {
                SchedS2 S; S.o.init(64, 16, G, cb); S.F2 = (const char*)(ws + WS_F2); S.A1 = (const char*)S0; EpiS2 E{S1};
                gm::gemm_phase<EpiS2, SchedS2, false>(lds, 128, 256u, 256u, S, E, nullptr); SEAM(3); }
        } else {
            if (IN(9)) {
                { SchedPlain S; S.o.init(128, 8, G, cb); S.A = (const char*)S0; S.B = (const char*)(ws + WS_WQKV); S.ldA = 2048u; S.ldB = 2048u; EpiRow E{S1, 1024, 4, (size_t)(WS_S2 - WS_S1) / 2, 0.125f};
                  gm::gemm_phase<EpiRow, SchedPlain, false>(lds, 1024, 2048u, 2048u, S, E, nullptr); }
                { SchedPlain S; S.o.init(4, 128, G, cb); S.A = (const char*)(ws + WS_WQKV) + (size_t)2048 * 2048; S.B = (const char*)S0; S.ldA = 2048u; S.ldB = 2048u; EpiRow E{S3, (size_t)T, 0, 0, 1.f};
                  gm::gemm_phase<EpiRow, SchedPlain, false>(lds, 1024, 2048u, 2048u, S, E, nullptr); }
                SEAM(9); }
            if (IN(10)) { phase_attn(p, lds, S1, S2, S3, S0); SEAM(10); }
        }
        if (IN(4 + pb)) {
            SchedPlain S; S.o.init(128, 4, G, cb);
            if (L == 0) { S.A = (const char*)S1; S.B = (const char*)(ws + WS_W2); S.ldA = 4096u; S.ldB = 4096u; } else { S.A = (const char*)S0; S.B = (const char*)(ws + WS_WO); S.ldA = 2048u; S.ldB = 2048u; }
            EpiRow E{L == 0 ? S0 : S1, 1024, 0, 0, 1.f};
            gm::gemm_phase<EpiRow, SchedPlain, false>(lds, L == 0 ? 2048 : 1024, S.ldA, S.ldB, S, E, nullptr); SEAM(4 + pb); }
        if (IN(5 + pb)) { phase_lnA(p, lds, L, L == 0 ? p.in[0] : p.out, L == 0 ? S0 : S1, p.out, S3); SEAM(5 + pb); }
        if (IN(6 + pb)) {
            const int ntile = moe_setup<1>(p, lds, L, tsm, idxsrc, idxdst);
            SchedMoe S; S.o.init(ntile, 4, G, cb); S.ts = tsm; S.A = (const char*)S3; S.W = (const char*)(ws + WS_WGU) + (size_t)L * 32 * 1024 * 1024 * 2; S.wstride = (size_t)1024 * 1024 * 2; S.ldB = 2048u;
            EpiGU E{S0, idxdst};
            gm::gemm_phase<EpiGU, SchedMoe, true>(lds, 1024, 2048u, 2048u, S, E, idxsrc); SEAM(6 + pb); }
        if (IN(7 + pb)) {
            const int ntile = moe_setup<0>(p, lds, L, tsm, idxsrc, idxdst);
            SchedMoe S; S.o.init(ntile, 4, G, cb); S.ts = tsm; S.A = (const char*)S0; S.W = (const char*)(ws + WS_WD) + (size_t)L * 32 * 1024 * 512 * 2; S.wstride = (size_t)1024 * 512 * 2; S.ldB = 1024u;
            EpiDown E{S1, idxdst};
            gm::gemm_phase<EpiDown, SchedMoe, true>(lds, 512, 1024u, 1024u, S, E, idxsrc); SEAM(7 + pb); }
        if (IN(8 + pb)) { phase_lnB(p, L, p.out, S1, L == 0 ? S0 : nullptr); if (L == 0) SEAM(8); }
    }
#undef IN
#undef SEAM
}

extern "C" void kernel_launch(void* const* d_in, const int* in_sizes, int n_in, void* d_out, int out_size, void* d_ws, size_t ws_size, hipStream_t stream) {
    static int grid = 0;
    if (grid == 0) {
        if (n_in != 13 || in_sizes[0] != T * DM || out_size != T * DM || ws_size < WS_END) { fprintf(stderr, "kernel_launch: unexpected shapes / workspace (%d inputs, in0 %d, out %d, ws %zu < %zu)\n", n_in, n_in > 0 ? in_sizes[0] : -1, out_size, ws_size, (size_t)WS_END); grid = -1; return; }
        int dev = 0, cus = 0, per_cu = 0;
        if (hipGetDevice(&dev) != hipSuccess || hipDeviceGetAttribute(&cus, hipDeviceAttributeMultiprocessorCount, dev) != hipSuccess) { grid = -1; return; }
        if (hipFuncSetAttribute((const void*)k_fwd, hipFuncAttributeMaxDynamicSharedMemorySize, LDS_BYTES) != hipSuccess) { fprintf(stderr, "kernel_launch: hipFuncSetAttribute failed\n"); grid = -1; return; }
        if (hipOccupancyMaxActiveBlocksPerMultiprocessor(&per_cu, (const void*)k_fwd, 512, LDS_BYTES) != hipSuccess || per_cu < 1) fprintf(stderr, "kernel_launch: occupancy query says %d\n", per_cu);
        (void)hipGetLastError();
        grid = cus;
    }
    if (grid < 0) return;
    (void)hipMemsetAsync((char*)d_ws + WS_CTL, 0, CTL_ZERO_BYTES, stream);
    Params a{};
    for (int i = 0; i < 13; ++i) a.in[i] = (const float*)d_in[i];
    a.out = (float*)d_out; a.ws = (unsigned char*)d_ws;
#if MK_N_LAUNCHES == 1
    a.ph_lo = 0; a.ph_hi = NPH;
    hipLaunchKernelGGL(k_fwd, dim3(grid), dim3(512), LDS_BYTES, stream, a);
#else
    for (int k = 0; k < NPH; ++k) { a.ph_lo = k; a.ph_hi = k + 1; hipLaunchKernelGGL(k_fwd, dim3(grid), dim3(512), LDS_BYTES, stream, a); }
#endif
}
```

```cpp
#include <hip/hip_runtime.h>
#include <cstdio>
#include <cstdint>

#ifndef MK_N_LAUNCHES
#define MK_N_LAUNCHES 1
#endif
#ifndef REPMASK
#define REPMASK 0x0
#endif

#define LAS __attribute__((address_space(3)))
typedef unsigned short bf16_t;
typedef short bf16x8 __attribute__((ext_vector_type(8)));
typedef short bf16x4 __attribute__((ext_vector_type(4)));
typedef float f32x4 __attribute__((ext_vector_type(4)));
typedef float f32x2 __attribute__((ext_vector_type(2)));
typedef unsigned u32x4 __attribute__((ext_vector_type(4)));
typedef unsigned u32x2 __attribute__((ext_vector_type(2)));

constexpr int T = 32768, DM = 1024, SEQ = 8192, NBATCH = 4, NE = 32, DEX = 512, NASG = 65536, NPH = 16;
constexpr float ALPHA = 1.41421356237309515f;
constexpr float LN_EPS = 1e-5f;
constexpr size_t MiB = (size_t)1 << 20;
constexpr size_t WS_CTL = 0, WS_GATE = 1 * MiB, WS_LIST = 2 * MiB, WS_WIN = 10 * MiB, WS_W2 = 12 * MiB, WS_F1 = 16 * MiB, WS_F2 = 17 * MiB, WS_WQKV = 21 * MiB, WS_WO = 27 * MiB,
                 WS_WGU = 30 * MiB, WS_WD = 158 * MiB, WS_S0 = 222 * MiB, WS_S1 = 286 * MiB, WS_S2 = 350 * MiB, WS_S3 = 414 * MiB, WS_END = 478 * MiB;
constexpr size_t CTL_ZERO_BYTES = 65536;
constexpr int CNT_WORD0 = 4096;
constexpr int LDS_BYTES = 159760;
constexpr int LDS_IDX = 131072, LDS_MISC = 131072 + 16384, LDS_BARW = LDS_BYTES - 16;

#define XB_TMO      128
#define XB_XCNT(j)  (256  + 64 * (j))
#define XB_XSUB(j)  (1280 + 64 * (j))
#define XB_XGEN(j)  (2304 + 64 * (j))
#define XB_TOP      3328
#define XB_TOPGEN   3392
#define XCD_BAR_WORDS 3456
#define XB_SPIN_CAP (1u << 18)

__device__ __forceinline__ unsigned xb_ld(unsigned* p)              { return __hip_atomic_load(p, __ATOMIC_RELAXED, __HIP_MEMORY_SCOPE_AGENT); }
__device__ __forceinline__ unsigned xb_add(unsigned* p, unsigned v) { return __hip_atomic_fetch_add(p, v, __ATOMIC_RELAXED, __HIP_MEMORY_SCOPE_AGENT); }
__device__ __forceinline__ unsigned xb_xcc_id() { return (unsigned)__builtin_amdgcn_s_getreg((3 << 11) | 20) & 0xFu; }
#define XB_SPIN(cond, bar) do { unsigned _sp = 0; while (cond) { __builtin_amdgcn_s_sleep(1); \
    if ((++_sp & 255u) == 0u) { if (xb_ld(&(bar)[XB_TMO])) break; if (_sp > XB_SPIN_CAP) { atomicAdd(&(bar)[XB_TMO], 1u); break; } } } } while (0)

struct XcdBarrier { unsigned* bar; unsigned x; volatile LAS unsigned* st; };

__device__ __forceinline__ XcdBarrier xcd_barrier_post(unsigned* bar, volatile LAS unsigned* st) {
    XcdBarrier b; b.bar = bar; b.x = xb_xcc_id(); b.st = st;
    if (threadIdx.x == 0) (void)xb_add(&bar[XB_XCNT(b.x)], 1u);
    return b;
}
__device__ __forceinline__ void xcd_barrier_complete(unsigned* bar, unsigned x, unsigned& nloc, unsigned& nx) {
    const unsigned G = gridDim.x * gridDim.y * gridDim.z;
    unsigned sum, cnt, mine, sp = 0u;
    for (;;) {
        sum = 0u; cnt = 0u; mine = 0u;
#pragma unroll
        for (unsigned j = 0; j < 16; ++j) { const unsigned c = xb_ld(&bar[XB_XCNT(j)]); sum += c; cnt += (c > 0u) ? 1u : 0u; mine = (j == x) ? c : mine; }
        if (sum == G) break;
        __builtin_amdgcn_s_sleep(1);
        if ((++sp & 255u) == 0u) { if (xb_ld(&bar[XB_TMO])) break; if (sp > XB_SPIN_CAP) { atomicAdd(&bar[XB_TMO], 1u); break; } }
    }
    nloc = mine > 0u ? mine : 1u; nx = cnt > 0u ? cnt : 1u;
}
__device__ __forceinline__ void xcd_barrier(const XcdBarrier& b) {
    asm volatile("s_waitcnt vmcnt(0)" ::: "memory");
    __syncthreads();
    if (threadIdx.x == 0) {
        unsigned* bar = b.bar;
        __builtin_amdgcn_s_waitcnt(0);
        unsigned nloc = b.st[0], nx = b.st[1];
        if (nloc == 0u) { xcd_barrier_complete(bar, b.x, nloc, nx); b.st[0] = nloc; b.st[1] = nx; }
        const unsigned old = xb_add(&bar[XB_XSUB(b.x)], 1u);
        const unsigned gen = old / nloc;
        if (old + 1u == (gen + 1u) * nloc) {
            __builtin_amdgcn_fence(__ATOMIC_RELEASE, "agent");
            asm volatile("s_waitcnt vmcnt(0)" ::: "memory");
            const unsigned og = xb_add(&bar[XB_TOP], 1u);
            const unsigned tg = og / nx;
            if (og + 1u == (tg + 1u) * nx) xb_add(&bar[XB_TOPGEN], 1u);
            else XB_SPIN(xb_ld(&bar[XB_TOPGEN]) == tg, bar);
            __builtin_amdgcn_fence(__ATOMIC_ACQUIRE, "agent");
            xb_add(&bar[XB_XGEN(b.x)], 1u);
            asm volatile("s_waitcnt vmcnt(0)" ::: "memory");
        } else {
            XB_SPIN(xb_ld(&bar[XB_XGEN(b.x)]) == gen, bar);
            __builtin_amdgcn_fence(__ATOMIC_ACQUIRE, "agent");
            asm volatile("s_waitcnt vmcnt(0)" ::: "memory");
        }
    }
    __syncthreads();
}

__device__ __forceinline__ unsigned cvt_pk_bf16(float lo, float hi) { unsigned r; asm volatile("v_cvt_pk_bf16_f32 %0, %1, %2" : "=v"(r) : "v"(lo), "v"(hi)); return r; }
__device__ __forceinline__ float bf_lo(unsigned w) { return __uint_as_float(w << 16); }
__device__ __forceinline__ float bf_hi(unsigned w) { return __uint_as_float(w & 0xffff0000u); }
__device__ __forceinline__ u32x4 pack8(const f32x4 a, const f32x4 b) { u32x4 w; w.x = cvt_pk_bf16(a[0], a[1]); w.y = cvt_pk_bf16(a[2], a[3]); w.z = cvt_pk_bf16(b[0], b[1]); w.w = cvt_pk_bf16(b[2], b[3]); return w; }
__device__ __forceinline__ int tid_fresh() { int t = threadIdx.x; asm volatile("" : "+v"(t)); return t; }
__device__ __forceinline__ void bf8_to_f32(const u32x4 w, f32x4& a, f32x4& b) { a[0] = bf_lo(w.x); a[1] = bf_hi(w.x); a[2] = bf_lo(w.y); a[3] = bf_hi(w.y); b[0] = bf_lo(w.z); b[1] = bf_hi(w.z); b[2] = bf_lo(w.w); b[3] = bf_hi(w.w); }
__device__ __forceinline__ float wave_sum(float v) {
#pragma unroll
    for (int o = 32; o >= 1; o >>= 1) v += __shfl_xor(v, o);
    return v;
}

constexpr float W_SCALE = 64.0f, H_SCALE = 4.0f, O_SCALE = 16.0f, Y_SCALE = 8.0f, W2_SCALE = 256.0f, YS_SCALE = 16.0f;
__device__ __forceinline__ f32x4 fp8x4_to_f32(unsigned w) { f32x4 r; r[0] = __builtin_amdgcn_cvt_f32_fp8(w, 0); r[1] = __builtin_amdgcn_cvt_f32_fp8(w, 1); r[2] = __builtin_amdgcn_cvt_f32_fp8(w, 2); r[3] = __builtin_amdgcn_cvt_f32_fp8(w, 3); return r; }
__device__ __forceinline__ float silu_mul(float g, float up) { return g * __builtin_amdgcn_rcpf(1.0f + __expf(-g)) * up; }
__device__ __forceinline__ unsigned pk4_fp8(float a, float b, float c, float d) { unsigned r = 0; r = __builtin_amdgcn_cvt_pk_fp8_f32(a, b, r, false); r = __builtin_amdgcn_cvt_pk_fp8_f32(c, d, r, true); return r; }
namespace gm {
constexpr int BM = 256, BK = 64, HALF = 128, HTB = HALF * BK * 2, STAGE_BYTES = 8 * HTB, NXCD = 8, WGM = 8;
__device__ __forceinline__ int lds_byte(int r, int c) { const int st = (r >> 4) * 2 + (c >> 5), rr = r & 15, cc = c & 31, ob = rr * 64 + cc * 2; return st * 1024 + (ob ^ (((ob >> 9) & 1) << 5)); }
__device__ __forceinline__ void stage_rc(int b, int& R, int& C) { const int st = b / 1024, sb = b % 1024, swz = sb ^ (((sb >> 9) & 1) << 5); R = (st >> 1) * 16 + swz / 64; C = (st & 1) * 32 + (swz % 64) / 2; }
__device__ __forceinline__ int perm32(int rho) { const int n = rho >> 4, i = rho & 15; return 8 * (i >> 2) + 4 * n + (i & 3); }

__device__ __forceinline__ void glds16(const char* sbase, unsigned voff, unsigned lds_dst) {
    unsigned keep;
    asm volatile("s_mov_b32 %0, m0\n\ts_mov_b32 m0, %3\n\ts_nop 0\n\tglobal_load_lds_dwordx4 %1, %2\n\ts_mov_b32 m0, %0" : "=&s"(keep) : "v"(voff), "s"(sbase), "s"(lds_dst) : "memory");
}
struct Unit { const char* A; const char* B; unsigned hsA, hsB; int pm, pn, x0, x1; };

struct GridOrder {
    int nM, nN, nwg, G, c;
    __device__ __forceinline__ void init(int nM_, int nN_, int G_, int c_) { nM = nM_; nN = nN_; nwg = nM * nN; G = G_; c = c_; }
    __device__ __forceinline__ bool mn(int i, int& pm, int& pn) const {
        const long L = (long)i * G + c; if (L >= nwg) return false;
        int wgid = (int)L; { const int q = nwg / NXCD, r = nwg % NXCD, xcd = wgid % NXCD, off = wgid / NXCD; wgid = (xcd < r ? xcd * (q + 1) : r * (q + 1) + (xcd - r) * q) + off; }
        const int nig = WGM * nN, gid = wgid / nig, fm = gid * WGM, gsz = (nM - fm) < WGM ? (nM - fm) : WGM;
        pm = fm + ((wgid % nig) % gsz); pn = (wgid % nig) / gsz; return true;
    }
};

typedef int i32x4v __attribute__((ext_vector_type(4)));
typedef int i32x8v __attribute__((ext_vector_type(8)));
__device__ __forceinline__ i32x8v cat8(const bf16x8 a, const bf16x8 b) { const i32x4v x = __builtin_bit_cast(i32x4v, a), y = __builtin_bit_cast(i32x4v, b); return (i32x8v){x[0], x[1], x[2], x[3], y[0], y[1], y[2], y[3]}; }
template <class E, class = void> struct epi_perm16 { static constexpr bool value = false; };
template <class E> struct epi_perm16<E, decltype((void)E::PERM16)> { static constexpr bool value = E::PERM16; };
template <class Epi, class Sched, bool GATHER, bool FP8 = false, bool SP2 = true, bool ALIGN_EPI = true>
__device__ __forceinline__ void gemm_phase(LAS unsigned char* lds, const int kbytes, const unsigned ldA, const unsigned ldB, const Sched& S, const Epi& E, const LAS int* idxsrc) {
    const int tid = tid_fresh(), wid = __builtin_amdgcn_readfirstlane(tid >> 6), lane = tid & 63, wr = wid >> 2, wc = wid & 3, fr = lane & 15, fq = lane >> 4;
    int nt = kbytes / (BK * 2); asm volatile("" : "+s"(nt));
    unsigned voffA[2][2], voffBh[2][2];
#pragma unroll
    for (int i = 0; i < 2; ++i) { int R, C; stage_rc(tid * 16 + i * 8192, R, C); const int q = perm32(R & 31); const int Rb = Epi::PERM ? ((R & ~31) + q) : R;
        voffA[0][i] = (unsigned)R * ldA + (unsigned)C * 2u; voffA[1][i] = voffA[0][i];
        if constexpr (epi_perm16<Epi>::value) { const int rb0 = 64 * (R >> 5) + 16 * (q >> 3) + (q & 7); voffBh[0][i] = (unsigned)rb0 * ldB + (unsigned)C * 2u; voffBh[1][i] = (unsigned)(rb0 + 8) * ldB + (unsigned)C * 2u; }
        else { voffBh[0][i] = (unsigned)Rb * ldB + (unsigned)C * 2u; voffBh[1][i] = voffBh[0][i]; } }
    const size_t kstep = (size_t)(BK * 2);
    const unsigned ldsw = (unsigned)wid * 1024u;
    const unsigned lds0 = (unsigned)(__UINTPTR_TYPE__)lds;
    const int aoff = lds_byte(wr * 64 + fr, fq * 8), boff = lds_byte(wc * 32 + fr, fq * 8);
#define PG8_SA(b, h) (((b) * 2 + (h)) * HTB)
#define PG8_SB(b, h) ((4 + (b) * 2 + (h)) * HTB)
#define PG8_STAGE(bufoff, gbase, voff) do { _Pragma("unroll") for (int _i = 0; _i < 2; ++_i) glds16((const char*)(gbase), (voff)[_i], lds0 + (unsigned)(bufoff) + ldsw + _i * 8192u); } while (0)
#define PG8_LDA(dst, b, h) do { _Pragma("unroll") for (int m = 0; m < 4; ++m) _Pragma("unroll") for (int k = 0; k < 2; ++k) dst[m][k] = *(const LAS bf16x8*)(lds + PG8_SA(b, h) + aoff + m * 2048 + k * 1024); } while (0)
#define PG8_LDB(dst, b, h) do { _Pragma("unroll") for (int n = 0; n < 2; ++n) _Pragma("unroll") for (int k = 0; k < 2; ++k) dst[n][k] = *(const LAS bf16x8*)(lds + PG8_SB(b, h) + boff + n * 2048 + k * 1024); } while (0)
#define PG8_MMA(ai, bj, At, Bt) do { __builtin_amdgcn_s_setprio(1); _Pragma("unroll") for (int m = 0; m < 4; ++m) _Pragma("unroll") for (int n = 0; n < 2; ++n) { \
        if constexpr (FP8) { const i32x8v b8_ = cat8(Bt[n][0], Bt[n][1]), a8_ = cat8(At[m][0], At[m][1]); \
            asm volatile("s_nop 1\n\tv_mfma_scale_f32_16x16x128_f8f6f4 %0, %1, %2, %0, %3, %3 op_sel_hi:[0,0,0]" : "+v"(acc[ai][bj][m][n]) : "v"(b8_), "v"(a8_), "v"(fp8_unit_scale)); } \
        else { _Pragma("unroll") for (int k = 0; k < 2; ++k) acc[ai][bj][m][n] = __builtin_amdgcn_mfma_f32_16x16x32_bf16(Bt[n][k], At[m][k], acc[ai][bj][m][n], 0, 0, 0); } } \
        __builtin_amdgcn_s_setprio(0); } while (0)
#define PG8_WAIT_V(n) asm volatile("s_waitcnt vmcnt(" #n ")" ::: "memory")
#define PG8_WAIT_L(n) asm volatile("s_waitcnt lgkmcnt(" #n ")" ::: "memory")
#define PG8_BAR __builtin_amdgcn_s_barrier()
#define PG8_SCHED __builtin_amdgcn_sched_barrier(0)
#define PG8_VA(h) voffA[GATHER ? (h) : 0]
#define PG8_VB(h) voffBh[epi_perm16<Epi>::value ? (h) : 0]
    const int fp8_unit_scale = 0x7f7f7f7f;
    Unit cur, nxt; int ui = 0;
    if (!S.next(0, cur)) return;
    if constexpr (GATHER) {
#pragma unroll
        for (int h = 0; h < 2; ++h)
#pragma unroll
            for (int i = 0; i < 2; ++i) { int R, C; stage_rc(tid * 16 + i * 8192, R, C); voffA[h][i] = (unsigned)idxsrc[h * 128 + R] * ldA + (unsigned)C * 2u; }
    }
    f32x4 acc[2][2][4][2];
#pragma unroll
    for (int a = 0; a < 2; ++a)
#pragma unroll
        for (int b = 0; b < 2; ++b)
#pragma unroll
            for (int m = 0; m < 4; ++m)
#pragma unroll
                for (int n = 0; n < 2; ++n) acc[a][b][m][n] = (f32x4){0.f, 0.f, 0.f, 0.f};
    bf16x8 At[4][2], B0[2][2], B1[2][2];
    const char* cA = cur.A; const char* cB = cur.B; unsigned chA = cur.hsA, chB = cur.hsB;
    if constexpr (SP2) {
        PG8_STAGE(PG8_SB(0, 0), cB, PG8_VB(0)); PG8_STAGE(PG8_SB(0, 1), cB + chB, PG8_VB(1)); PG8_STAGE(PG8_SA(0, 0), cA, PG8_VA(0)); PG8_STAGE(PG8_SA(0, 1), cA + chA, PG8_VA(1));
        if (wr == 1) PG8_BAR;
        PG8_WAIT_V(2); PG8_BAR;
        PG8_STAGE(PG8_SB(1, 0), cB + kstep, PG8_VB(0)); PG8_STAGE(PG8_SA(1, 0), cA + kstep, PG8_VA(0)); PG8_STAGE(PG8_SB(1, 1), cB + chB + kstep, PG8_VB(1));
        PG8_WAIT_V(6); PG8_BAR;
    } else {
    PG8_STAGE(PG8_SB(0, 0), cB, PG8_VB(0)); PG8_STAGE(PG8_SA(0, 0), cA, PG8_VA(0)); PG8_STAGE(PG8_SB(0, 1), cB + chB, PG8_VB(1)); PG8_STAGE(PG8_SA(0, 1), cA + chA, PG8_VA(1));
    if (wr == 1) PG8_BAR;
    PG8_WAIT_V(4); PG8_BAR;
    PG8_STAGE(PG8_SB(1, 0), cB + kstep, PG8_VB(0)); PG8_STAGE(PG8_SA(1, 0), cA + kstep, PG8_VA(0)); PG8_STAGE(PG8_SB(1, 1), cB + chB + kstep, PG8_VB(1));
    PG8_WAIT_V(6); PG8_BAR;
    }
    for (;;) {
        const bool has_next = S.next(ui + 1, nxt);
        const char* nA = has_next ? nxt.A : cA; const char* nB = has_next ? nxt.B : cB; const unsigned nhA = has_next ? nxt.hsA : chA, nhB = has_next ? nxt.hsB : chB;
#pragma unroll 1
        for (int t = 0; t < nt; t += 2) {
            const bool last = (t == nt - 2);
            const char* a1 = cA + (size_t)(t + 1) * kstep;
            const char* a2 = last ? nA : cA + (size_t)(t + 2) * kstep; const char* b2 = last ? nB : cB + (size_t)(t + 2) * kstep;
            const unsigned hA2 = last ? nhA : chA, hB2 = last ? nhB : chB;
            const char* a3 = a2 + kstep; const char* b3 = b2 + kstep;
            const bool sw = GATHER && last && has_next;
            int gi[2][2];
            if constexpr (SP2) {
            PG8_LDB(B0, 0, 0); PG8_LDB(B1, 0, 1); PG8_SCHED; PG8_LDA(At, 0, 0); PG8_STAGE(PG8_SA(1, 1), a1 + chA, PG8_VA(1));
            PG8_WAIT_V(8); PG8_WAIT_L(0); PG8_BAR; PG8_MMA(0, 0, At, B0); PG8_MMA(0, 1, At, B1); PG8_BAR; PG8_SCHED;
            if constexpr (GATHER) { if (sw) {
#pragma unroll
                for (int h = 0; h < 2; ++h)
#pragma unroll
                    for (int i = 0; i < 2; ++i) { int R, C; stage_rc(tid * 16 + i * 8192, R, C); gi[h][i] = idxsrc[(ui + 1) * 256 + h * 128 + R]; } } }
            PG8_LDA(At, 0, 1); PG8_STAGE(PG8_SB(0, 0), b2, PG8_VB(0)); PG8_STAGE(PG8_SB(0, 1), b2 + hB2, PG8_VB(1));
            if constexpr (GATHER) { if (sw) {
#pragma unroll
                for (int h = 0; h < 2; ++h)
#pragma unroll
                    for (int i = 0; i < 2; ++i) { int R, C; stage_rc(tid * 16 + i * 8192, R, C); voffA[h][i] = (unsigned)gi[h][i] * ldA + (unsigned)C * 2u; } } }
            PG8_STAGE(PG8_SA(0, 0), a2, PG8_VA(0));
            PG8_WAIT_V(8); PG8_WAIT_L(0); PG8_BAR; PG8_MMA(1, 0, At, B0); PG8_MMA(1, 1, At, B1); PG8_BAR; PG8_SCHED;
            PG8_LDB(B0, 1, 0); PG8_LDB(B1, 1, 1); PG8_SCHED; PG8_LDA(At, 1, 0); PG8_STAGE(PG8_SA(0, 1), a2 + hA2, PG8_VA(1));
            PG8_WAIT_V(8); PG8_WAIT_L(0); PG8_BAR; PG8_MMA(0, 0, At, B0); PG8_MMA(0, 1, At, B1); PG8_BAR; PG8_SCHED;
            PG8_LDA(At, 1, 1); PG8_STAGE(PG8_SB(1, 0), b3, PG8_VB(0)); PG8_STAGE(PG8_SB(1, 1), b3 + hB2, PG8_VB(1)); PG8_STAGE(PG8_SA(1, 0), a3, PG8_VA(0));
            PG8_WAIT_V(8); PG8_WAIT_L(0); PG8_BAR; PG8_MMA(1, 0, At, B0); PG8_MMA(1, 1, At, B1); PG8_BAR; PG8_SCHED;
            } else {
            PG8_LDB(B0, 0, 0); PG8_SCHED; PG8_LDA(At, 0, 0); PG8_STAGE(PG8_SA(1, 1), a1 + chA, PG8_VA(1));
            PG8_WAIT_L(8); PG8_BAR; PG8_WAIT_L(0); PG8_MMA(0, 0, At, B0); PG8_BAR; PG8_SCHED;
            if constexpr (GATHER) { if (sw) {
#pragma unroll
                for (int h = 0; h < 2; ++h)
#pragma unroll
                    for (int i = 0; i < 2; ++i) { int R, C; stage_rc(tid * 16 + i * 8192, R, C); gi[h][i] = idxsrc[(ui + 1) * 256 + h * 128 + R]; } } }
            PG8_LDB(B1, 0, 1); PG8_STAGE(PG8_SB(0, 0), b2, PG8_VB(0));
            PG8_BAR; PG8_WAIT_L(0); PG8_MMA(0, 1, At, B1); PG8_BAR;
            if constexpr (GATHER) { if (sw) {
#pragma unroll
                for (int h = 0; h < 2; ++h)
#pragma unroll
                    for (int i = 0; i < 2; ++i) { int R, C; stage_rc(tid * 16 + i * 8192, R, C); voffA[h][i] = (unsigned)gi[h][i] * ldA + (unsigned)C * 2u; } } }
            PG8_LDA(At, 0, 1); PG8_STAGE(PG8_SA(0, 0), a2, PG8_VA(0));
            PG8_BAR; PG8_WAIT_L(0); PG8_MMA(1, 0, At, B0); PG8_BAR; PG8_SCHED;
            PG8_STAGE(PG8_SB(0, 1), b2 + hB2, PG8_VB(1));
            PG8_WAIT_V(6); PG8_BAR; PG8_MMA(1, 1, At, B1); PG8_BAR;
            PG8_LDB(B0, 1, 0); PG8_SCHED; PG8_LDA(At, 1, 0); PG8_STAGE(PG8_SA(0, 1), a2 + hA2, PG8_VA(1));
            PG8_WAIT_L(8); PG8_BAR; PG8_WAIT_L(0); PG8_MMA(0, 0, At, B0); PG8_BAR; PG8_SCHED;
            PG8_LDB(B1, 1, 1); PG8_STAGE(PG8_SB(1, 0), b3, PG8_VB(0));
            PG8_BAR; PG8_WAIT_L(0); PG8_MMA(0, 1, At, B1); PG8_BAR;
            PG8_LDA(At, 1, 1); PG8_STAGE(PG8_SA(1, 0), a3, PG8_VA(0));
            PG8_BAR; PG8_WAIT_L(0); PG8_MMA(1, 0, At, B0); PG8_BAR; PG8_SCHED;
            PG8_STAGE(PG8_SB(1, 1), b3 + hB2, PG8_VB(1));
            PG8_WAIT_V(6); PG8_BAR; PG8_MMA(1, 1, At, B1); PG8_BAR;
            }
        }
        if constexpr (ALIGN_EPI) { if (wr == 0) PG8_BAR; }
        if constexpr (FP8) asm volatile("s_nop 15\n\ts_nop 15" ::: "memory");
        E(acc, cur, ui, wr, wc, fr, fq);
        if (!has_next) break;
#pragma unroll
        for (int a = 0; a < 2; ++a)
#pragma unroll
            for (int b = 0; b < 2; ++b)
#pragma unroll
                for (int m = 0; m < 4; ++m)
#pragma unroll
                    for (int n = 0; n < 2; ++n) acc[a][b][m][n] = (f32x4){0.f, 0.f, 0.f, 0.f};
        cur = nxt; cA = nA; cB = nB; chA = nhA; chB = nhB; ++ui;
        if constexpr (ALIGN_EPI) { if (wr == 1) PG8_BAR; }
    }
    PG8_WAIT_V(0);
    if constexpr (!ALIGN_EPI) { if (wr == 0) PG8_BAR; }
    PG8_BAR;
#undef PG8_SA
#undef PG8_SB
#undef PG8_STAGE
#undef PG8_LDA
#undef PG8_LDB
#undef PG8_MMA
#undef PG8_WAIT_V
#undef PG8_WAIT_L
#undef PG8_BAR
#undef PG8_SCHED
#undef PG8_VA
#undef PG8_VB
}
}
using gm::Unit;

struct Params { const float* in[13]; float* out; unsigned char* ws; int ph_lo, ph_hi; };

struct SchedPlain {
    gm::GridOrder o; const char* A; const char* B; unsigned ldA, ldB; bool p16 = false;
    __device__ __forceinline__ bool next(int i, Unit& u) const { int pm, pn; if (!o.mn(i, pm, pn)) return false;
        u.pm = pm; u.pn = pn; u.x0 = 0; u.x1 = 0; u.A = A + (size_t)pm * 256 * ldA; u.hsA = 128u * ldA; u.B = B + (size_t)pn * 256 * ldB; u.hsB = p16 ? 0u : 128u * ldB; return true; }
};
struct SchedG1 {
    gm::GridOrder o; const char* WinT; const char* xb;
    __device__ __forceinline__ bool next(int i, Unit& u) const { int pm, pn; if (!o.mn(i, pm, pn)) return false;
        const int b = pn >> 5, j = pn & 31; u.pm = pm; u.pn = pn; u.x0 = b; u.x1 = j;
        u.A = WinT + (size_t)pm * 256 * 1024; u.hsA = 128u * 1024u; u.B = xb + ((size_t)(b * SEQ + 2 * j)) * 1024; u.hsB = 1024u; return true; }
};
struct SchedS1 {
    int G, c; const char* F1; const char* Ut;
    __device__ __forceinline__ bool next(int i, Unit& u) const { const int L = i * G + c; if (L >= 1024) return false;
        u.pm = 0; u.pn = L; u.x0 = 0; u.x1 = 0; u.A = F1; u.hsA = 128u * 256u; u.B = Ut + (size_t)L * 256 * 256; u.hsB = 128u * 256u; return true; }
};
struct SchedS2 {
    gm::GridOrder o; const char* F2; const char* A1;
    __device__ __forceinline__ bool next(int i, Unit& u) const { int pm, pn; if (!o.mn(i, pm, pn)) return false;
        const int g = pm, b = pn >> 2, ct = pn & 3; u.pm = g; u.pn = ct; u.x0 = b; u.x1 = g;
        u.A = F2 + (size_t)g * 256 * 256; u.hsA = 128u * 256u; u.B = A1 + ((size_t)((b * 64 + g) * 1024 + ct * 256)) * 256; u.hsB = 0u; return true; }
};
__device__ __forceinline__ int expert_of_tile(const LAS int* ts, int pm) {
    const int ln = (int)__builtin_amdgcn_mbcnt_hi(~0u, __builtin_amdgcn_mbcnt_lo(~0u, 0u));
    const int v = ts[ln & 31];
    return (int)__builtin_popcountll(__ballot((ln >= 1) && (ln < 32) && (v <= pm)));
}
struct SchedMoe {
    gm::GridOrder o; const LAS int* ts; const char* A; const char* W; size_t wstride; unsigned ldB; bool hsB128; unsigned tileA;
    __device__ __forceinline__ bool next(int i, Unit& u) const { int pm, pn; if (!o.mn(i, pm, pn)) return false;
        const int e = expert_of_tile(ts, pm);
        u.pm = pm; u.pn = pn; u.x0 = e; u.x1 = pm - ts[e]; u.A = A + (size_t)pm * tileA; u.hsA = tileA >> 1; u.B = W + (size_t)e * wstride + (size_t)pn * 256 * ldB; u.hsB = hsB128 ? 128u * ldB : 0u; return true; }
};

typedef f32x4 Acc[2][2][4][2];
struct EpiRow {
    static constexpr bool PERM = true;
    bf16_t* O; size_t ld; int split_tiles; size_t split_stride; float scale0, scale1;
    __device__ __forceinline__ void operator()(const Acc& acc, const Unit& u, int, int wr, int wc, int fr, int fq) const {
        int pn = u.pn; bf16_t* base = O; float sc = scale0;
        if (split_tiles) { const int t = pn / split_tiles; base += (size_t)t * split_stride; pn -= t * split_tiles; if (t != 0) sc = scale1; }
        const size_t row0 = (size_t)u.pm * 256 + wr * 64 + fr; const int col0 = pn * 256 + wc * 32 + 8 * fq;
#pragma unroll
        for (int ai = 0; ai < 2; ++ai)
#pragma unroll
            for (int m = 0; m < 4; ++m) { bf16_t* rowp = base + (row0 + ai * 128 + m * 16) * ld + col0;
#pragma unroll
                for (int bj = 0; bj < 2; ++bj) *(u32x4*)(rowp + bj * 128) = pack8(acc[ai][bj][m][0] * sc, acc[ai][bj][m][1] * sc); }
    }
};
struct EpiRow8 {
    static constexpr bool PERM = true, PERM16 = true;
    unsigned char* O; size_t ld; int split_tiles; size_t split_stride; float scale0, scale1;
    __device__ __forceinline__ void operator()(const Acc& acc, const Unit& u, int, int wr, int wc, int fr, int fq) const {
        int pn = u.pn; unsigned char* base = O; float sc = scale0;
        if (split_tiles) { const int t = pn / split_tiles; base += (size_t)t * split_stride; pn -= t * split_tiles; if (t != 0) sc = scale1; }
        const size_t row0 = (size_t)u.pm * 256 + wr * 64 + fr; const int col0 = pn * 256 + wc * 64 + 16 * fq;
#pragma unroll
        for (int ai = 0; ai < 2; ++ai)
#pragma unroll
            for (int m = 0; m < 4; ++m) { u32x4 w;
                { const f32x4 v = acc[ai][0][m][0] * sc; w.x = pk4_fp8(v[0], v[1], v[2], v[3]); } { const f32x4 v = acc[ai][0][m][1] * sc; w.y = pk4_fp8(v[0], v[1], v[2], v[3]); }
                { const f32x4 v = acc[ai][1][m][0] * sc; w.z = pk4_fp8(v[0], v[1], v[2], v[3]); } { const f32x4 v = acc[ai][1][m][1] * sc; w.w = pk4_fp8(v[0], v[1], v[2], v[3]); }
                *(u32x4*)(base + (row0 + ai * 128 + m * 16) * ld + col0) = w; }
    }
};
struct EpiG1 {
    static constexpr bool PERM = true;
    bf16_t* Ut; float sc;
    __device__ __forceinline__ void operator()(const Acc& acc, const Unit& u, int, int wr, int wc, int fr, int fq) const {
#pragma unroll
        for (int ai = 0; ai < 2; ++ai)
#pragma unroll
            for (int m = 0; m < 4; ++m) { const int c = u.pm * 256 + ai * 128 + wr * 64 + m * 16 + fr;
#pragma unroll
                for (int bj = 0; bj < 2; ++bj) { const int s2 = 2 * u.x1 + bj;
                    *(u32x4*)(Ut + (((size_t)(u.x0 * 1024 + c) * 64 + s2) * 128 + wc * 32 + 8 * fq)) = pack8(acc[ai][bj][m][0] * sc, acc[ai][bj][m][1] * sc); } }
    }
};
struct EpiS1 {
    static constexpr bool PERM = true;
    bf16_t* A1;
    __device__ __forceinline__ void operator()(const Acc& acc, const Unit& u, int, int wr, int wc, int fr, int fq) const {
#pragma unroll
        for (int m = 0; m < 4; ++m) { const int m1 = wr * 64 + m * 16 + fr, g = m1 >> 1, ri = m1 & 1;
#pragma unroll
            for (int bj = 0; bj < 2; ++bj) { const int nrow = u.pn * 256 + bj * 128 + wc * 32 + 8 * fq, s2 = nrow & 63, c = (nrow >> 6) & 1023, b = nrow >> 16;
                *(u32x4*)(A1 + ((size_t)((b * 64 + g) * 1024 + c) * 128 + ri * 64 + s2)) = pack8(acc[0][bj][m][0], acc[0][bj][m][1]); } }
    }
};
struct EpiS2 {
    static constexpr bool PERM = true, PERM16 = true;
    unsigned char* Y;
    __device__ __forceinline__ void operator()(const Acc& acc, const Unit& u, int, int wr, int wc, int fr, int fq) const {
        const int g = u.x1, b = u.x0;
#pragma unroll
        for (int ai = 0; ai < 2; ++ai)
#pragma unroll
            for (int m = 0; m < 4; ++m) { const int mm = wr * 64 + m * 16 + fr, k2 = mm >> 1, rip = mm & 1;
                const int k1 = ai ? (g ? 128 - g : 64) : g, k = k1 + 128 * k2;
                { const int c = u.pn * 256 + wc * 64 + 16 * fq; u32x4 w;
                    { const f32x4 v = acc[ai][0][m][0] * Y_SCALE; w.x = pk4_fp8(v[0], v[1], v[2], v[3]); } { const f32x4 v = acc[ai][0][m][1] * Y_SCALE; w.y = pk4_fp8(v[0], v[1], v[2], v[3]); }
                    { const f32x4 v = acc[ai][1][m][0] * Y_SCALE; w.z = pk4_fp8(v[0], v[1], v[2], v[3]); } { const f32x4 v = acc[ai][1][m][1] * Y_SCALE; w.w = pk4_fp8(v[0], v[1], v[2], v[3]); }
                    *(u32x4*)(Y + ((size_t)(b * SEQ + k) * 2048 + rip * 1024 + c)) = w; } }
    }
};
struct EpiGU {
    static constexpr bool PERM = true;
    unsigned char* Hb; const LAS int* idxdst;
    __device__ __forceinline__ void operator()(const Acc& acc, const Unit& u, int ui, int wr, int wc, int fr, int fq) const {
#pragma unroll
        for (int ai = 0; ai < 2; ++ai)
#pragma unroll
            for (int m = 0; m < 4; ++m) { const int a = idxdst[ui * 256 + ai * 128 + wr * 64 + m * 16 + fr];
                if (a >= 0) { f32x4 h0, h1;
#pragma unroll
                    for (int j = 0; j < 4; ++j) { h0[j] = silu_mul(acc[ai][0][m][0][j] * (1.0f / W_SCALE), acc[ai][1][m][0][j] * (H_SCALE / W_SCALE)); h1[j] = silu_mul(acc[ai][0][m][1][j] * (1.0f / W_SCALE), acc[ai][1][m][1][j] * (H_SCALE / W_SCALE)); }
                    u32x2 w; w.x = pk4_fp8(h0[0], h0[1], h0[2], h0[3]); w.y = pk4_fp8(h1[0], h1[1], h1[2], h1[3]);
                    *(u32x2*)(Hb + ((size_t)(u.pm * 256 + ai * 128 + wr * 64 + m * 16 + fr) * DEX + u.pn * 128 + wc * 32 + 8 * fq)) = w; } }
    }
};
struct EpiDown {
    static constexpr bool PERM = true, PERM16 = true;
    unsigned char* ys; const LAS int* idxdst;
    __device__ __forceinline__ void operator()(const Acc& acc, const Unit& u, int ui, int wr, int wc, int fr, int fq) const {
#pragma unroll
        for (int ai = 0; ai < 2; ++ai)
#pragma unroll
            for (int m = 0; m < 4; ++m) { const int a = idxdst[ui * 256 + ai * 128 + wr * 64 + m * 16 + fr];
                if (a >= 0) { constexpr float sc = YS_SCALE / (W_SCALE * H_SCALE); u32x4 w;
                    { const f32x4 v = acc[ai][0][m][0] * sc; w.x = pk4_fp8(v[0], v[1], v[2], v[3]); } { const f32x4 v = acc[ai][0][m][1] * sc; w.y = pk4_fp8(v[0], v[1], v[2], v[3]); }
                    { const f32x4 v = acc[ai][1][m][0] * sc; w.z = pk4_fp8(v[0], v[1], v[2], v[3]); } { const f32x4 v = acc[ai][1][m][1] * sc; w.w = pk4_fp8(v[0], v[1], v[2], v[3]); }
                    *(u32x4*)(ys + ((size_t)a * DM + u.pn * 256 + wc * 64 + 16 * fq)) = w; } }
    }
};

struct TileDesc { const float* src; unsigned char* dst; int C, r0, c0, dld, kind; };
__device__ __forceinline__ TileDesc tile_desc(const Params& p, int tt) {
    TileDesc d; d.kind = 3; unsigned char* ws = p.ws;
    if (tt < 256) { d.src = p.in[1]; d.C = 1024; d.r0 = (tt >> 5) * 128; d.c0 = (tt & 31) * 32; d.dst = ws + WS_WIN; d.dld = 1024; }
    else if (tt < 1024) { const int t2 = tt - 256; d.src = p.in[3]; d.C = 3072; d.r0 = (t2 / 96) * 128; d.c0 = (t2 % 96) * 32; d.dst = ws + WS_WQKV; d.dld = 1024; }
    else if (tt < 1280) { const int t2 = tt - 1024; d.src = p.in[5]; d.C = 1024; d.r0 = (t2 >> 5) * 128; d.c0 = (t2 & 31) * 32; d.dst = ws + WS_WO; d.dld = 1024; }
    else { const int t3 = tt - 1280, ee = t3 >> 7, tl = t3 & 127, mat = ee & 63; d.kind = ee >> 6;
        if (d.kind < 2) { d.src = (d.kind == 0 ? p.in[8] : p.in[9]) + (size_t)mat * 1024 * 512; d.C = 512; d.r0 = (tl >> 4) * 128; d.c0 = (tl & 15) * 32; d.dst = ws + WS_WGU + (size_t)mat * 1024 * 1024; d.dld = 1024; }
        else { d.src = p.in[10] + (size_t)mat * 512 * 1024; d.C = 1024; d.r0 = (tl >> 5) * 128; d.c0 = (tl & 31) * 32; d.dst = ws + WS_WD + (size_t)mat * 1024 * 512; d.dld = 512; } }
    return d;
}
__device__ __forceinline__ void tile_load(const TileDesc& d, f32x4 (&v)[16], int lane) {
#pragma unroll
    for (int ps = 0; ps < 16; ++ps) v[ps] = *(const f32x4*)(d.src + (size_t)(d.r0 + ps * 8 + (lane >> 3)) * d.C + d.c0 + (lane & 7) * 4);
}
__device__ __forceinline__ void tile_store(const TileDesc& d, const f32x4 (&v)[16], LAS float* tile, int lane) {
#pragma unroll
    for (int ps = 0; ps < 16; ++ps) { const int row = ps * 8 + (lane >> 3), col4 = (lane & 7) * 4;
        tile[row * 33 + col4 + 0] = v[ps][0]; tile[row * 33 + col4 + 1] = v[ps][1]; tile[row * 33 + col4 + 2] = v[ps][2]; tile[row * 33 + col4 + 3] = v[ps][3]; }
    __builtin_amdgcn_fence(__ATOMIC_RELEASE, "wavefront"); __builtin_amdgcn_wave_barrier(); __builtin_amdgcn_fence(__ATOMIC_ACQUIRE, "wavefront");
#pragma unroll
    for (int ps = 0; ps < 4; ++ps) { const int n = ps * 8 + (lane >> 3), kc = (lane & 7) * 16; float a[16];
#pragma unroll
        for (int j = 0; j < 16; ++j) a[j] = tile[(kc + j) * 33 + n] * W_SCALE;
        const int nn = d.c0 + n; const int drow = (d.kind == 0 || d.kind == 1) ? (256 * (nn >> 7) + (nn & 127) + 128 * d.kind) : nn;
        u32x4 w; w.x = pk4_fp8(a[0], a[1], a[2], a[3]); w.y = pk4_fp8(a[4], a[5], a[6], a[7]); w.z = pk4_fp8(a[8], a[9], a[10], a[11]); w.w = pk4_fp8(a[12], a[13], a[14], a[15]);
        *(u32x4*)(d.dst + (size_t)drow * d.dld + d.r0 + kc) = w; }
    __builtin_amdgcn_fence(__ATOMIC_RELEASE, "wavefront"); __builtin_amdgcn_wave_barrier(); __builtin_amdgcn_fence(__ATOMIC_ACQUIRE, "wavefront");
}

__device__ __forceinline__ void transpose_share(const Params& p, LAS unsigned char* lds, int wid, int lane, int nslot, int slot0) {
    LAS float* tile = (LAS float*)lds + wid * (128 * 33); constexpr int NT = 1280 + 192 * 128; const int G = gridDim.x;
    for (int rnd = 0; (rnd * G) * 22 < NT; ++rnd) { const int base = (rnd * G + (int)blockIdx.x) * 22 + slot0;
        const int t0 = base, t1 = base + 1, t2 = base + 2;
        if (t0 < NT) { const bool two = t1 < NT; const TileDesc d0 = tile_desc(p, t0), d1 = tile_desc(p, two ? t1 : t0);
            f32x4 v0[16], v1[16]; tile_load(d0, v0, lane); tile_load(d1, v1, lane);
            tile_store(d0, v0, tile, lane); if (two) tile_store(d1, v1, tile, lane); }
        if (nslot > 2 && t2 < NT) { const TileDesc d2 = tile_desc(p, t2); f32x4 v2[16]; tile_load(d2, v2, lane); tile_store(d2, v2, tile, lane); } }
}
__device__ __forceinline__ void phase_prologue(const Params& p, LAS unsigned char* lds) {
    const int tid = tid_fresh(), lane = tid & 63, wid = __builtin_amdgcn_readfirstlane(tid >> 6); unsigned char* ws = p.ws;
    if (wid < 6) {
        { const float* x = p.in[0]; unsigned char* xb = (unsigned char*)(ws + WS_S0); bf16_t* xh = (bf16_t*)p.out; const size_t stride = (size_t)gridDim.x * 384 * 8, total = (size_t)T * DM;
          for (size_t i = ((size_t)blockIdx.x * 384 + tid) * 8; i < total; i += 4 * stride) {
              f32x4 a[4], b[4];
#pragma unroll
              for (int u = 0; u < 4; ++u) { const size_t o = i + u * stride < total ? i + u * stride : i; a[u] = *(const f32x4*)(x + o); b[u] = *(const f32x4*)(x + o + 4); }
#pragma unroll
              for (int u = 0; u < 4; ++u) if (i + u * stride < total) { u32x2 w; w.x = pk4_fp8(a[u][0], a[u][1], a[u][2], a[u][3]); w.y = pk4_fp8(b[u][0], b[u][1], b[u][2], b[u][3]); *(u32x2*)(xb + i + u * stride) = w;
                  *(u32x4*)(xh + i + u * stride) = pack8(a[u], b[u]); } } }
        transpose_share(p, lds, wid, lane, 3, 3 * wid);
    } else {
        const int gw = blockIdx.x * 2 + (wid - 6), gl = gw * 64 + lane;
        { bf16_t* F1 = (bf16_t*)(ws + WS_F1); bf16_t* F2 = (bf16_t*)(ws + WS_F2);
          { const int idx = gl; const int m1 = idx >> 7, s1 = idx & 127; float v = 0.f;
            if (m1 < 128) { const int g = m1 >> 1, ri = m1 & 1;
                if (g == 0) v = ri ? ((s1 & 1) ? -1.f : 1.f) : 1.f;
                else { const float ph = (float)((s1 * g) & 127) * (1.0f / 128.0f); v = ri ? -__builtin_amdgcn_sinf(ph) : __builtin_amdgcn_cosf(ph); } }
            F1[idx] = (bf16_t)(cvt_pk_bf16(v, 0.f) & 0xffffu); }
          const float sc = 0.011048543456039806f;
          for (int idx = gl; idx < 64 * 256 * 128; idx += 32768) { const int g = idx >> 15, m2 = (idx >> 7) & 255, kk = idx & 127;
              const int hsel = m2 >> 7, k2 = (m2 & 127) >> 1, rip = m2 & 1, slot = kk >> 6, s2 = kk & 63;
              const int k1 = hsel ? (g ? 128 - g : 64) : g, k = k1 + 128 * k2;
              const float ph = (float)((s2 * k) & 8191) * (1.0f / 8192.0f); const float cs = __builtin_amdgcn_cosf(ph), sn = __builtin_amdgcn_sinf(ph);
              float v;
              if (g == 0) { v = (slot == hsel) ? (rip ? -sn : cs) : 0.f; }
              else if (hsel == 0) { v = rip ? (slot ? cs : -sn) : (slot ? sn : cs); }
              else { v = rip ? (slot ? -cs : -sn) : (slot ? -sn : cs); }
              F2[idx] = (bf16_t)(cvt_pk_bf16(v * sc, 0.f) & 0xffffu); } }
        { LAS float* ctab = (LAS float*)(lds + 135168) + (wid - 6) * 512; LAS float* stab = ctab + 256; const float* wout = p.in[2]; unsigned char* W2 = (unsigned char*)(ws + WS_W2);
#pragma unroll
          for (int u = 0; u < 4; ++u) { const float ph = (float)(lane + 64 * u) * (1.0f / 256.0f); ctab[lane + 64 * u] = __builtin_amdgcn_cosf(ph); stab[lane + 64 * u] = __builtin_amdgcn_sinf(ph); }
          __builtin_amdgcn_fence(__ATOMIC_RELEASE, "wavefront"); __builtin_amdgcn_wave_barrier(); __builtin_amdgcn_fence(__ATOMIC_ACQUIRE, "wavefront");
          for (int item = gw; item < 4 * 4 * 64; item += 512) { const int gp = item >> 8, cq = (item >> 6) & 3, n0 = (item & 63) * 16, c = cq * 64 + lane;
              float ac[16], as[16];
#pragma unroll
              for (int j = 0; j < 16; ++j) { ac[j] = 0.f; as[j] = 0.f; }
              const float* wrow = wout + (size_t)(gp * 256) * 1024 + n0 + (lane & 15);
#pragma unroll 4
              for (int k2 = 0; k2 < 256; ++k2) { const int ix = (c * k2) & 255; const float cv = ctab[ix], sv = stab[ix]; const float wv = wrow[(size_t)k2 * 1024];
#pragma unroll
                  for (int j = 0; j < 16; ++j) { const float w = __builtin_bit_cast(float, __builtin_amdgcn_readlane(__builtin_bit_cast(int, wv), j)); ac[j] += cv * w; as[j] += sv * w; } }
#pragma unroll
              for (int j = 0; j < 16; ++j) { unsigned char* o = W2 + (size_t)(n0 + j) * 2048 + gp * 256 + c;
                  o[0] = (unsigned char)(pk4_fp8(ac[j] * (0.0625f * W2_SCALE), 0.f, 0.f, 0.f) & 0xffu); o[1024] = (unsigned char)(pk4_fp8(as[j] * (0.0625f * W2_SCALE), 0.f, 0.f, 0.f) & 0xffu); } } }
        transpose_share(p, lds, wid, lane, 2, 18 + 2 * (wid - 6));
    }
    __syncthreads();
}

typedef _Float16 f16x8 __attribute__((ext_vector_type(8)));
typedef _Float16 f16x4 __attribute__((ext_vector_type(4)));
constexpr int LA_HT = 0, LA_RED = 65536, LA_SEL = 65536 + 32768, LA_ASG = LA_SEL + 8192, LA_MISC = LA_ASG + 1024;
__device__ __forceinline__ void phase_lnA(const Params& p, LAS unsigned char* lds, const int L, const bf16_t* res16, const bf16_t* ybuf, bf16_t* hb, unsigned char* h8) {
    const int tid = tid_fresh(), lane = tid & 63, wid = __builtin_amdgcn_readfirstlane(tid >> 6), fr = lane & 15, fq = lane >> 4;
    unsigned char* ws = p.ws;
    LAS unsigned char* ht = lds + LA_HT;
    LAS float* red = (LAS float*)(lds + LA_RED);
    LAS float* selL = (LAS float*)(lds + LA_SEL);
    LAS int* asgE = (LAS int*)(lds + LA_ASG);
    LAS int* misc = (LAS int*)(lds + LA_MISC);
    f16x8 wf[2][4];
    { const float* wrg = p.in[6];
#pragma unroll
      for (int eb = 0; eb < 2; ++eb)
#pragma unroll
          for (int sx = 0; sx < 4; ++sx)
#pragma unroll
              for (int j = 0; j < 8; ++j) wf[eb][sx][j] = (_Float16)wrg[(size_t)(128 * wid + 32 * sx + 8 * fq + j) * 32 + fr + 16 * eb]; }
    const float* lg = p.in[11] + (L * 2 + 0) * 1024; const float* lb = p.in[12] + (L * 2 + 0) * 1024;
    f32x4 gv[4], bv[4];
#pragma unroll
    for (int k = 0; k < 4; ++k) { gv[k] = *(const f32x4*)(lg + 512 * (k >> 1) + 8 * lane + 4 * (k & 1)); bv[k] = *(const f32x4*)(lb + 512 * (k >> 1) + 8 * lane + 4 * (k & 1)); }
    const float br = p.in[7][tid & 31];
    float* gates = (float*)(ws + WS_GATE);
    const int tok0 = blockIdx.x * 128;
#ifndef LNA_REP
#define LNA_REP 1
#endif
    u32x4 rx16[4][2], ryw[4][2];
#define LA_LOAD(gg) do { _Pragma("unroll") for (int tk = 0; tk < 4; ++tk) { const size_t rowo_ = (size_t)(tok0 + (gg) * 32 + 4 * wid + tk) * DM; _Pragma("unroll") for (int jj = 0; jj < 2; ++jj) { const size_t co_ = rowo_ + 512 * jj + 8 * lane; \
        rx16[tk][jj] = *(const u32x4*)(res16 + co_); ryw[tk][jj] = *(const u32x4*)(ybuf + co_); } } } while (0)
    LA_LOAD(0);
#pragma unroll 1
    for (int g_ = 0; g_ < 4 * LNA_REP; ++g_) { const int g = g_ & 3;
        f32x4 hv[4][4];
#pragma unroll
        for (int tk = 0; tk < 4; ++tk) {
#pragma unroll
            for (int jj = 0; jj < 2; ++jj) { f32x4 xa, xb2, ya, yb; bf8_to_f32(rx16[tk][jj], xa, xb2); bf8_to_f32(ryw[tk][jj], ya, yb);
                hv[tk][2 * jj] = ALPHA * xa + ya; hv[tk][2 * jj + 1] = ALPHA * xb2 + yb; } }
        float sm[4], qv[4];
#pragma unroll
        for (int tk = 0; tk < 4; ++tk) { float s = 0.f;
#pragma unroll
            for (int j = 0; j < 4; ++j) s += (hv[tk][j][0] + hv[tk][j][1]) + (hv[tk][j][2] + hv[tk][j][3]);
            sm[tk] = s; }
#pragma unroll
        for (int o = 32; o >= 1; o >>= 1) {
#pragma unroll
            for (int tk = 0; tk < 4; ++tk) sm[tk] += __shfl_xor(sm[tk], o); }
#pragma unroll
        for (int tk = 0; tk < 4; ++tk) { sm[tk] *= (1.0f / 1024.0f); float q = 0.f;
#pragma unroll
            for (int j = 0; j < 4; ++j) { const f32x4 d = hv[tk][j] - sm[tk]; q += (d[0] * d[0] + d[1] * d[1]) + (d[2] * d[2] + d[3] * d[3]); }
            qv[tk] = q; }
#pragma unroll
        for (int o = 32; o >= 1; o >>= 1) {
#pragma unroll
            for (int tk = 0; tk < 4; ++tk) qv[tk] += __shfl_xor(qv[tk], o); }
#pragma unroll
        for (int tk = 0; tk < 4; ++tk) { const int ts = 4 * wid + tk; const size_t rowo = (size_t)(tok0 + g * 32 + ts) * DM; const float rstd = 1.0f / sqrtf(qv[tk] * (1.0f / 1024.0f) + LN_EPS);
#pragma unroll
            for (int jj = 0; jj < 2; ++jj) { const size_t co = rowo + 512 * jj + 8 * lane;
                const f32x4 h0 = (hv[tk][2 * jj] - sm[tk]) * rstd * gv[2 * jj] + bv[2 * jj], h1 = (hv[tk][2 * jj + 1] - sm[tk]) * rstd * gv[2 * jj + 1] + bv[2 * jj + 1];
                *(u32x4*)(hb + co) = pack8(h0, h1);
                u32x2 w8; w8.x = pk4_fp8(h0[0], h0[1], h0[2], h0[3]); w8.y = pk4_fp8(h1[0], h1[1], h1[2], h1[3]); *(u32x2*)(h8 + co) = w8;
                const f16x8 hh = (f16x8){(_Float16)h0[0], (_Float16)h0[1], (_Float16)h0[2], (_Float16)h0[3], (_Float16)h1[0], (_Float16)h1[1], (_Float16)h1[2], (_Float16)h1[3]};
                const int chunk = (64 * jj + lane) ^ (ts & 15);
                *(LAS f16x8*)(ht + ts * 2048 + chunk * 16) = hh; } }
        if (g_ + 1 < 4 * LNA_REP) LA_LOAD((g_ + 1) & 3);
        __syncthreads();
#pragma unroll
        for (int tb = 0; tb < 2; ++tb) { f32x4 d0 = (f32x4){0.f, 0.f, 0.f, 0.f}, d1 = d0;
#pragma unroll
          for (int sx = 0; sx < 4; ++sx) { const int chunk = (16 * wid + 4 * sx + fq) ^ fr; const f16x8 hf = *(const LAS f16x8*)(ht + (16 * tb + fr) * 2048 + chunk * 16);
              d0 = __builtin_amdgcn_mfma_f32_16x16x32_f16(wf[0][sx], hf, d0, 0, 0, 0); d1 = __builtin_amdgcn_mfma_f32_16x16x32_f16(wf[1][sx], hf, d1, 0, 0, 0); }
          *(LAS f32x4*)(red + wid * 1024 + (16 * tb + fr) * 32 + 4 * fq) = d0; *(LAS f32x4*)(red + wid * 1024 + (16 * tb + fr) * 32 + 16 + 4 * fq) = d1; }
        __syncthreads();
#pragma unroll
        for (int u = 0; u < 2; ++u) { const int ix = tid + 512 * u; float lgt = 0.f;
#pragma unroll
          for (int w = 0; w < 8; ++w) lgt += red[w * 1024 + ix];
          const float sc = 1.0f / (1.0f + __expf(-lgt)); selL[ix] = sc + br; selL[1024 + ix] = sc; }
        __syncthreads();
        if (lane < 4) { const int tq = 4 * wid + lane; const LAS f32x4* sel4 = (const LAS f32x4*)(selL + tq * 32); float best = -3.0e38f; int bg = 0, b1 = 0, b2 = 0;
            f32x4 sv[8];
#pragma unroll
            for (int q = 0; q < 8; ++q) sv[q] = sel4[q];
#pragma unroll
            for (int gg = 0; gg < 4; ++gg) { float m1 = -3.0e38f, m2 = -3.0e38f; int i1 = 0, i2 = 0;
#pragma unroll
                for (int j = 0; j < 8; ++j) { const float v = sv[gg * 2 + (j >> 2)][j & 3]; const bool gt1 = v > m1, gt2 = v > m2;
                    m2 = gt1 ? m1 : (gt2 ? v : m2); i2 = gt1 ? i1 : (gt2 ? j : i2); m1 = gt1 ? v : m1; i1 = gt1 ? j : i1; }
                const float gs = m1 + m2; if (gs > best) { best = gs; bg = gg; b1 = i1; b2 = i2; } }
            const int e1 = bg * 8 + b1, e2 = bg * 8 + b2; const float s1 = selL[1024 + tq * 32 + e1], s2 = selL[1024 + tq * 32 + e2], inv = 1.0f / (s1 + s2);
            const int tl = g * 32 + tq; asgE[2 * tl] = e1; asgE[2 * tl + 1] = e2;
            const int t = tok0 + tl; gates[2 * t] = s1 * inv; gates[2 * t + 1] = s2 * inv; }
    }
    __syncthreads();
#undef LA_LOAD
    int my_e = 0, my_rank = 0; LAS int* cntW = misc + 32;
    if (tid < 256) { my_e = asgE[tid]; unsigned long long mym = 0ull; int cw = 0;
#pragma unroll
        for (int e = 0; e < 32; ++e) { const unsigned long long m = __ballot(my_e == e); if (my_e == e) mym = m; if (lane == e) cw = (int)__builtin_popcountll(m); }
        my_rank = (int)__builtin_popcountll(mym & ((1ull << lane) - 1ull));
        if (lane < 32) cntW[wid * 32 + lane] = cw; }
    __syncthreads();
    if (tid < 256) { for (int w = 0; w < 3; ++w) if (w < wid) my_rank += cntW[w * 32 + my_e]; }
    if (tid < 32) { const int c = cntW[tid] + cntW[32 + tid] + cntW[64 + tid] + cntW[96 + tid];
        unsigned* cnt = (unsigned*)(ws + WS_CTL) + CNT_WORD0 + (L * 32 + tid) * 64;
        misc[tid] = (int)__hip_atomic_fetch_add(cnt, (unsigned)c, __ATOMIC_RELAXED, __HIP_MEMORY_SCOPE_AGENT); }
    __syncthreads();
    if (tid < 256) { int* list = (int*)(ws + WS_LIST); list[(size_t)my_e * NASG + misc[my_e] + my_rank] = blockIdx.x * 256 + tid; }
    __syncthreads();
}

__device__ __forceinline__ void phase_lnB(const Params& p, const int L, const bf16_t* hb, const unsigned char* ys, bf16_t* xb_out, unsigned char* x8_out, float* f_out) {
    const int tid = tid_fresh(), lane = tid & 63, wid = tid >> 6;
    const float* lg = p.in[11] + (L * 2 + 1) * 1024; const float* lb = p.in[12] + (L * 2 + 1) * 1024;
    const float* gates = (const float*)(p.ws + WS_GATE);
    f32x4 gv[4], bv[4];
#pragma unroll
    for (int k = 0; k < 4; ++k) { gv[k] = *(const f32x4*)(lg + 512 * (k >> 1) + 8 * lane + 4 * (k & 1)); bv[k] = *(const f32x4*)(lb + 512 * (k >> 1) + 8 * lane + 4 * (k & 1)); }
    const int tok0 = blockIdx.x * 128 + wid * 16;
    u32x4 rh[2][2]; u32x2 ry0[2][2], ry1[2][2]; f32x2 rg[2];
#define LB_LOAD(tt) do { _Pragma("unroll") for (int u_ = 0; u_ < 2; ++u_) { const int t_ = (tt) + u_; const size_t ro_ = (size_t)t_ * DM; rg[u_] = *(const f32x2*)(gates + 2 * t_); _Pragma("unroll") for (int jj = 0; jj < 2; ++jj) { \
        const size_t co_ = 512 * jj + 8 * lane; rh[u_][jj] = *(const u32x4*)(hb + ro_ + co_); ry0[u_][jj] = *(const u32x2*)(ys + (size_t)(2 * t_) * DM + co_); ry1[u_][jj] = *(const u32x2*)(ys + (size_t)(2 * t_ + 1) * DM + co_); } } } while (0)
    LB_LOAD(tok0);
#pragma unroll 1
    for (int it = 0; it < 8; ++it) {
        u32x4 ch[2][2]; u32x2 cy0[2][2], cy1[2][2]; f32x2 cg[2];
#pragma unroll
        for (int u = 0; u < 2; ++u) { cg[u] = rg[u];
#pragma unroll
            for (int jj = 0; jj < 2; ++jj) { ch[u][jj] = rh[u][jj]; cy0[u][jj] = ry0[u][jj]; cy1[u][jj] = ry1[u][jj]; } }
        if (it < 7) LB_LOAD(tok0 + 2 * it + 2);
#pragma unroll
        for (int u = 0; u < 2; ++u) { const int t = tok0 + 2 * it + u; const size_t rowo = (size_t)t * DM; const float g0 = cg[u].x * (1.0f / YS_SCALE), g1 = cg[u].y * (1.0f / YS_SCALE);
            f32x4 v[4]; float s = 0.f;
#pragma unroll
            for (int jj = 0; jj < 2; ++jj) { f32x4 ha, hb2; bf8_to_f32(ch[u][jj], ha, hb2);
                const f32x4 ya = fp8x4_to_f32(cy0[u][jj].x), yb = fp8x4_to_f32(cy0[u][jj].y), za = fp8x4_to_f32(cy1[u][jj].x), zb = fp8x4_to_f32(cy1[u][jj].y);
                const f32x4 w0 = ALPHA * ha + g0 * ya + g1 * za, w1 = ALPHA * hb2 + g0 * yb + g1 * zb;
                v[2 * jj] = w0; v[2 * jj + 1] = w1; s += ((w0[0] + w0[1]) + (w0[2] + w0[3])) + ((w1[0] + w1[1]) + (w1[2] + w1[3])); }
            const float mean = wave_sum(s) * (1.0f / 1024.0f); float q = 0.f;
#pragma unroll
            for (int k = 0; k < 4; ++k) { const f32x4 d = v[k] - mean; q += (d[0] * d[0] + d[1] * d[1]) + (d[2] * d[2] + d[3] * d[3]); }
            const float rstd = 1.0f / sqrtf(wave_sum(q) * (1.0f / 1024.0f) + LN_EPS);
#pragma unroll
            for (int jj = 0; jj < 2; ++jj) { const size_t co = 512 * jj + 8 * lane;
                const f32x4 o0 = (v[2 * jj] - mean) * rstd * gv[2 * jj] + bv[2 * jj], o1 = (v[2 * jj + 1] - mean) * rstd * gv[2 * jj + 1] + bv[2 * jj + 1];
                if (f_out) { *(f32x4*)(f_out + rowo + co) = o0; *(f32x4*)(f_out + rowo + co + 4) = o1; }
                if (xb_out) { *(u32x4*)(xb_out + rowo + co) = pack8(o0, o1);
                    u32x2 w8; w8.x = pk4_fp8(o0[0], o0[1], o0[2], o0[3]); w8.y = pk4_fp8(o1[0], o1[1], o1[2], o1[3]); *(u32x2*)(x8_out + rowo + co) = w8; } } }
    }
#undef LB_LOAD
}

__device__ __forceinline__ void glds4(const char* sbase, unsigned voff, unsigned lds_dst) {
    unsigned keep;
    asm volatile("s_mov_b32 %0, m0\n\ts_mov_b32 m0, %3\n\ts_nop 0\n\tglobal_load_lds_dword %1, %2\n\ts_mov_b32 m0, %0" : "=&s"(keep) : "v"(voff), "s"(sbase), "s"(lds_dst) : "memory");
}
constexpr int A8_K = 0, A8_V = 81920, A8_RP = 122880, A8_KBUF = 40960;
__device__ __forceinline__ long mk64(unsigned lo, unsigned hi) { return (long)(((unsigned long long)hi << 32) | (unsigned long long)lo); }
__device__ __forceinline__ void phase_attn(const Params& p, LAS unsigned char* lds, const unsigned char* q8, const unsigned char* k8, const unsigned char* vt8, unsigned char* ob) {
    const int tid = tid_fresh(), lane = tid & 63, wid = __builtin_amdgcn_readfirstlane(tid >> 6), fr = lane & 15, fq = lane >> 4;
    const unsigned lds0 = (unsigned)(__UINTPTR_TYPE__)lds;
    const int item = (gridDim.x == 256) ? (int)((blockIdx.x & 7) * 32 + (blockIdx.x >> 3)) : (int)blockIdx.x, b = item >> 6, r0 = (item & 63) * 2;
    const int rsU = min(max(r0 - 4, 0), 118);
    const int r = r0 + (wid >> 2), jq = wid & 3;
    const int rs = min(max(r - 4, 0), 120), c0 = min(max(16 * jq - 8, 0), 32), lrow0 = rs - rsU;
    unsigned offK; { const int tokl = tid >> 2, pc = tid & 3, lc = pc ^ ((tokl >> 2) & 3); offK = (unsigned)(tokl * DM + lc * 16); }
    unsigned offV[5];
#pragma unroll
    for (int k = 0; k < 5; ++k) { const int q = k * 512 + tid, d = q / 40, pc = q - d * 40, lc = pc ^ (d & 7); offV[k] = (unsigned)(d * T + lc * 16); }
    const unsigned offR = (unsigned)min(wid * 64 + lane, 464) * 4u;
    const char* kbase0 = (const char*)k8 + ((size_t)(b * SEQ + rsU * 64) * DM);
    const char* vbase0 = (const char*)vt8 + ((size_t)(b * SEQ + rsU * 64));
    const char* rbase0 = (const char*)p.in[4];
    const size_t tokq = (size_t)b * SEQ + r * 64 + 16 * jq + fr;
    const char* qrow = (const char*)q8 + tokq * DM + 8 * fq;
#define AT_ISSUE_A(h, buf) do { const char* kb_ = kbase0 + (h) * 64; _Pragma("unroll") for (int k = 0; k < 5; ++k) gm::glds16(kb_ + (size_t)k * 131072, offK, lds0 + A8_K + (buf) * A8_KBUF + k * 8192 + wid * 1024); \
        glds4(rbase0 + (h) * 1860, offR, lds0 + A8_RP + (buf) * 2048 + wid * 256); } while (0)
#define AT_ISSUE_B(h) do { const char* vb_ = vbase0 + (size_t)(h) * 64 * T; _Pragma("unroll") for (int k = 0; k < 5; ++k) gm::glds16(vb_, offV[k], lds0 + A8_V + k * 8192 + wid * 1024); } while (0)
#define AT_LDQ(h, q0, q1) do { asm volatile("global_load_dwordx2 %0, %2, off\n\tglobal_load_dwordx2 %1, %2, off offset:32" : "=&v"(q0), "=&v"(q1) : "v"(qrow + (h) * 64) : "memory"); } while (0)
    const int swzk = ((c0 >> 2) + (fr >> 2)) & 3;
    const int kofs0 = (lrow0 * 64 + c0 + fr) * 64 + ((((fq >> 1) ^ swzk)) << 4) + (fq & 1) * 8, kofs1 = (lrow0 * 64 + c0 + fr) * 64 + (((((fq >> 1) ^ swzk)) ^ 2) << 4) + (fq & 1) * 8;
    int vo[8][2];
#pragma unroll
    for (int i = 0; i < 8; ++i)
#pragma unroll
        for (int hf = 0; hf < 2; ++hf) { const int tokoff = (lrow0 + i) * 64 + c0 + 4 * fq + 16 * hf; vo[i][hf] = fr * 640 + (((tokoff >> 4) ^ (fr & 7)) << 4) + (tokoff & 15); }
    const int qc = 16 * jq + fr, cs = min(max(qc - 8, 0), 48);
    long qn0, qn1;
    AT_LDQ(0, qn0, qn1);
    AT_ISSUE_A(0, 0); AT_ISSUE_B(0);
#pragma unroll 1
    for (int h = 0; h < 16; ++h) {
        const int hn = h < 15 ? h + 1 : 15, kb = h & 1;
        asm volatile("s_waitcnt vmcnt(5)" : "+v"(qn0), "+v"(qn1) :: "memory");
        const long q0 = qn0, q1 = qn1;
        __builtin_amdgcn_s_barrier();
        AT_LDQ(hn, qn0, qn1);
        AT_ISSUE_A(hn, kb ^ 1);
        f32x4 s[16];
#pragma unroll
        for (int kbi = 0; kbi < 16; ++kbi) { const int i = kbi >> 1, half = kbi & 1;
            const long k0 = *(const LAS long*)(lds + A8_K + kb * A8_KBUF + kofs0 + i * 4096 + half * 1024), k1 = *(const LAS long*)(lds + A8_K + kb * A8_KBUF + kofs1 + i * 4096 + half * 1024);
            f32x4 a = (f32x4){0.f, 0.f, 0.f, 0.f};
            a = __builtin_amdgcn_mfma_f32_16x16x32_fp8_fp8(k0, q0, a, 0, 0, 0); a = __builtin_amdgcn_mfma_f32_16x16x32_fp8_fp8(k1, q1, a, 0, 0, 0); s[kbi] = a; }
        const LAS float* rp = (const LAS float*)(lds + A8_RP + kb * 2048);
        float mx = -3.0e38f; const int thr = cs - c0;
#pragma unroll
        for (int i = 0; i < 8; ++i) { const int ri = rs + i - r + 7;
#pragma unroll
            for (int j = 0; j < 4; ++j) { const int pos = 4 * fq + j; const bool sel0 = pos >= thr; const int ci = min(max(c0 + pos - qc + 15 + (sel0 ? 0 : 16), 0), 30);
                float bvv = rp[ri * 31 + ci]; asm volatile("" : "+v"(bvv)); const float v = (sel0 ? s[2 * i][j] : s[2 * i + 1][j]) * 0.125f + bvv; s[2 * i][j] = v; mx = fmaxf(mx, v); } }
        mx = fmaxf(mx, __shfl_xor(mx, 16)); mx = fmaxf(mx, __shfl_xor(mx, 32));
        const float mxp = mx - 4.1588830833596715f;
        float sum = 0.f;
#pragma unroll
        for (int i = 0; i < 8; ++i)
#pragma unroll
            for (int j = 0; j < 4; ++j) { const int pos = 4 * fq + j; const bool sel0 = pos >= thr; const float e = __expf(s[2 * i][j] - mxp); sum += e; s[2 * i][j] = sel0 ? e : 0.f; s[2 * i + 1][j] = sel0 ? 0.f : e; }
        sum += __shfl_xor(sum, 16); sum += __shfl_xor(sum, 32);
        asm volatile("s_waitcnt vmcnt(8)" ::: "memory");
        __builtin_amdgcn_s_barrier();
        f32x4 oacc[4];
#pragma unroll
        for (int db = 0; db < 4; ++db) oacc[db] = (f32x4){0.f, 0.f, 0.f, 0.f};
#pragma unroll
        for (int i = 0; i < 8; ++i) { const long pf = mk64(pk4_fp8(s[2 * i][0], s[2 * i][1], s[2 * i][2], s[2 * i][3]), pk4_fp8(s[2 * i + 1][0], s[2 * i + 1][1], s[2 * i + 1][2], s[2 * i + 1][3]));
#pragma unroll
            for (int db = 0; db < 4; ++db) { const unsigned lo = *(const LAS unsigned*)(lds + A8_V + vo[i][0] + db * 10240), hi = *(const LAS unsigned*)(lds + A8_V + vo[i][1] + db * 10240);
                oacc[db] = __builtin_amdgcn_mfma_f32_16x16x32_fp8_fp8(mk64(lo, hi), pf, oacc[db], 0, 0, 0); } }
        asm volatile("s_waitcnt lgkmcnt(0)" ::: "memory");
        __builtin_amdgcn_s_barrier();
        AT_ISSUE_B(hn);
        const float inv = O_SCALE / sum;
#pragma unroll
        for (int db = 0; db < 4; ++db) *(unsigned*)(ob + tokq * DM + h * 64 + 16 * db + 4 * fq) = pk4_fp8(oacc[db][0] * inv, oacc[db][1] * inv, oacc[db][2] * inv, oacc[db][3] * inv);
    }
    asm volatile("s_waitcnt vmcnt(0)" ::: "memory");
    __builtin_amdgcn_s_barrier();
#undef AT_ISSUE_A
#undef AT_ISSUE_B
#undef AT_LDQ
}

template <int SRC_SHIFT>
__device__ __forceinline__ int moe_setup(const Params& p, LAS unsigned char* lds, const int L, LAS int* ts, LAS int* idxsrc, LAS int* idxdst) {
    const int tid = tid_fresh(), lane = tid & 63; unsigned char* ws = p.ws;
    LAS int* cn = ts + 40;
    if (tid < 64) {
        const int c = (int)__hip_atomic_load((unsigned*)(ws + WS_CTL) + CNT_WORD0 + (L * 32 + (lane & 31)) * 64, __ATOMIC_RELAXED, __HIP_MEMORY_SCOPE_AGENT);
        const int nt = (c + 255) >> 8; int incl = nt;
#pragma unroll
        for (int o = 1; o < 32; o <<= 1) { const int up = __shfl_up(incl, o); if ((lane & 31) >= o) incl += up; }
        if (lane < 32) { cn[lane] = c; ts[lane] = incl - nt; if (lane == 31) ts[32] = incl; } }
    __syncthreads();
    const int ntile = ts[NE];
    gm::GridOrder o; o.init(ntile, 4, gridDim.x, blockIdx.x);
    const int* list = (const int*)(ws + WS_LIST);
#pragma unroll
    for (int k = 0; k < 4; ++k) { const int ui = 2 * k + (tid >> 8), r = tid & 255; int pm = 0, pn = 0; const bool ok_u = o.mn(ui, pm, pn);
        const int e = expert_of_tile(ts, ok_u ? pm : 0);
        if (ok_u) { const int j = pm - ts[e], ce = cn[e]; const int pos = j * 256 + r; const bool ok = pos < ce; const int a = list[(size_t)e * NASG + (ok ? pos : j * 256)];
            idxsrc[ui * 256 + r] = a >> SRC_SHIFT; idxdst[ui * 256 + r] = ok ? a : -1; } }
    __syncthreads();
    return ntile;
}

__device__ __forceinline__ bool in_rng(int lo, int hi, int k) { asm volatile("" : "+s"(lo), "+s"(hi)); return lo <= k && k < hi; }
__device__ __forceinline__ Params params_fresh() {
    Params r{};
#if defined(__HIP_DEVICE_COMPILE__)
    auto k = __builtin_amdgcn_kernarg_segment_ptr(); asm volatile("" : "+s"(k));
    const __attribute__((address_space(4))) Params* kp = (const __attribute__((address_space(4))) Params*)k;
#pragma unroll
    for (int i = 0; i < 13; ++i) r.in[i] = kp->in[i];
    r.out = kp->out; r.ws = kp->ws; r.ph_lo = kp->ph_lo; r.ph_hi = kp->ph_hi;
#endif
    return r;
}
__global__ void __launch_bounds__(512, 2) k_fwd(Params p_unused) {
    extern __shared__ __attribute__((aligned(16))) unsigned char lds_raw[];
    LAS unsigned char* lds = (LAS unsigned char*)lds_raw;
    const Params p0 = params_fresh();
    { const int tid = tid_fresh(); if (tid < 4) ((LAS unsigned*)(lds + LDS_BARW))[tid] = 0u; }
    __syncthreads();
    XcdBarrier bar; bar.bar = (unsigned*)(p0.ws + WS_CTL); bar.x = 0; bar.st = nullptr;
    const int lo = p0.ph_lo, hi = p0.ph_hi;
    if (hi - lo > 1) bar = xcd_barrier_post((unsigned*)(p0.ws + WS_CTL), (volatile LAS unsigned*)(lds + LDS_BARW));
#ifndef PHMASK
#define PHMASK 0xffff
#endif
#define IN(k) (((PHMASK >> (k)) & 1) && in_rng(lo, hi, (k)))
#define SEAM(k) do { if (IN((k) + 1)) xcd_barrier(bar); } while (0)
#define PH_PTRS const Params p = params_fresh(); unsigned char* ws = p.ws; const int G = gridDim.x, cb = blockIdx.x; \
    bf16_t* S0 = (bf16_t*)(ws + WS_S0); bf16_t* S1 = (bf16_t*)(ws + WS_S1); bf16_t* S2 = (bf16_t*)(ws + WS_S2); bf16_t* S3 = (bf16_t*)(ws + WS_S3); \
    unsigned char* H8 = (unsigned char*)p.out + 64 * MiB; unsigned char* X8 = (unsigned char*)p.out + 96 * MiB; bf16_t* D0 = (bf16_t*)p.out; (void)X8; \
    LAS int* idxsrc = (LAS int*)(lds + LDS_IDX); LAS int* idxdst = idxsrc + 8 * 256; LAS int* tsm = (LAS int*)(lds + LDS_MISC); \
    (void)G; (void)cb; (void)S0; (void)S1; (void)S2; (void)S3; (void)H8; (void)D0; (void)idxsrc; (void)idxdst; (void)tsm;

    if (IN(0)) { PH_PTRS phase_prologue(p, lds); SEAM(0); }

#pragma unroll 1
    for (int L = 0; L < 2; ++L) {
        const int pb = 7 * L;
        if (L == 0) {
            if (IN(1)) {
                PH_PTRS SchedG1 S; S.o.init(4, 128, G, cb); S.WinT = (const char*)(ws + WS_WIN); S.xb = (const char*)S0; EpiG1 E{S1, 1.0f / W_SCALE};
                gm::gemm_phase<EpiG1, SchedG1, false, true>(lds, 1024, 1024u, 64u * 1024u, S, E, nullptr); SEAM(1); }
            if (IN(2)) {
                PH_PTRS SchedS1 S{G, cb, (const char*)(ws + WS_F1), (const char*)S1}; EpiS1 E{S0};
                gm::gemm_phase<EpiS1, SchedS1, false>(lds, 256, 256u, 256u, S, E, nullptr); SEAM(2); }
            if (IN(3)) {
                PH_PTRS SchedS2 S; S.o.init(64, 16, G, cb); S.F2 = (const char*)(ws + WS_F2); S.A1 = (const char*)S0; EpiS2 E{(unsigned char*)S1};
                gm::gemm_phase<EpiS2, SchedS2, false>(lds, 256, 256u, 256u, S, E, nullptr); SEAM(3); }
        } else {
            if (IN(9)) {
                PH_PTRS
                { SchedPlain S; S.o.init(128, 8, G, cb); S.A = (const char*)X8; S.B = (const char*)(ws + WS_WQKV); S.ldA = 1024u; S.ldB = 1024u; S.p16 = true; EpiRow8 E{(unsigned char*)S1, 1024, 4, (size_t)32 * MiB, 1.0f / W_SCALE, 1.0f / W_SCALE};
                  gm::gemm_phase<EpiRow8, SchedPlain, false, true>(lds, 1024, 1024u, 1024u, S, E, nullptr); }
                { SchedPlain S; S.o.init(4, 128, G, cb); S.A = (const char*)(ws + WS_WQKV) + (size_t)2048 * 1024; S.B = (const char*)X8; S.ldA = 1024u; S.ldB = 1024u; S.p16 = true; EpiRow8 E{(unsigned char*)S3, (size_t)T, 0, 0, 1.0f / W_SCALE, 1.0f / W_SCALE};
                  gm::gemm_phase<EpiRow8, SchedPlain, false, true>(lds, 1024, 1024u, 1024u, S, E, nullptr); }
                SEAM(9); }
            if (IN(10)) { PH_PTRS phase_attn(p, lds, (const unsigned char*)S1, (const unsigned char*)S1 + 32 * MiB, (const unsigned char*)S3, (unsigned char*)S0); SEAM(10); }
        }
        if (L == 0) { if (IN(4)) {
            PH_PTRS SchedPlain S; S.o.init(128, 4, G, cb); S.A = (const char*)S1; S.B = (const char*)(ws + WS_W2); S.ldA = 2048u; S.ldB = 2048u;
            EpiRow E{S0, 1024, 0, 0, 1.0f / (Y_SCALE * W2_SCALE), 1.f};
            gm::gemm_phase<EpiRow, SchedPlain, false, true>(lds, 2048, 2048u, 2048u, S, E, nullptr); SEAM(4); } }
        else { if (IN(11)) {
            PH_PTRS SchedPlain S; S.o.init(128, 4, G, cb); S.A = (const char*)S0; S.B = (const char*)(ws + WS_WO); S.ldA = 1024u; S.ldB = 1024u;
            EpiRow E{S1, 1024, 0, 0, 1.0f / (W_SCALE * O_SCALE), 1.f};
            gm::gemm_phase<EpiRow, SchedPlain, false, true>(lds, 1024, 1024u, 1024u, S, E, nullptr); SEAM(11); } }
        if (IN(5 + pb)) { PH_PTRS phase_lnA(p, lds, L, D0, L == 0 ? S0 : S1, S3, H8); SEAM(5 + pb); }
        if (IN(6 + pb)) {
            PH_PTRS const int ntile = moe_setup<1>(p, lds, L, tsm, idxsrc, idxdst);
            SchedMoe S; S.o.init(ntile, 4, G, cb); S.ts = tsm; S.A = (const char*)H8; S.W = (const char*)(ws + WS_WGU) + (size_t)L * 32 * 1024 * 1024; S.wstride = (size_t)1024 * 1024; S.ldB = 1024u; S.hsB128 = true; S.tileA = 0u;
            EpiGU E{(unsigned char*)S0, idxdst};
            gm::gemm_phase<EpiGU, SchedMoe, true, true>(lds, 1024, 1024u, 1024u, S, E, idxsrc); SEAM(6 + pb); }
        if (IN(7 + pb)) {
            PH_PTRS int ntile; if (IN(6 + pb)) { __syncthreads(); ntile = tsm[NE]; } else ntile = moe_setup<0>(p, lds, L, tsm, idxsrc, idxdst);
            SchedMoe S; S.o.init(ntile, 4, G, cb); S.ts = tsm; S.A = (const char*)S0; S.W = (const char*)(ws + WS_WD) + (size_t)L * 32 * 1024 * 512; S.wstride = (size_t)1024 * 512; S.ldB = 512u; S.hsB128 = false; S.tileA = 256u * 512u;
            EpiDown E{(unsigned char*)S1, idxdst};
            gm::gemm_phase<EpiDown, SchedMoe, false, true>(lds, 512, 512u, 512u, S, E, nullptr); SEAM(7 + pb); }
        if (IN(8 + pb)) { PH_PTRS phase_lnB(p, L, S3, (const unsigned char*)S1, L == 0 ? D0 : nullptr, X8, L == 0 ? nullptr : p.out); if (L == 0) SEAM(8); }
    }
#undef IN
#undef SEAM
#undef PH_PTRS
}

extern "C" void kernel_launch(void* const* d_in, const int* in_sizes, int n_in, void* d_out, int out_size, void* d_ws, size_t ws_size, hipStream_t stream) {
    static int grid = 0;
    if (grid == 0) {
        if (n_in != 13 || in_sizes[0] != T * DM || out_size != T * DM || ws_size < WS_END) { fprintf(stderr, "kernel_launch: unexpected shapes / workspace (%d inputs, in0 %d, out %d, ws %zu < %zu)\n", n_in, n_in > 0 ? in_sizes[0] : -1, out_size, ws_size, (size_t)WS_END); grid = -1; return; }
        int dev = 0, cus = 0, per_cu = 0;
        if (hipGetDevice(&dev) != hipSuccess || hipDeviceGetAttribute(&cus, hipDeviceAttributeMultiprocessorCount, dev) != hipSuccess) { grid = -1; return; }
        if (hipFuncSetAttribute((const void*)k_fwd, hipFuncAttributeMaxDynamicSharedMemorySize, LDS_BYTES) != hipSuccess) { fprintf(stderr, "kernel_launch: hipFuncSetAttribute failed\n"); grid = -1; return; }
        if (hipOccupancyMaxActiveBlocksPerMultiprocessor(&per_cu, (const void*)k_fwd, 512, LDS_BYTES) != hipSuccess || per_cu < 1) fprintf(stderr, "kernel_launch: occupancy query says %d\n", per_cu);
        (void)hipGetLastError();
        grid = cus;
    }
    if (grid < 0) return;
    (void)hipMemsetAsync((char*)d_ws + WS_CTL, 0, CTL_ZERO_BYTES, stream);
    Params a{};
    for (int i = 0; i < 13; ++i) a.in[i] = (const float*)d_in[i];
    a.out = (float*)d_out; a.ws = (unsigned char*)d_ws;
#if MK_N_LAUNCHES == 1
    a.ph_lo = 0; a.ph_hi = NPH;
    hipLaunchKernelGGL(k_fwd, dim3(grid), dim3(512), LDS_BYTES, stream, a);
#else
    for (int k = 0; k < NPH; ++k) { a.ph_lo = k; a.ph_hi = k + 1; const int reps = ((REPMASK >> k) & 1) ? 2 : 1;
        for (int r = 0; r < reps; ++r) hipLaunchKernelGGL(k_fwd, dim3(grid), dim3(512), LDS_BYTES, stream, a); }
#endif
}
```

```cpp
#include <hip/hip_runtime.h>
#include <cstdio>
#include <cstdint>

#ifndef MK_N_LAUNCHES
#define MK_N_LAUNCHES 1
#endif
#ifndef REPMASK
#define REPMASK 0x0
#endif

#define LAS __attribute__((address_space(3)))
typedef unsigned short bf16_t;
typedef short bf16x8 __attribute__((ext_vector_type(8)));
typedef short bf16x4 __attribute__((ext_vector_type(4)));
typedef float f32x4 __attribute__((ext_vector_type(4)));
typedef float f32x2 __attribute__((ext_vector_type(2)));
typedef unsigned u32x4 __attribute__((ext_vector_type(4)));
typedef unsigned u32x2 __attribute__((ext_vector_type(2)));

constexpr int T = 32768, DM = 1024, SEQ = 8192, NBATCH = 4, NE = 32, DEX = 512, NASG = 65536, NPH = 16;
constexpr float ALPHA = 1.41421356237309515f;
constexpr float LN_EPS = 1e-5f;
constexpr size_t MiB = (size_t)1 << 20;
constexpr size_t WS_CTL = 0, WS_GATE = 1 * MiB, WS_LIST = 2 * MiB, WS_WIN = 10 * MiB, WS_W2 = 12 * MiB, WS_F1 = 16 * MiB, WS_F2 = 17 * MiB, WS_WQKV = 21 * MiB, WS_WO = 27 * MiB,
                 WS_WGU = 30 * MiB, WS_WD = 158 * MiB, WS_S0 = 222 * MiB, WS_S1 = 286 * MiB, WS_S2 = 350 * MiB, WS_S3 = 414 * MiB, WS_END = 478 * MiB;
constexpr size_t CTL_ZERO_BYTES = 65536;
constexpr int CNT_WORD0 = 4096;
constexpr int LDS_BYTES = 159760;
constexpr int LDS_IDX = 131072, LDS_MISC = 131072 + 16384, LDS_BARW = LDS_BYTES - 16;

#define XB_TMO      128
#define XB_XCNT(j)  (256  + 64 * (j))
#define XB_XSUB(j)  (1280 + 64 * (j))
#define XB_XGEN(j)  (2304 + 64 * (j))
#define XB_TOP      3328
#define XB_TOPGEN   3392
#define XCD_BAR_WORDS 3456
#define XB_SPIN_CAP (1u << 18)

__device__ __forceinline__ unsigned xb_ld(unsigned* p)              { return __hip_atomic_load(p, __ATOMIC_RELAXED, __HIP_MEMORY_SCOPE_AGENT); }
__device__ __forceinline__ unsigned xb_add(unsigned* p, unsigned v) { return __hip_atomic_fetch_add(p, v, __ATOMIC_RELAXED, __HIP_MEMORY_SCOPE_AGENT); }
__device__ __forceinline__ unsigned xb_xcc_id() { return (unsigned)__builtin_amdgcn_s_getreg((3 << 11) | 20) & 0xFu; }
#define XB_SPIN(cond, bar) do { unsigned _sp = 0; while (cond) { __builtin_amdgcn_s_sleep(1); \
    if ((++_sp & 255u) == 0u) { if (xb_ld(&(bar)[XB_TMO])) break; if (_sp > XB_SPIN_CAP) { atomicAdd(&(bar)[XB_TMO], 1u); break; } } } } while (0)

struct XcdBarrier { unsigned* bar; unsigned x; volatile LAS unsigned* st; };

__device__ __forceinline__ XcdBarrier xcd_barrier_post(unsigned* bar, volatile LAS unsigned* st) {
    XcdBarrier b; b.bar = bar; b.x = xb_xcc_id(); b.st = st;
    if (threadIdx.x == 0) (void)xb_add(&bar[XB_XCNT(b.x)], 1u);
    return b;
}
__device__ __forceinline__ void xcd_barrier_complete(unsigned* bar, unsigned x, unsigned& nloc, unsigned& nx) {
    const unsigned G = gridDim.x * gridDim.y * gridDim.z;
    unsigned sum, cnt, mine, sp = 0u;
    for (;;) {
        sum = 0u; cnt = 0u; mine = 0u;
#pragma unroll
        for (unsigned j = 0; j < 16; ++j) { const unsigned c = xb_ld(&bar[XB_XCNT(j)]); sum += c; cnt += (c > 0u) ? 1u : 0u; mine = (j == x) ? c : mine; }
        if (sum == G) break;
        __builtin_amdgcn_s_sleep(1);
        if ((++sp & 255u) == 0u) { if (xb_ld(&bar[XB_TMO])) break; if (sp > XB_SPIN_CAP) { atomicAdd(&bar[XB_TMO], 1u); break; } }
    }
    nloc = mine > 0u ? mine : 1u; nx = cnt > 0u ? cnt : 1u;
}
__device__ __forceinline__ void xcd_barrier(const XcdBarrier& b) {
    asm volatile("s_waitcnt vmcnt(0)" ::: "memory");
    __syncthreads();
    if (threadIdx.x == 0) {
        unsigned* bar = b.bar;
        __builtin_amdgcn_s_waitcnt(0);
        unsigned nloc = b.st[0], nx = b.st[1];
        if (nloc == 0u) { xcd_barrier_complete(bar, b.x, nloc, nx); b.st[0] = nloc; b.st[1] = nx; }
        const unsigned old = xb_add(&bar[XB_XSUB(b.x)], 1u);
        const unsigned gen = old / nloc;
        if (old + 1u == (gen + 1u) * nloc) {
            __builtin_amdgcn_fence(__ATOMIC_RELEASE, "agent");
            asm volatile("s_waitcnt vmcnt(0)" ::: "memory");
            const unsigned og = xb_add(&bar[XB_TOP], 1u);
            const unsigned tg = og / nx;
            if (og + 1u == (tg + 1u) * nx) xb_add(&bar[XB_TOPGEN], 1u);
            else XB_SPIN(xb_ld(&bar[XB_TOPGEN]) == tg, bar);
            __builtin_amdgcn_fence(__ATOMIC_ACQUIRE, "agent");
            xb_add(&bar[XB_XGEN(b.x)], 1u);
            asm volatile("s_waitcnt vmcnt(0)" ::: "memory");
        } else {
            XB_SPIN(xb_ld(&bar[XB_XGEN(b.x)]) == gen, bar);
            __builtin_amdgcn_fence(__ATOMIC_ACQUIRE, "agent");
            asm volatile("s_waitcnt vmcnt(0)" ::: "memory");
        }
    }
    __syncthreads();
}

__device__ __forceinline__ unsigned cvt_pk_bf16(float lo, float hi) { unsigned r; asm volatile("v_cvt_pk_bf16_f32 %0, %1, %2" : "=v"(r) : "v"(lo), "v"(hi)); return r; }
__device__ __forceinline__ float bf_lo(unsigned w) { return __uint_as_float(w << 16); }
__device__ __forceinline__ float bf_hi(unsigned w) { return __uint_as_float(w & 0xffff0000u); }
__device__ __forceinline__ u32x4 pack8(const f32x4 a, const f32x4 b) { u32x4 w; w.x = cvt_pk_bf16(a[0], a[1]); w.y = cvt_pk_bf16(a[2], a[3]); w.z = cvt_pk_bf16(b[0], b[1]); w.w = cvt_pk_bf16(b[2], b[3]); return w; }
__device__ __forceinline__ int tid_fresh() { int t = threadIdx.x; asm volatile("" : "+v"(t)); return t; }
__device__ __forceinline__ void bf8_to_f32(const u32x4 w, f32x4& a, f32x4& b) { a[0] = bf_lo(w.x); a[1] = bf_hi(w.x); a[2] = bf_lo(w.y); a[3] = bf_hi(w.y); b[0] = bf_lo(w.z); b[1] = bf_hi(w.z); b[2] = bf_lo(w.w); b[3] = bf_hi(w.w); }
__device__ __forceinline__ float wave_sum(float v) {
#pragma unroll
    for (int o = 32; o >= 1; o >>= 1) v += __shfl_xor(v, o);
    return v;
}

constexpr float W_SCALE = 64.0f, H_SCALE = 4.0f, O_SCALE = 16.0f, Y_SCALE = 8.0f, W2_SCALE = 256.0f, YS_SCALE = 16.0f;
__device__ __forceinline__ f32x4 fp8x4_to_f32(unsigned w) { f32x4 r; r[0] = __builtin_amdgcn_cvt_f32_fp8(w, 0); r[1] = __builtin_amdgcn_cvt_f32_fp8(w, 1); r[2] = __builtin_amdgcn_cvt_f32_fp8(w, 2); r[3] = __builtin_amdgcn_cvt_f32_fp8(w, 3); return r; }
__device__ __forceinline__ float silu_mul(float g, float up) { return g * __builtin_amdgcn_rcpf(1.0f + __expf(-g)) * up; }
__device__ __forceinline__ unsigned pk4_fp8(float a, float b, float c, float d) { unsigned r = 0; r = __builtin_amdgcn_cvt_pk_fp8_f32(a, b, r, false); r = __builtin_amdgcn_cvt_pk_fp8_f32(c, d, r, true); return r; }
namespace gm {
constexpr int BM = 256, BK = 64, HALF = 128, HTB = HALF * BK * 2, STAGE_BYTES = 8 * HTB, NXCD = 8, WGM = 8;
__device__ __forceinline__ int lds_byte(int r, int c) { const int st = (r >> 4) * 2 + (c >> 5), rr = r & 15, cc = c & 31, ob = rr * 64 + cc * 2; return st * 1024 + (ob ^ (((ob >> 9) & 1) << 5)); }
__device__ __forceinline__ void stage_rc(int b, int& R, int& C) { const int st = b / 1024, sb = b % 1024, swz = sb ^ (((sb >> 9) & 1) << 5); R = (st >> 1) * 16 + swz / 64; C = (st & 1) * 32 + (swz % 64) / 2; }
__device__ __forceinline__ int perm32(int rho) { const int n = rho >> 4, i = rho & 15; return 8 * (i >> 2) + 4 * n + (i & 3); }

__device__ __forceinline__ void glds16(const char* sbase, unsigned voff, unsigned lds_dst) {
    unsigned keep;
    asm volatile("s_mov_b32 %0, m0\n\ts_mov_b32 m0, %3\n\ts_nop 0\n\tglobal_load_lds_dwordx4 %1, %2\n\ts_mov_b32 m0, %0" : "=&s"(keep) : "v"(voff), "s"(sbase), "s"(lds_dst) : "memory");
}
struct Unit { const char* A; const char* B; unsigned hsA, hsB; int pm, pn, x0, x1; };

struct GridOrder {
    int nM, nN, nwg, G, c;
    __device__ __forceinline__ void init(int nM_, int nN_, int G_, int c_) { nM = nM_; nN = nN_; nwg = nM * nN; G = G_; c = c_; }
    __device__ __forceinline__ bool mn(int i, int& pm, int& pn) const {
        const long L = (long)i * G + c; if (L >= nwg) return false;
        int wgid = (int)L; { const int q = nwg / NXCD, r = nwg % NXCD, xcd = wgid % NXCD, off = wgid / NXCD; wgid = (xcd < r ? xcd * (q + 1) : r * (q + 1) + (xcd - r) * q) + off; }
        const int nig = WGM * nN, gid = wgid / nig, fm = gid * WGM, gsz = (nM - fm) < WGM ? (nM - fm) : WGM;
        pm = fm + ((wgid % nig) % gsz); pn = (wgid % nig) / gsz; return true;
    }
};

typedef int i32x4v __attribute__((ext_vector_type(4)));
typedef int i32x8v __attribute__((ext_vector_type(8)));
__device__ __forceinline__ i32x8v cat8(const bf16x8 a, const bf16x8 b) { const i32x4v x = __builtin_bit_cast(i32x4v, a), y = __builtin_bit_cast(i32x4v, b); return (i32x8v){x[0], x[1], x[2], x[3], y[0], y[1], y[2], y[3]}; }
template <class E, class = void> struct epi_perm16 { static constexpr bool value = false; };
template <class E> struct epi_perm16<E, decltype((void)E::PERM16)> { static constexpr bool value = E::PERM16; };
template <class Epi, class Sched, bool GATHER, bool FP8 = false, bool SP2 = true, bool ALIGN_EPI = true>
__device__ __forceinline__ void gemm_phase(LAS unsigned char* lds, const int kbytes, const unsigned ldA, const unsigned ldB, const Sched& S, const Epi& E, const LAS int* idxsrc) {
    const int tid = tid_fresh(), wid = __builtin_amdgcn_readfirstlane(tid >> 6), lane = tid & 63, wr = wid >> 2, wc = wid & 3, fr = lane & 15, fq = lane >> 4;
    int nt = kbytes / (BK * 2); asm volatile("" : "+s"(nt));
    unsigned voffA[2][2], voffBh[2][2];
#pragma unroll
    for (int i = 0; i < 2; ++i) { int R, C; stage_rc(tid * 16 + i * 8192, R, C); const int q = perm32(R & 31); const int Rb = Epi::PERM ? ((R & ~31) + q) : R;
        voffA[0][i] = (unsigned)R * ldA + (unsigned)C * 2u; voffA[1][i] = voffA[0][i];
        if constexpr (epi_perm16<Epi>::value) { const int rb0 = 64 * (R >> 5) + 16 * (q >> 3) + (q & 7); voffBh[0][i] = (unsigned)rb0 * ldB + (unsigned)C * 2u; voffBh[1][i] = (unsigned)(rb0 + 8) * ldB + (unsigned)C * 2u; }
        else { voffBh[0][i] = (unsigned)Rb * ldB + (unsigned)C * 2u; voffBh[1][i] = voffBh[0][i]; } }
    const size_t kstep = (size_t)(BK * 2);
    const unsigned ldsw = (unsigned)wid * 1024u;
    const unsigned lds0 = (unsigned)(__UINTPTR_TYPE__)lds;
    const int aoff = lds_byte(wr * 64 + fr, fq * 8), boff = lds_byte(wc * 32 + fr, fq * 8);
#define PG8_SA(b, h) (((b) * 2 + (h)) * HTB)
#define PG8_SB(b, h) ((4 + (b) * 2 + (h)) * HTB)
#define PG8_STAGE(bufoff, gbase, voff) do { _Pragma("unroll") for (int _i = 0; _i < 2; ++_i) glds16((const char*)(gbase), (voff)[_i], lds0 + (unsigned)(bufoff) + ldsw + _i * 8192u); } while (0)
#define PG8_LDA(dst, b, h) do { _Pragma("unroll") for (int m = 0; m < 4; ++m) _Pragma("unroll") for (int k = 0; k < 2; ++k) dst[m][k] = *(const LAS bf16x8*)(lds + PG8_SA(b, h) + aoff + m * 2048 + k * 1024); } while (0)
#define PG8_LDB(dst, b, h) do { _Pragma("unroll") for (int n = 0; n < 2; ++n) _Pragma("unroll") for (int k = 0; k < 2; ++k) dst[n][k] = *(const LAS bf16x8*)(lds + PG8_SB(b, h) + boff + n * 2048 + k * 1024); } while (0)
#define PG8_MMA(ai, bj, At, Bt) do { __builtin_amdgcn_s_setprio(1); _Pragma("unroll") for (int m = 0; m < 4; ++m) _Pragma("unroll") for (int n = 0; n < 2; ++n) { \
        if constexpr (FP8) { const i32x8v b8_ = cat8(Bt[n][0], Bt[n][1]), a8_ = cat8(At[m][0], At[m][1]); \
            asm volatile("s_nop 1\n\tv_mfma_scale_f32_16x16x128_f8f6f4 %0, %1, %2, %0, %3, %3 op_sel_hi:[0,0,0]" : "+v"(acc[ai][bj][m][n]) : "v"(b8_), "v"(a8_), "v"(fp8_unit_scale)); } \
        else { _Pragma("unroll") for (int k = 0; k < 2; ++k) acc[ai][bj][m][n] = __builtin_amdgcn_mfma_f32_16x16x32_bf16(Bt[n][k], At[m][k], acc[ai][bj][m][n], 0, 0, 0); } } \
        __builtin_amdgcn_s_setprio(0); } while (0)
#define PG8_WAIT_V(n) asm volatile("s_waitcnt vmcnt(" #n ")" ::: "memory")
#define PG8_WAIT_L(n) asm volatile("s_waitcnt lgkmcnt(" #n ")" ::: "memory")
#define PG8_BAR __builtin_amdgcn_s_barrier()
#define PG8_SCHED __builtin_amdgcn_sched_barrier(0)
#define PG8_VA(h) voffA[GATHER ? (h) : 0]
#define PG8_VB(h) voffBh[epi_perm16<Epi>::value ? (h) : 0]
    const int fp8_unit_scale = 0x7f7f7f7f;
    Unit cur, nxt; int ui = 0;
    if (!S.next(0, cur)) return;
    if constexpr (GATHER) {
#pragma unroll
        for (int h = 0; h < 2; ++h)
#pragma unroll
            for (int i = 0; i < 2; ++i) { int R, C; stage_rc(tid * 16 + i * 8192, R, C); voffA[h][i] = (unsigned)idxsrc[h * 128 + R] * ldA + (unsigned)C * 2u; }
    }
    f32x4 acc[2][2][4][2];
#pragma unroll
    for (int a = 0; a < 2; ++a)
#pragma unroll
        for (int b = 0; b < 2; ++b)
#pragma unroll
            for (int m = 0; m < 4; ++m)
#pragma unroll
                for (int n = 0; n < 2; ++n) acc[a][b][m][n] = (f32x4){0.f, 0.f, 0.f, 0.f};
    bf16x8 At[4][2], B0[2][2], B1[2][2];
    const char* cA = cur.A; const char* cB = cur.B; unsigned chA = cur.hsA, chB = cur.hsB;
    if constexpr (SP2) {
        PG8_STAGE(PG8_SB(0, 0), cB, PG8_VB(0)); PG8_STAGE(PG8_SB(0, 1), cB + chB, PG8_VB(1)); PG8_STAGE(PG8_SA(0, 0), cA, PG8_VA(0)); PG8_STAGE(PG8_SA(0, 1), cA + chA, PG8_VA(1));
        if (wr == 1) PG8_BAR;
        PG8_WAIT_V(2); PG8_BAR;
        PG8_STAGE(PG8_SB(1, 0), cB + kstep, PG8_VB(0)); PG8_STAGE(PG8_SA(1, 0), cA + kstep, PG8_VA(0)); PG8_STAGE(PG8_SB(1, 1), cB + chB + kstep, PG8_VB(1));
        PG8_WAIT_V(6); PG8_BAR;
    } else {
    PG8_STAGE(PG8_SB(0, 0), cB, PG8_VB(0)); PG8_STAGE(PG8_SA(0, 0), cA, PG8_VA(0)); PG8_STAGE(PG8_SB(0, 1), cB + chB, PG8_VB(1)); PG8_STAGE(PG8_SA(0, 1), cA + chA, PG8_VA(1));
    if (wr == 1) PG8_BAR;
    PG8_WAIT_V(4); PG8_BAR;
    PG8_STAGE(PG8_SB(1, 0), cB + kstep, PG8_VB(0)); PG8_STAGE(PG8_SA(1, 0), cA + kstep, PG8_VA(0)); PG8_STAGE(PG8_SB(1, 1), cB + chB + kstep, PG8_VB(1));
    PG8_WAIT_V(6); PG8_BAR;
    }
    for (;;) {
        const bool has_next = S.next(ui + 1, nxt);
        const char* nA = has_next ? nxt.A : cA; const char* nB = has_next ? nxt.B : cB; const unsigned nhA = has_next ? nxt.hsA : chA, nhB = has_next ? nxt.hsB : chB;
#pragma unroll 1
        for (int t = 0; t < nt; t += 2) {
            const bool last = (t == nt - 2);
            const char* a1 = cA + (size_t)(t + 1) * kstep;
            const char* a2 = last ? nA : cA + (size_t)(t + 2) * kstep; const char* b2 = last ? nB : cB + (size_t)(t + 2) * kstep;
            const unsigned hA2 = last ? nhA : chA, hB2 = last ? nhB : chB;
            const char* a3 = a2 + kstep; const char* b3 = b2 + kstep;
            const bool sw = GATHER && last && has_next;
            int gi[2][2];
            if constexpr (SP2) {
            PG8_LDB(B0, 0, 0); PG8_LDB(B1, 0, 1); PG8_SCHED; PG8_LDA(At, 0, 0); PG8_STAGE(PG8_SA(1, 1), a1 + chA, PG8_VA(1));
            PG8_WAIT_V(8); PG8_WAIT_L(0); PG8_BAR; PG8_MMA(0, 0, At, B0); PG8_MMA(0, 1, At, B1); PG8_BAR; PG8_SCHED;
            if constexpr (GATHER) { if (sw) {
#pragma unroll
                for (int h = 0; h < 2; ++h)
#pragma unroll
                    for (int i = 0; i < 2; ++i) { int R, C; stage_rc(tid * 16 + i * 8192, R, C); gi[h][i] = idxsrc[(ui + 1) * 256 + h * 128 + R]; } } }
            PG8_LDA(At, 0, 1); PG8_STAGE(PG8_SB(0, 0), b2, PG8_VB(0)); PG8_STAGE(PG8_SB(0, 1), b2 + hB2, PG8_VB(1));
            if constexpr (GATHER) { if (sw) {
#pragma unroll
                for (int h = 0; h < 2; ++h)
#pragma unroll
                    for (int i = 0; i < 2; ++i) { int R, C; stage_rc(tid * 16 + i * 8192, R, C); voffA[h][i] = (unsigned)gi[h][i] * ldA + (unsigned)C * 2u; } } }
            PG8_STAGE(PG8_SA(0, 0), a2, PG8_VA(0));
            PG8_WAIT_V(8); PG8_WAIT_L(0); PG8_BAR; PG8_MMA(1, 0, At, B0); PG8_MMA(1, 1, At, B1); PG8_BAR; PG8_SCHED;
            PG8_LDB(B0, 1, 0); PG8_LDB(B1, 1, 1); PG8_SCHED; PG8_LDA(At, 1, 0); PG8_STAGE(PG8_SA(0, 1), a2 + hA2, PG8_VA(1));
            PG8_WAIT_V(8); PG8_WAIT_L(0); PG8_BAR; PG8_MMA(0, 0, At, B0); PG8_MMA(0, 1, At, B1); PG8_BAR; PG8_SCHED;
            PG8_LDA(At, 1, 1); PG8_STAGE(PG8_SB(1, 0), b3, PG8_VB(0)); PG8_STAGE(PG8_SB(1, 1), b3 + hB2, PG8_VB(1)); PG8_STAGE(PG8_SA(1, 0), a3, PG8_VA(0));
            PG8_WAIT_V(8); PG8_WAIT_L(0); PG8_BAR; PG8_MMA(1, 0, At, B0); PG8_MMA(1, 1, At, B1); PG8_BAR; PG8_SCHED;
            } else {
            PG8_LDB(B0, 0, 0); PG8_SCHED; PG8_LDA(At, 0, 0); PG8_STAGE(PG8_SA(1, 1), a1 + chA, PG8_VA(1));
            PG8_WAIT_L(8); PG8_BAR; PG8_WAIT_L(0); PG8_MMA(0, 0, At, B0); PG8_BAR; PG8_SCHED;
            if constexpr (GATHER) { if (sw) {
#pragma unroll
                for (int h = 0; h < 2; ++h)
#pragma unroll
                    for (int i = 0; i < 2; ++i) { int R, C; stage_rc(tid * 16 + i * 8192, R, C); gi[h][i] = idxsrc[(ui + 1) * 256 + h * 128 + R]; } } }
            PG8_LDB(B1, 0, 1); PG8_STAGE(PG8_SB(0, 0), b2, PG8_VB(0));
            PG8_BAR; PG8_WAIT_L(0); PG8_MMA(0, 1, At, B1); PG8_BAR;
            if constexpr (GATHER) { if (sw) {
#pragma unroll
                for (int h = 0; h < 2; ++h)
#pragma unroll
                    for (int i = 0; i < 2; ++i) { int R, C; stage_rc(tid * 16 + i * 8192, R, C); voffA[h][i] = (unsigned)gi[h][i] * ldA + (unsigned)C * 2u; } } }
            PG8_LDA(At, 0, 1); PG8_STAGE(PG8_SA(0, 0), a2, PG8_VA(0));
            PG8_BAR; PG8_WAIT_L(0); PG8_MMA(1, 0, At, B0); PG8_BAR; PG8_SCHED;
            PG8_STAGE(PG8_SB(0, 1), b2 + hB2, PG8_VB(1));
            PG8_WAIT_V(6); PG8_BAR; PG8_MMA(1, 1, At, B1); PG8_BAR;
            PG8_LDB(B0, 1, 0); PG8_SCHED; PG8_LDA(At, 1, 0); PG8_STAGE(PG8_SA(0, 1), a2 + hA2, PG8_VA(1));
            PG8_WAIT_L(8); PG8_BAR; PG8_WAIT_L(0); PG8_MMA(0, 0, At, B0); PG8_BAR; PG8_SCHED;
            PG8_LDB(B1, 1, 1); PG8_STAGE(PG8_SB(1, 0), b3, PG8_VB(0));
            PG8_BAR; PG8_WAIT_L(0); PG8_MMA(0, 1, At, B1); PG8_BAR;
            PG8_LDA(At, 1, 1); PG8_STAGE(PG8_SA(1, 0), a3, PG8_VA(0));
            PG8_BAR; PG8_WAIT_L(0); PG8_MMA(1, 0, At, B0); PG8_BAR; PG8_SCHED;
            PG8_STAGE(PG8_SB(1, 1), b3 + hB2, PG8_VB(1));
            PG8_WAIT_V(6); PG8_BAR; PG8_MMA(1, 1, At, B1); PG8_BAR;
            }
        }
        if constexpr (ALIGN_EPI) { if (wr == 0) PG8_BAR; }
        if constexpr (FP8) asm volatile("s_nop 15\n\ts_nop 15" ::: "memory");
        E(acc, cur, ui, wr, wc, fr, fq);
        if (!has_next) break;
#pragma unroll
        for (int a = 0; a < 2; ++a)
#pragma unroll
            for (int b = 0; b < 2; ++b)
#pragma unroll
                for (int m = 0; m < 4; ++m)
#pragma unroll
                    for (int n = 0; n < 2; ++n) acc[a][b][m][n] = (f32x4){0.f, 0.f, 0.f, 0.f};
        cur = nxt; cA = nA; cB = nB; chA = nhA; chB = nhB; ++ui;
        if constexpr (ALIGN_EPI) { if (wr == 1) PG8_BAR; }
    }
    PG8_WAIT_V(0);
    if constexpr (!ALIGN_EPI) { if (wr == 0) PG8_BAR; }
    PG8_BAR;
#undef PG8_SA
#undef PG8_SB
#undef PG8_STAGE
#undef PG8_LDA
#undef PG8_LDB
#undef PG8_MMA
#undef PG8_WAIT_V
#undef PG8_WAIT_L
#undef PG8_BAR
#undef PG8_SCHED
#undef PG8_VA
#undef PG8_VB
}
}
using gm::Unit;

struct Params { const float* in[13]; float* out; unsigned char* ws; int ph_lo, ph_hi; };

struct SchedPlain {
    gm::GridOrder o; const char* A; const char* B; unsigned ldA, ldB; bool p16 = false;
    __device__ __forceinline__ bool next(int i, Unit& u) const { int pm, pn; if (!o.mn(i, pm, pn)) return false;
        u.pm = pm; u.pn = pn; u.x0 = 0; u.x1 = 0; u.A = A + (size_t)pm * 256 * ldA; u.hsA = 128u * ldA; u.B = B + (size_t)pn * 256 * ldB; u.hsB = p16 ? 0u : 128u * ldB; return true; }
};
struct SchedG1 {
    gm::GridOrder o; const char* WinT; const char* xb;
    __device__ __forceinline__ bool next(int i, Unit& u) const { int pm, pn; if (!o.mn(i, pm, pn)) return false;
        const int b = pn >> 5, j = pn & 31; u.pm = pm; u.pn = pn; u.x0 = b; u.x1 = j;
        u.A = WinT + (size_t)pm * 256 * 1024; u.hsA = 128u * 1024u; u.B = xb + ((size_t)(b * SEQ + 2 * j)) * 1024; u.hsB = 1024u; return true; }
};
struct SchedS1 {
    int G, c; const char* F1; const char* Ut;
    __device__ __forceinline__ bool next(int i, Unit& u) const { const int L = i * G + c; if (L >= 1024) return false;
        u.pm = 0; u.pn = L; u.x0 = 0; u.x1 = 0; u.A = F1; u.hsA = 128u * 256u; u.B = Ut + (size_t)L * 256 * 256; u.hsB = 128u * 256u; return true; }
};
struct SchedS2 {
    gm::GridOrder o; const char* F2; const char* A1;
    __device__ __forceinline__ bool next(int i, Unit& u) const { int pm, pn; if (!o.mn(i, pm, pn)) return false;
        const int g = pm, b = pn >> 2, ct = pn & 3; u.pm = g; u.pn = ct; u.x0 = b; u.x1 = g;
        u.A = F2 + (size_t)g * 256 * 256; u.hsA = 128u * 256u; u.B = A1 + ((size_t)((b * 64 + g) * 1024 + ct * 256)) * 256; u.hsB = 0u; return true; }
};
__device__ __forceinline__ int expert_of_tile(const LAS int* ts, int pm) {
    const int ln = (int)__builtin_amdgcn_mbcnt_hi(~0u, __builtin_amdgcn_mbcnt_lo(~0u, 0u));
    const int v = ts[ln & 31];
    return (int)__builtin_popcountll(__ballot((ln >= 1) && (ln < 32) && (v <= pm)));
}
struct SchedMoe {
    gm::GridOrder o; const LAS int* ts; const char* A; const char* W; size_t wstride; unsigned ldB; bool hsB128; unsigned tileA;
    __device__ __forceinline__ bool next(int i, Unit& u) const { int pm, pn; if (!o.mn(i, pm, pn)) return false;
        const int e = expert_of_tile(ts, pm);
        u.pm = pm; u.pn = pn; u.x0 = e; u.x1 = pm - ts[e]; u.A = A + (size_t)pm * tileA; u.hsA = tileA >> 1; u.B = W + (size_t)e * wstride + (size_t)pn * 256 * ldB; u.hsB = hsB128 ? 128u * ldB : 0u; return true; }
};

typedef f32x4 Acc[2][2][4][2];
struct EpiRow {
    static constexpr bool PERM = true;
    bf16_t* O; size_t ld; int split_tiles; size_t split_stride; float scale0, scale1;
    __device__ __forceinline__ void operator()(const Acc& acc, const Unit& u, int, int wr, int wc, int fr, int fq) const {
        int pn = u.pn; bf16_t* base = O; float sc = scale0;
        if (split_tiles) { const int t = pn / split_tiles; base += (size_t)t * split_stride; pn -= t * split_tiles; if (t != 0) sc = scale1; }
        const size_t row0 = (size_t)u.pm * 256 + wr * 64 + fr; const int col0 = pn * 256 + wc * 32 + 8 * fq;
#pragma unroll
        for (int ai = 0; ai < 2; ++ai)
#pragma unroll
            for (int m = 0; m < 4; ++m) { bf16_t* rowp = base + (row0 + ai * 128 + m * 16) * ld + col0;
#pragma unroll
                for (int bj = 0; bj < 2; ++bj) *(u32x4*)(rowp + bj * 128) = pack8(acc[ai][bj][m][0] * sc, acc[ai][bj][m][1] * sc); }
    }
};
struct EpiRow8 {
    static constexpr bool PERM = true, PERM16 = true;
    unsigned char* O; size_t ld; int split_tiles; size_t split_stride; float scale0, scale1;
    __device__ __forceinline__ void operator()(const Acc& acc, const Unit& u, int, int wr, int wc, int fr, int fq) const {
        int pn = u.pn; unsigned char* base = O; float sc = scale0;
        if (split_tiles) { const int t = pn / split_tiles; base += (size_t)t * split_stride; pn -= t * split_tiles; if (t != 0) sc = scale1; }
        const size_t row0 = (size_t)u.pm * 256 + wr * 64 + fr; const int col0 = pn * 256 + wc * 64 + 16 * fq;
#pragma unroll
        for (int ai = 0; ai < 2; ++ai)
#pragma unroll
            for (int m = 0; m < 4; ++m) { u32x4 w;
                { const f32x4 v = acc[ai][0][m][0] * sc; w.x = pk4_fp8(v[0], v[1], v[2], v[3]); } { const f32x4 v = acc[ai][0][m][1] * sc; w.y = pk4_fp8(v[0], v[1], v[2], v[3]); }
                { const f32x4 v = acc[ai][1][m][0] * sc; w.z = pk4_fp8(v[0], v[1], v[2], v[3]); } { const f32x4 v = acc[ai][1][m][1] * sc; w.w = pk4_fp8(v[0], v[1], v[2], v[3]); }
                *(u32x4*)(base + (row0 + ai * 128 + m * 16) * ld + col0) = w; }
    }
};
struct EpiG1 {
    static constexpr bool PERM = true;
    bf16_t* Ut; float sc;
    __device__ __forceinline__ void operator()(const Acc& acc, const Unit& u, int, int wr, int wc, int fr, int fq) const {
#pragma unroll
        for (int ai = 0; ai < 2; ++ai)
#pragma unroll
            for (int m = 0; m < 4; ++m) { const int c = u.pm * 256 + ai * 128 + wr * 64 + m * 16 + fr;
#pragma unroll
                for (int bj = 0; bj < 2; ++bj) { const int s2 = 2 * u.x1 + bj;
                    *(u32x4*)(Ut + (((size_t)(u.x0 * 1024 + c) * 64 + s2) * 128 + wc * 32 + 8 * fq)) = pack8(acc[ai][bj][m][0] * sc, acc[ai][bj][m][1] * sc); } }
    }
};
struct EpiS1 {
    static constexpr bool PERM = true;
    bf16_t* A1;
    __device__ __forceinline__ void operator()(const Acc& acc, const Unit& u, int, int wr, int wc, int fr, int fq) const {
#pragma unroll
        for (int m = 0; m < 4; ++m) { const int m1 = wr * 64 + m * 16 + fr, g = m1 >> 1, ri = m1 & 1;
#pragma unroll
            for (int bj = 0; bj < 2; ++bj) { const int nrow = u.pn * 256 + bj * 128 + wc * 32 + 8 * fq, s2 = nrow & 63, c = (nrow >> 6) & 1023, b = nrow >> 16;
                *(u32x4*)(A1 + ((size_t)((b * 64 + g) * 1024 + c) * 128 + ri * 64 + s2)) = pack8(acc[0][bj][m][0], acc[0][bj][m][1]); } }
    }
};
struct EpiS2 {
    static constexpr bool PERM = true, PERM16 = true;
    unsigned char* Y;
    __device__ __forceinline__ void operator()(const Acc& acc, const Unit& u, int, int wr, int wc, int fr, int fq) const {
        const int g = u.x1, b = u.x0;
#pragma unroll
        for (int ai = 0; ai < 2; ++ai)
#pragma unroll
            for (int m = 0; m < 4; ++m) { const int mm = wr * 64 + m * 16 + fr, k2 = mm >> 1, rip = mm & 1;
                const int k1 = ai ? (g ? 128 - g : 64) : g, k = k1 + 128 * k2;
                { const int c = u.pn * 256 + wc * 64 + 16 * fq; u32x4 w;
                    { const f32x4 v = acc[ai][0][m][0] * Y_SCALE; w.x = pk4_fp8(v[0], v[1], v[2], v[3]); } { const f32x4 v = acc[ai][0][m][1] * Y_SCALE; w.y = pk4_fp8(v[0], v[1], v[2], v[3]); }
                    { const f32x4 v = acc[ai][1][m][0] * Y_SCALE; w.z = pk4_fp8(v[0], v[1], v[2], v[3]); } { const f32x4 v = acc[ai][1][m][1] * Y_SCALE; w.w = pk4_fp8(v[0], v[1], v[2], v[3]); }
                    *(u32x4*)(Y + ((size_t)(b * SEQ + k) * 2048 + rip * 1024 + c)) = w; } }
    }
};
struct EpiGU {
    static constexpr bool PERM = true;
    unsigned char* Hb; const LAS int* idxdst;
    __device__ __forceinline__ void operator()(const Acc& acc, const Unit& u, int ui, int wr, int wc, int fr, int fq) const {
#pragma unroll
        for (int ai = 0; ai < 2; ++ai)
#pragma unroll
            for (int m = 0; m < 4; ++m) { const int a = idxdst[ui * 256 + ai * 128 + wr * 64 + m * 16 + fr];
                if (a >= 0) { f32x4 h0, h1;
#pragma unroll
                    for (int j = 0; j < 4; ++j) { h0[j] = silu_mul(acc[ai][0][m][0][j] * (1.0f / W_SCALE), acc[ai][1][m][0][j] * (H_SCALE / W_SCALE)); h1[j] = silu_mul(acc[ai][0][m][1][j] * (1.0f / W_SCALE), acc[ai][1][m][1][j] * (H_SCALE / W_SCALE)); }
                    u32x2 w; w.x = pk4_fp8(h0[0], h0[1], h0[2], h0[3]); w.y = pk4_fp8(h1[0], h1[1], h1[2], h1[3]);
                    *(u32x2*)(Hb + ((size_t)(u.pm * 256 + ai * 128 + wr * 64 + m * 16 + fr) * DEX + u.pn * 128 + wc * 32 + 8 * fq)) = w; } }
    }
};
struct EpiDown {
    static constexpr bool PERM = true, PERM16 = true;
    unsigned char* ys; const LAS int* idxdst;
    __device__ __forceinline__ void operator()(const Acc& acc, const Unit& u, int ui, int wr, int wc, int fr, int fq) const {
#pragma unroll
        for (int ai = 0; ai < 2; ++ai)
#pragma unroll
            for (int m = 0; m < 4; ++m) { const int a = idxdst[ui * 256 + ai * 128 + wr * 64 + m * 16 + fr];
                if (a >= 0) { constexpr float sc = YS_SCALE / (W_SCALE * H_SCALE); u32x4 w;
                    { const f32x4 v = acc[ai][0][m][0] * sc; w.x = pk4_fp8(v[0], v[1], v[2], v[3]); } { const f32x4 v = acc[ai][0][m][1] * sc; w.y = pk4_fp8(v[0], v[1], v[2], v[3]); }
                    { const f32x4 v = acc[ai][1][m][0] * sc; w.z = pk4_fp8(v[0], v[1], v[2], v[3]); } { const f32x4 v = acc[ai][1][m][1] * sc; w.w = pk4_fp8(v[0], v[1], v[2], v[3]); }
                    *(u32x4*)(ys + ((size_t)a * DM + u.pn * 256 + wc * 64 + 16 * fq)) = w; } }
    }
};

struct TileDesc { const float* src; unsigned char* dst; int C, r0, c0, dld, kind; };
__device__ __forceinline__ TileDesc tile_desc(const Params& p, int tt) {
    TileDesc d; d.kind = 3; unsigned char* ws = p.ws;
    if (tt < 256) { d.src = p.in[1]; d.C = 1024; d.r0 = (tt >> 5) * 128; d.c0 = (tt & 31) * 32; d.dst = ws + WS_WIN; d.dld = 1024; }
    else if (tt < 1024) { const int t2 = tt - 256; d.src = p.in[3]; d.C = 3072; d.r0 = (t2 / 96) * 128; d.c0 = (t2 % 96) * 32; d.dst = ws + WS_WQKV; d.dld = 1024; }
    else if (tt < 1280) { const int t2 = tt - 1024; d.src = p.in[5]; d.C = 1024; d.r0 = (t2 >> 5) * 128; d.c0 = (t2 & 31) * 32; d.dst = ws + WS_WO; d.dld = 1024; }
    else { const int t3 = tt - 1280, ee = t3 >> 7, tl = t3 & 127, mat = ee & 63; d.kind = ee >> 6;
        if (d.kind < 2) { d.src = (d.kind == 0 ? p.in[8] : p.in[9]) + (size_t)mat * 1024 * 512; d.C = 512; d.r0 = (tl >> 4) * 128; d.c0 = (tl & 15) * 32; d.dst = ws + WS_WGU + (size_t)mat * 1024 * 1024; d.dld = 1024; }
        else { d.src = p.in[10] + (size_t)mat * 512 * 1024; d.C = 1024; d.r0 = (tl >> 5) * 128; d.c0 = (tl & 31) * 32; d.dst = ws + WS_WD + (size_t)mat * 1024 * 512; d.dld = 512; } }
    return d;
}
__device__ __forceinline__ void tile_load(const TileDesc& d, f32x4 (&v)[16], int lane) {
#pragma unroll
    for (int ps = 0; ps < 16; ++ps) v[ps] = __builtin_nontemporal_load((const f32x4*)(d.src + (size_t)(d.r0 + ps * 8 + (lane >> 3)) * d.C + d.c0 + (lane & 7) * 4));
}
__device__ __forceinline__ void tile_store(const TileDesc& d, const f32x4 (&v)[16], LAS float* tile, int lane) {
#pragma unroll
    for (int ps = 0; ps < 16; ++ps) { const int row = ps * 8 + (lane >> 3), col4 = (lane & 7) * 4;
        tile[row * 33 + col4 + 0] = v[ps][0]; tile[row * 33 + col4 + 1] = v[ps][1]; tile[row * 33 + col4 + 2] = v[ps][2]; tile[row * 33 + col4 + 3] = v[ps][3]; }
    __builtin_amdgcn_fence(__ATOMIC_RELEASE, "wavefront"); __builtin_amdgcn_wave_barrier(); __builtin_amdgcn_fence(__ATOMIC_ACQUIRE, "wavefront");
#pragma unroll
    for (int ps = 0; ps < 4; ++ps) { const int n = ps * 8 + (lane >> 3), kc = (lane & 7) * 16; float a[16];
#pragma unroll
        for (int j = 0; j < 16; ++j) a[j] = tile[(kc + j) * 33 + n] * W_SCALE;
        const int nn = d.c0 + n; const int drow = (d.kind == 0 || d.kind == 1) ? (256 * (nn >> 7) + (nn & 127) + 128 * d.kind) : nn;
        u32x4 w; w.x = pk4_fp8(a[0], a[1], a[2], a[3]); w.y = pk4_fp8(a[4], a[5], a[6], a[7]); w.z = pk4_fp8(a[8], a[9], a[10], a[11]); w.w = pk4_fp8(a[12], a[13], a[14], a[15]);
        *(u32x4*)(d.dst + (size_t)drow * d.dld + d.r0 + kc) = w; }
    __builtin_amdgcn_fence(__ATOMIC_RELEASE, "wavefront"); __builtin_amdgcn_wave_barrier(); __builtin_amdgcn_fence(__ATOMIC_ACQUIRE, "wavefront");
}

__device__ __forceinline__ void transpose_share(const Params& p, LAS unsigned char* lds, int wid, int lane, int nslot, int slot0) {
    LAS float* tile = (LAS float*)lds + wid * (128 * 33); constexpr int NT = 1280 + 192 * 128; const int G = gridDim.x;
    for (int rnd = 0; (rnd * G) * 22 < NT; ++rnd) { const int base = (rnd * G + (int)blockIdx.x) * 22 + slot0;
        const int t0 = base, t1 = base + 1, t2 = base + 2;
        if (t0 < NT) { const bool two = t1 < NT; const TileDesc d0 = tile_desc(p, t0), d1 = tile_desc(p, two ? t1 : t0);
            f32x4 v0[16], v1[16]; tile_load(d0, v0, lane); tile_load(d1, v1, lane);
            tile_store(d0, v0, tile, lane); if (two) tile_store(d1, v1, tile, lane); }
        if (nslot > 2 && t2 < NT) { const TileDesc d2 = tile_desc(p, t2); f32x4 v2[16]; tile_load(d2, v2, lane); tile_store(d2, v2, tile, lane); } }
}
__device__ __forceinline__ void phase_prologue(const Params& p, LAS unsigned char* lds) {
    const int tid = tid_fresh(), lane = tid & 63, wid = __builtin_amdgcn_readfirstlane(tid >> 6); unsigned char* ws = p.ws;
    if (wid < 6) {
        { const float* x = p.in[0]; unsigned char* xb = (unsigned char*)(ws + WS_S0); bf16_t* xh = (bf16_t*)p.out; const size_t stride = (size_t)gridDim.x * 384 * 8, total = (size_t)T * DM;
          for (size_t i = ((size_t)blockIdx.x * 384 + tid) * 8; i < total; i += 4 * stride) {
              f32x4 a[4], b[4];
#pragma unroll
              for (int u = 0; u < 4; ++u) { const size_t o = i + u * stride < total ? i + u * stride : i; a[u] = __builtin_nontemporal_load((const f32x4*)(x + o)); b[u] = __builtin_nontemporal_load((const f32x4*)(x + o + 4)); }
#pragma unroll
              for (int u = 0; u < 4; ++u) if (i + u * stride < total) { u32x2 w; w.x = pk4_fp8(a[u][0], a[u][1], a[u][2], a[u][3]); w.y = pk4_fp8(b[u][0], b[u][1], b[u][2], b[u][3]); *(u32x2*)(xb + i + u * stride) = w;
                  *(u32x4*)(xh + i + u * stride) = pack8(a[u], b[u]); } } }
        transpose_share(p, lds, wid, lane, 3, 3 * wid);
    } else {
        const int gw = blockIdx.x * 2 + (wid - 6), gl = gw * 64 + lane;
        { bf16_t* F1 = (bf16_t*)(ws + WS_F1); bf16_t* F2 = (bf16_t*)(ws + WS_F2);
          { const int idx = gl; const int m1 = idx >> 7, s1 = idx & 127; float v = 0.f;
            if (m1 < 128) { const int g = m1 >> 1, ri = m1 & 1;
                if (g == 0) v = ri ? ((s1 & 1) ? -1.f : 1.f) : 1.f;
                else { const float ph = (float)((s1 * g) & 127) * (1.0f / 128.0f); v = ri ? -__builtin_amdgcn_sinf(ph) : __builtin_amdgcn_cosf(ph); } }
            F1[idx] = (bf16_t)(cvt_pk_bf16(v, 0.f) & 0xffffu); }
          const float sc = 0.011048543456039806f;
          for (int idx = gl; idx < 64 * 256 * 128; idx += 32768) { const int g = idx >> 15, m2 = (idx >> 7) & 255, kk = idx & 127;
              const int hsel = m2 >> 7, k2 = (m2 & 127) >> 1, rip = m2 & 1, slot = kk >> 6, s2 = kk & 63;
              const int k1 = hsel ? (g ? 128 - g : 64) : g, k = k1 + 128 * k2;
              const float ph = (float)((s2 * k) & 8191) * (1.0f / 8192.0f); const float cs = __builtin_amdgcn_cosf(ph), sn = __builtin_amdgcn_sinf(ph);
              float v;
              if (g == 0) { v = (slot == hsel) ? (rip ? -sn : cs) : 0.f; }
              else if (hsel == 0) { v = rip ? (slot ? cs : -sn) : (slot ? sn : cs); }
              else { v = rip ? (slot ? -cs : -sn) : (slot ? -sn : cs); }
              F2[idx] = (bf16_t)(cvt_pk_bf16(v * sc, 0.f) & 0xffffu); } }
        { LAS float* ctab = (LAS float*)(lds + 135168) + (wid - 6) * 512; LAS float* stab = ctab + 256; const float* wout = p.in[2]; unsigned char* W2 = (unsigned char*)(ws + WS_W2);
#pragma unroll
          for (int u = 0; u < 4; ++u) { const float ph = (float)(lane + 64 * u) * (1.0f / 256.0f); ctab[lane + 64 * u] = __builtin_amdgcn_cosf(ph); stab[lane + 64 * u] = __builtin_amdgcn_sinf(ph); }
          __builtin_amdgcn_fence(__ATOMIC_RELEASE, "wavefront"); __builtin_amdgcn_wave_barrier(); __builtin_amdgcn_fence(__ATOMIC_ACQUIRE, "wavefront");
          for (int item = gw; item < 4 * 4 * 64; item += 512) { const int gp = item >> 8, cq = (item >> 6) & 3, n0 = (item & 63) * 16, c = cq * 64 + lane;
              float ac[16], as[16];
#pragma unroll
              for (int j = 0; j < 16; ++j) { ac[j] = 0.f; as[j] = 0.f; }
              const float* wrow = wout + (size_t)(gp * 256) * 1024 + n0 + (lane & 15);
#pragma unroll 4
              for (int k2 = 0; k2 < 256; ++k2) { const int ix = (c * k2) & 255; const float cv = ctab[ix], sv = stab[ix]; const float wv = wrow[(size_t)k2 * 1024];
#pragma unroll
                  for (int j = 0; j < 16; ++j) { const float w = __builtin_bit_cast(float, __builtin_amdgcn_readlane(__builtin_bit_cast(int, wv), j)); ac[j] += cv * w; as[j] += sv * w; } }
#pragma unroll
              for (int j = 0; j < 16; ++j) { unsigned char* o = W2 + (size_t)(n0 + j) * 2048 + gp * 256 + c;
                  o[0] = (unsigned char)(pk4_fp8(ac[j] * (0.0625f * W2_SCALE), 0.f, 0.f, 0.f) & 0xffu); o[1024] = (unsigned char)(pk4_fp8(as[j] * (0.0625f * W2_SCALE), 0.f, 0.f, 0.f) & 0xffu); } } }
        transpose_share(p, lds, wid, lane, 2, 18 + 2 * (wid - 6));
    }
    __syncthreads();
}

typedef _Float16 f16x8 __attribute__((ext_vector_type(8)));
typedef _Float16 f16x4 __attribute__((ext_vector_type(4)));
constexpr int LA_HT = 0, LA_RED = 65536, LA_SEL = 65536 + 32768, LA_ASG = LA_SEL + 8192, LA_MISC = LA_ASG + 1024;
__device__ __forceinline__ void phase_lnA(const Params& p, LAS unsigned char* lds, const int L, const bf16_t* res16, const bf16_t* ybuf, bf16_t* hb, unsigned char* h8) {
    const int tid = tid_fresh(), lane = tid & 63, wid = __builtin_amdgcn_readfirstlane(tid >> 6), fr = lane & 15, fq = lane >> 4;
    unsigned char* ws = p.ws;
    LAS unsigned char* ht = lds + LA_HT;
    LAS float* red = (LAS float*)(lds + LA_RED);
    LAS float* selL = (LAS float*)(lds + LA_SEL);
    LAS int* asgE = (LAS int*)(lds + LA_ASG);
    LAS int* misc = (LAS int*)(lds + LA_MISC);
    f16x8 wf[2][4];
    { const float* wrg = p.in[6];
#pragma unroll
      for (int eb = 0; eb < 2; ++eb)
#pragma unroll
          for (int sx = 0; sx < 4; ++sx)
#pragma unroll
              for (int j = 0; j < 8; ++j) wf[eb][sx][j] = (_Float16)wrg[(size_t)(128 * wid + 32 * sx + 8 * fq + j) * 32 + fr + 16 * eb]; }
    const float* lg = p.in[11] + (L * 2 + 0) * 1024; const float* lb = p.in[12] + (L * 2 + 0) * 1024;
    f32x4 gv[4], bv[4];
#pragma unroll
    for (int k = 0; k < 4; ++k) { gv[k] = *(const f32x4*)(lg + 512 * (k >> 1) + 8 * lane + 4 * (k & 1)); bv[k] = *(const f32x4*)(lb + 512 * (k >> 1) + 8 * lane + 4 * (k & 1)); }
    const float br = p.in[7][tid & 31];
    float* gates = (float*)(ws + WS_GATE);
    const int tok0 = blockIdx.x * 128;
#ifndef LNA_REP
#define LNA_REP 1
#endif
    u32x4 rx16[4][2], ryw[4][2];
#define LA_LOAD(gg) do { _Pragma("unroll") for (int tk = 0; tk < 4; ++tk) { const size_t rowo_ = (size_t)(tok0 + (gg) * 32 + 4 * wid + tk) * DM; _Pragma("unroll") for (int jj = 0; jj < 2; ++jj) { const size_t co_ = rowo_ + 512 * jj + 8 * lane; \
        rx16[tk][jj] = *(const u32x4*)(res16 + co_); ryw[tk][jj] = *(const u32x4*)(ybuf + co_); } } } while (0)
    LA_LOAD(0);
#pragma unroll 1
    for (int g_ = 0; g_ < 4 * LNA_REP; ++g_) { const int g = g_ & 3;
        f32x4 hv[4][4];
#pragma unroll
        for (int tk = 0; tk < 4; ++tk) {
#pragma unroll
            for (int jj = 0; jj < 2; ++jj) { f32x4 xa, xb2, ya, yb; bf8_to_f32(rx16[tk][jj], xa, xb2); bf8_to_f32(ryw[tk][jj], ya, yb);
                hv[tk][2 * jj] = ALPHA * xa + ya; hv[tk][2 * jj + 1] = ALPHA * xb2 + yb; } }
        float sm[4], qv[4];
#pragma unroll
        for (int tk = 0; tk < 4; ++tk) { float s = 0.f;
#pragma unroll
            for (int j = 0; j < 4; ++j) s += (hv[tk][j][0] + hv[tk][j][1]) + (hv[tk][j][2] + hv[tk][j][3]);
            sm[tk] = s; }
#pragma unroll
        for (int o = 32; o >= 1; o >>= 1) {
#pragma unroll
            for (int tk = 0; tk < 4; ++tk) sm[tk] += __shfl_xor(sm[tk], o); }
#pragma unroll
        for (int tk = 0; tk < 4; ++tk) { sm[tk] *= (1.0f / 1024.0f); float q = 0.f;
#pragma unroll
            for (int j = 0; j < 4; ++j) { const f32x4 d = hv[tk][j] - sm[tk]; q += (d[0] * d[0] + d[1] * d[1]) + (d[2] * d[2] + d[3] * d[3]); }
            qv[tk] = q; }
#pragma unroll
        for (int o = 32; o >= 1; o >>= 1) {
#pragma unroll
            for (int tk = 0; tk < 4; ++tk) qv[tk] += __shfl_xor(qv[tk], o); }
#pragma unroll
        for (int tk = 0; tk < 4; ++tk) { const int ts = 4 * wid + tk; const size_t rowo = (size_t)(tok0 + g * 32 + ts) * DM; const float rstd = 1.0f / sqrtf(qv[tk] * (1.0f / 1024.0f) + LN_EPS);
#pragma unroll
            for (int jj = 0; jj < 2; ++jj) { const size_t co = rowo + 512 * jj + 8 * lane;
                const f32x4 h0 = (hv[tk][2 * jj] - sm[tk]) * rstd * gv[2 * jj] + bv[2 * jj], h1 = (hv[tk][2 * jj + 1] - sm[tk]) * rstd * gv[2 * jj + 1] + bv[2 * jj + 1];
                *(u32x4*)(hb + co) = pack8(h0, h1);
                u32x2 w8; w8.x = pk4_fp8(h0[0], h0[1], h0[2], h0[3]); w8.y = pk4_fp8(h1[0], h1[1], h1[2], h1[3]); *(u32x2*)(h8 + co) = w8;
                const f16x8 hh = (f16x8){(_Float16)h0[0], (_Float16)h0[1], (_Float16)h0[2], (_Float16)h0[3], (_Float16)h1[0], (_Float16)h1[1], (_Float16)h1[2], (_Float16)h1[3]};
                const int chunk = (64 * jj + lane) ^ (ts & 15);
                *(LAS f16x8*)(ht + ts * 2048 + chunk * 16) = hh; } }
        if (g_ + 1 < 4 * LNA_REP) LA_LOAD((g_ + 1) & 3);
        __syncthreads();
#pragma unroll
        for (int tb = 0; tb < 2; ++tb) { f32x4 d0 = (f32x4){0.f, 0.f, 0.f, 0.f}, d1 = d0;
#pragma unroll
          for (int sx = 0; sx < 4; ++sx) { const int chunk = (16 * wid + 4 * sx + fq) ^ fr; const f16x8 hf = *(const LAS f16x8*)(ht + (16 * tb + fr) * 2048 + chunk * 16);
              d0 = __builtin_amdgcn_mfma_f32_16x16x32_f16(wf[0][sx], hf, d0, 0, 0, 0); d1 = __builtin_amdgcn_mfma_f32_16x16x32_f16(wf[1][sx], hf, d1, 0, 0, 0); }
          *(LAS f32x4*)(red + wid * 1024 + (16 * tb + fr) * 32 + 4 * fq) = d0; *(LAS f32x4*)(red + wid * 1024 + (16 * tb + fr) * 32 + 16 + 4 * fq) = d1; }
        __syncthreads();
#pragma unroll
        for (int u = 0; u < 2; ++u) { const int ix = tid + 512 * u; float lgt = 0.f;
#pragma unroll
          for (int w = 0; w < 8; ++w) lgt += red[w * 1024 + ix];
          const float sc = 1.0f / (1.0f + __expf(-lgt)); selL[ix] = sc + br; selL[1024 + ix] = sc; }
        __syncthreads();
        if (lane < 4) { const int tq = 4 * wid + lane; const LAS f32x4* sel4 = (const LAS f32x4*)(selL + tq * 32); float best = -3.0e38f; int bg = 0, b1 = 0, b2 = 0;
            f32x4 sv[8];
#pragma unroll
            for (int q = 0; q < 8; ++q) sv[q] = sel4[q];
#pragma unroll
            for (int gg = 0; gg < 4; ++gg) { float m1 = -3.0e38f, m2 = -3.0e38f; int i1 = 0, i2 = 0;
#pragma unroll
                for (int j = 0; j < 8; ++j) { const float v = sv[gg * 2 + (j >> 2)][j & 3]; const bool gt1 = v > m1, gt2 = v > m2;
                    m2 = gt1 ? m1 : (gt2 ? v : m2); i2 = gt1 ? i1 : (gt2 ? j : i2); m1 = gt1 ? v : m1; i1 = gt1 ? j : i1; }
                const float gs = m1 + m2; if (gs > best) { best = gs; bg = gg; b1 = i1; b2 = i2; } }
            const int e1 = bg * 8 + b1, e2 = bg * 8 + b2; const float s1 = selL[1024 + tq * 32 + e1], s2 = selL[1024 + tq * 32 + e2], inv = 1.0f / (s1 + s2);
            const int tl = g * 32 + tq; asgE[2 * tl] = e1; asgE[2 * tl + 1] = e2;
            const int t = tok0 + tl; gates[2 * t] = s1 * inv; gates[2 * t + 1] = s2 * inv; }
    }
    __syncthreads();
#undef LA_LOAD
    int my_e = 0, my_rank = 0; LAS int* cntW = misc + 32;
    if (tid < 256) { my_e = asgE[tid]; unsigned long long mym = 0ull; int cw = 0;
#pragma unroll
        for (int e = 0; e < 32; ++e) { const unsigned long long m = __ballot(my_e == e); if (my_e == e) mym = m; if (lane == e) cw = (int)__builtin_popcountll(m); }
        my_rank = (int)__builtin_popcountll(mym & ((1ull << lane) - 1ull));
        if (lane < 32) cntW[wid * 32 + lane] = cw; }
    __syncthreads();
    if (tid < 256) { for (int w = 0; w < 3; ++w) if (w < wid) my_rank += cntW[w * 32 + my_e]; }
    if (tid < 32) { const int c = cntW[tid] + cntW[32 + tid] + cntW[64 + tid] + cntW[96 + tid];
        unsigned* cnt = (unsigned*)(ws + WS_CTL) + CNT_WORD0 + (L * 32 + tid) * 64;
        misc[tid] = (int)__hip_atomic_fetch_add(cnt, (unsigned)c, __ATOMIC_RELAXED, __HIP_MEMORY_SCOPE_AGENT); }
    __syncthreads();
    if (tid < 256) { int* list = (int*)(ws + WS_LIST); list[(size_t)my_e * NASG + misc[my_e] + my_rank] = blockIdx.x * 256 + tid; }
    __syncthreads();
}

__device__ __forceinline__ void phase_lnB(const Params& p, const int L, const bf16_t* hb, const unsigned char* ys, bf16_t* xb_out, unsigned char* x8_out, float* f_out) {
    const int tid = tid_fresh(), lane = tid & 63, wid = tid >> 6;
    const float* lg = p.in[11] + (L * 2 + 1) * 1024; const float* lb = p.in[12] + (L * 2 + 1) * 1024;
    const float* gates = (const float*)(p.ws + WS_GATE);
    f32x4 gv[4], bv[4];
#pragma unroll
    for (int k = 0; k < 4; ++k) { gv[k] = *(const f32x4*)(lg + 512 * (k >> 1) + 8 * lane + 4 * (k & 1)); bv[k] = *(const f32x4*)(lb + 512 * (k >> 1) + 8 * lane + 4 * (k & 1)); }
    const int tok0 = blockIdx.x * 128 + wid * 16;
    u32x4 rh[2][2]; u32x2 ry0[2][2], ry1[2][2]; f32x2 rg[2];
#define LB_LOAD(tt) do { _Pragma("unroll") for (int u_ = 0; u_ < 2; ++u_) { const int t_ = (tt) + u_; const size_t ro_ = (size_t)t_ * DM; rg[u_] = *(const f32x2*)(gates + 2 * t_); _Pragma("unroll") for (int jj = 0; jj < 2; ++jj) { \
        const size_t co_ = 512 * jj + 8 * lane; rh[u_][jj] = *(const u32x4*)(hb + ro_ + co_); ry0[u_][jj] = *(const u32x2*)(ys + (size_t)(2 * t_) * DM + co_); ry1[u_][jj] = *(const u32x2*)(ys + (size_t)(2 * t_ + 1) * DM + co_); } } } while (0)
    LB_LOAD(tok0);
#pragma unroll 1
    for (int it = 0; it < 8; ++it) {
        u32x4 ch[2][2]; u32x2 cy0[2][2], cy1[2][2]; f32x2 cg[2];
#pragma unroll
        for (int u = 0; u < 2; ++u) { cg[u] = rg[u];
#pragma unroll
            for (int jj = 0; jj < 2; ++jj) { ch[u][jj] = rh[u][jj]; cy0[u][jj] = ry0[u][jj]; cy1[u][jj] = ry1[u][jj]; } }
        if (it < 7) LB_LOAD(tok0 + 2 * it + 2);
#pragma unroll
        for (int u = 0; u < 2; ++u) { const int t = tok0 + 2 * it + u; const size_t rowo = (size_t)t * DM; const float g0 = cg[u].x * (1.0f / YS_SCALE), g1 = cg[u].y * (1.0f / YS_SCALE);
            f32x4 v[4]; float s = 0.f;
#pragma unroll
            for (int jj = 0; jj < 2; ++jj) { f32x4 ha, hb2; bf8_to_f32(ch[u][jj], ha, hb2);
                const f32x4 ya = fp8x4_to_f32(cy0[u][jj].x), yb = fp8x4_to_f32(cy0[u][jj].y), za = fp8x4_to_f32(cy1[u][jj].x), zb = fp8x4_to_f32(cy1[u][jj].y);
                const f32x4 w0 = ALPHA * ha + g0 * ya + g1 * za, w1 = ALPHA * hb2 + g0 * yb + g1 * zb;
                v[2 * jj] = w0; v[2 * jj + 1] = w1; s += ((w0[0] + w0[1]) + (w0[2] + w0[3])) + ((w1[0] + w1[1]) + (w1[2] + w1[3])); }
            const float mean = wave_sum(s) * (1.0f / 1024.0f); float q = 0.f;
#pragma unroll
            for (int k = 0; k < 4; ++k) { const f32x4 d = v[k] - mean; q += (d[0] * d[0] + d[1] * d[1]) + (d[2] * d[2] + d[3] * d[3]); }
            const float rstd = 1.0f / sqrtf(wave_sum(q) * (1.0f / 1024.0f) + LN_EPS);
#pragma unroll
            for (int jj = 0; jj < 2; ++jj) { const size_t co = 512 * jj + 8 * lane;
                const f32x4 o0 = (v[2 * jj] - mean) * rstd * gv[2 * jj] + bv[2 * jj], o1 = (v[2 * jj + 1] - mean) * rstd * gv[2 * jj + 1] + bv[2 * jj + 1];
                if (f_out) { *(f32x4*)(f_out + rowo + co) = o0; *(f32x4*)(f_out + rowo + co + 4) = o1; }
                if (xb_out) { *(u32x4*)(xb_out + rowo + co) = pack8(o0, o1);
                    u32x2 w8; w8.x = pk4_fp8(o0[0], o0[1], o0[2], o0[3]); w8.y = pk4_fp8(o1[0], o1[1], o1[2], o1[3]); *(u32x2*)(x8_out + rowo + co) = w8; } } }
    }
#undef LB_LOAD
}

__device__ __forceinline__ void glds4(const char* sbase, unsigned voff, unsigned lds_dst) {
    unsigned keep;
    asm volatile("s_mov_b32 %0, m0\n\ts_mov_b32 m0, %3\n\ts_nop 0\n\tglobal_load_lds_dword %1, %2\n\ts_mov_b32 m0, %0" : "=&s"(keep) : "v"(voff), "s"(sbase), "s"(lds_dst) : "memory");
}
constexpr int A8_K = 0, A8_V = 81920, A8_RP = 122880, A8_KBUF = 40960;
__device__ __forceinline__ long mk64(unsigned lo, unsigned hi) { return (long)(((unsigned long long)hi << 32) | (unsigned long long)lo); }
__device__ __forceinline__ void phase_attn(const Params& p, LAS unsigned char* lds, const unsigned char* q8, const unsigned char* k8, const unsigned char* vt8, unsigned char* ob) {
    const int tid = tid_fresh(), lane = tid & 63, wid = __builtin_amdgcn_readfirstlane(tid >> 6), fr = lane & 15, fq = lane >> 4;
    const unsigned lds0 = (unsigned)(__UINTPTR_TYPE__)lds;
    const int item = (gridDim.x == 256) ? (int)((blockIdx.x & 7) * 32 + (blockIdx.x >> 3)) : (int)blockIdx.x, b = item >> 6, r0 = (item & 63) * 2;
    const int rsU = min(max(r0 - 4, 0), 118);
    const int r = r0 + (wid >> 2), jq = wid & 3;
    const int rs = min(max(r - 4, 0), 120), c0 = min(max(16 * jq - 8, 0), 32), lrow0 = rs - rsU;
    unsigned offK; { const int tokl = tid >> 2, pc = tid & 3, lc = pc ^ ((tokl >> 2) & 3); offK = (unsigned)(tokl * DM + lc * 16); }
    unsigned offV[5];
#pragma unroll
    for (int k = 0; k < 5; ++k) { const int q = k * 512 + tid, d = q / 40, pc = q - d * 40, lc = pc ^ (d & 7); offV[k] = (unsigned)(d * T + lc * 16); }
    const unsigned offR = (unsigned)min(wid * 64 + lane, 464) * 4u;
    const char* kbase0 = (const char*)k8 + ((size_t)(b * SEQ + rsU * 64) * DM);
    const char* vbase0 = (const char*)vt8 + ((size_t)(b * SEQ + rsU * 64));
    const char* rbase0 = (const char*)p.in[4];
    const size_t tokq = (size_t)b * SEQ + r * 64 + 16 * jq + fr;
    const char* qrow = (const char*)q8 + tokq * DM + 8 * fq;
#define AT_ISSUE_A(h, buf) do { const char* kb_ = kbase0 + (h) * 64; _Pragma("unroll") for (int k = 0; k < 5; ++k) gm::glds16(kb_ + (size_t)k * 131072, offK, lds0 + A8_K + (buf) * A8_KBUF + k * 8192 + wid * 1024); \
        glds4(rbase0 + (h) * 1860, offR, lds0 + A8_RP + (buf) * 2048 + wid * 256); } while (0)
#define AT_ISSUE_B(h) do { const char* vb_ = vbase0 + (size_t)(h) * 64 * T; _Pragma("unroll") for (int k = 0; k < 5; ++k) gm::glds16(vb_, offV[k], lds0 + A8_V + k * 8192 + wid * 1024); } while (0)
#define AT_LDQ(h, q0, q1) do { asm volatile("global_load_dwordx2 %0, %2, off\n\tglobal_load_dwordx2 %1, %2, off offset:32" : "=&v"(q0), "=&v"(q1) : "v"(qrow + (h) * 64) : "memory"); } while (0)
    const int swzk = ((c0 >> 2) + (fr >> 2)) & 3;
    const int kofs0 = (lrow0 * 64 + c0 + fr) * 64 + ((((fq >> 1) ^ swzk)) << 4) + (fq & 1) * 8, kofs1 = (lrow0 * 64 + c0 + fr) * 64 + (((((fq >> 1) ^ swzk)) ^ 2) << 4) + (fq & 1) * 8;
    int vo[8][2];
#pragma unroll
    for (int i = 0; i < 8; ++i)
#pragma unroll
        for (int hf = 0; hf < 2; ++hf) { const int tokoff = (lrow0 + i) * 64 + c0 + 4 * fq + 16 * hf; vo[i][hf] = fr * 640 + (((tokoff >> 4) ^ (fr & 7)) << 4) + (tokoff & 15); }
    const int qc = 16 * jq + fr, cs = min(max(qc - 8, 0), 48);
    long qn0, qn1;
    AT_LDQ(0, qn0, qn1);
    AT_ISSUE_A(0, 0); AT_ISSUE_B(0);
#pragma unroll 1
    for (int h = 0; h < 16; ++h) {
        const int hn = h < 15 ? h + 1 : 15, kb = h & 1;
        asm volatile("s_waitcnt vmcnt(5)" : "+v"(qn0), "+v"(qn1) :: "memory");
        const long q0 = qn0, q1 = qn1;
        __builtin_amdgcn_s_barrier();
        AT_LDQ(hn, qn0, qn1);
        AT_ISSUE_A(hn, kb ^ 1);
        f32x4 s[16];
#pragma unroll
        for (int kbi = 0; kbi < 16; ++kbi) { const int i = kbi >> 1, half = kbi & 1;
            const long k0 = *(const LAS long*)(lds + A8_K + kb * A8_KBUF + kofs0 + i * 4096 + half * 1024), k1 = *(const LAS long*)(lds + A8_K + kb * A8_KBUF + kofs1 + i * 4096 + half * 1024);
            f32x4 a = (f32x4){0.f, 0.f, 0.f, 0.f};
            a = __builtin_amdgcn_mfma_f32_16x16x32_fp8_fp8(k0, q0, a, 0, 0, 0); a = __builtin_amdgcn_mfma_f32_16x16x32_fp8_fp8(k1, q1, a, 0, 0, 0); s[kbi] = a; }
        const LAS float* rp = (const LAS float*)(lds + A8_RP + kb * 2048);
        float mx = -3.0e38f; const int thr = cs - c0;
#pragma unroll
        for (int i = 0; i < 8; ++i) { const int ri = rs + i - r + 7;
#pragma unroll
            for (int j = 0; j < 4; ++j) { const int pos = 4 * fq + j; const bool sel0 = pos >= thr; const int ci = min(max(c0 + pos - qc + 15 + (sel0 ? 0 : 16), 0), 30);
                float bvv = rp[ri * 31 + ci]; asm volatile("" : "+v"(bvv)); const float v = (sel0 ? s[2 * i][j] : s[2 * i + 1][j]) * 0.125f + bvv; s[2 * i][j] = v; mx = fmaxf(mx, v); } }
        mx = fmaxf(mx, __shfl_xor(mx, 16)); mx = fmaxf(mx, __shfl_xor(mx, 32));
        const float mxp = mx - 4.1588830833596715f;
        float sum = 0.f;
#pragma unroll
        for (int i = 0; i < 8; ++i)
#pragma unroll
            for (int j = 0; j < 4; ++j) { const int pos = 4 * fq + j; const bool sel0 = pos >= thr; const float e = __expf(s[2 * i][j] - mxp); sum += e; s[2 * i][j] = sel0 ? e : 0.f; s[2 * i + 1][j] = sel0 ? 0.f : e; }
        sum += __shfl_xor(sum, 16); sum += __shfl_xor(sum, 32);
        asm volatile("s_waitcnt vmcnt(8)" ::: "memory");
        __builtin_amdgcn_s_barrier();
        f32x4 oacc[4];
#pragma unroll
        for (int db = 0; db < 4; ++db) oacc[db] = (f32x4){0.f, 0.f, 0.f, 0.f};
#pragma unroll
        for (int i = 0; i < 8; ++i) { const long pf = mk64(pk4_fp8(s[2 * i][0], s[2 * i][1], s[2 * i][2], s[2 * i][3]), pk4_fp8(s[2 * i + 1][0], s[2 * i + 1][1], s[2 * i + 1][2], s[2 * i + 1][3]));
#pragma unroll
            for (int db = 0; db < 4; ++db) { const unsigned lo = *(const LAS unsigned*)(lds + A8_V + vo[i][0] + db * 10240), hi = *(const LAS unsigned*)(lds + A8_V + vo[i][1] + db * 10240);
                oacc[db] = __builtin_amdgcn_mfma_f32_16x16x32_fp8_fp8(mk64(lo, hi), pf, oacc[db], 0, 0, 0); } }
        asm volatile("s_waitcnt lgkmcnt(0)" ::: "memory");
        __builtin_amdgcn_s_barrier();
        AT_ISSUE_B(hn);
        const float inv = O_SCALE / sum;
#pragma unroll
        for (int db = 0; db < 4; ++db) *(unsigned*)(ob + tokq * DM + h * 64 + 16 * db + 4 * fq) = pk4_fp8(oacc[db][0] * inv, oacc[db][1] * inv, oacc[db][2] * inv, oacc[db][3] * inv);
    }
    asm volatile("s_waitcnt vmcnt(0)" ::: "memory");
    __builtin_amdgcn_s_barrier();
#undef AT_ISSUE_A
#undef AT_ISSUE_B
#undef AT_LDQ
}

template <int SRC_SHIFT>
__device__ __forceinline__ int moe_setup(const Params& p, LAS unsigned char* lds, const int L, LAS int* ts, LAS int* idxsrc, LAS int* idxdst) {
    const int tid = tid_fresh(), lane = tid & 63; unsigned char* ws = p.ws;
    LAS int* cn = ts + 40;
    if (tid < 64) {
        const int c = (int)__hip_atomic_load((unsigned*)(ws + WS_CTL) + CNT_WORD0 + (L * 32 + (lane & 31)) * 64, __ATOMIC_RELAXED, __HIP_MEMORY_SCOPE_AGENT);
        const int nt = (c + 255) >> 8; int incl = nt;
#pragma unroll
        for (int o = 1; o < 32; o <<= 1) { const int up = __shfl_up(incl, o); if ((lane & 31) >= o) incl += up; }
        if (lane < 32) { cn[lane] = c; ts[lane] = incl - nt; if (lane == 31) ts[32] = incl; } }
    __syncthreads();
    const int ntile = ts[NE];
    gm::GridOrder o; o.init(ntile, 4, gridDim.x, blockIdx.x);
    const int* list = (const int*)(ws + WS_LIST);
#pragma unroll
    for (int k = 0; k < 4; ++k) { const int ui = 2 * k + (tid >> 8), r = tid & 255; int pm = 0, pn = 0; const bool ok_u = o.mn(ui, pm, pn);
        const int e = expert_of_tile(ts, ok_u ? pm : 0);
        if (ok_u) { const int j = pm - ts[e], ce = cn[e]; const int pos = j * 256 + r; const bool ok = pos < ce; const int a = list[(size_t)e * NASG + (ok ? pos : j * 256)];
            idxsrc[ui * 256 + r] = a >> SRC_SHIFT; idxdst[ui * 256 + r] = ok ? a : -1; } }
    __syncthreads();
    return ntile;
}

__device__ __forceinline__ bool in_rng(int lo, int hi, int k) { asm volatile("" : "+s"(lo), "+s"(hi)); return lo <= k && k < hi; }
__device__ __forceinline__ Params params_fresh() {
    Params r{};
#if defined(__HIP_DEVICE_COMPILE__)
    auto k = __builtin_amdgcn_kernarg_segment_ptr(); asm volatile("" : "+s"(k));
    const __attribute__((address_space(4))) Params* kp = (const __attribute__((address_space(4))) Params*)k;
#pragma unroll
    for (int i = 0; i < 13; ++i) r.in[i] = kp->in[i];
    r.out = kp->out; r.ws = kp->ws; r.ph_lo = kp->ph_lo; r.ph_hi = kp->ph_hi;
#endif
    return r;
}
__global__ void __launch_bounds__(512, 2) k_fwd(Params p_unused) {
    extern __shared__ __attribute__((aligned(16))) unsigned char lds_raw[];
    LAS unsigned char* lds = (LAS unsigned char*)lds_raw;
    const Params p0 = params_fresh();
    { const int tid = tid_fresh(); if (tid < 4) ((LAS unsigned*)(lds + LDS_BARW))[tid] = 0u; }
    __syncthreads();
    XcdBarrier bar; bar.bar = (unsigned*)(p0.ws + WS_CTL); bar.x = 0; bar.st = nullptr;
    const int lo = p0.ph_lo, hi = p0.ph_hi;
    if (hi - lo > 1) bar = xcd_barrier_post((unsigned*)(p0.ws + WS_CTL), (volatile LAS unsigned*)(lds + LDS_BARW));
#ifndef PHMASK
#define PHMASK 0xffff
#endif
#define IN(k) (((PHMASK >> (k)) & 1) && in_rng(lo, hi, (k)))
#define SEAM(k) do { if (IN((k) + 1)) xcd_barrier(bar); } while (0)
#define PH_PTRS const Params p = params_fresh(); unsigned char* ws = p.ws; const int G = gridDim.x, cb = blockIdx.x; \
    bf16_t* S0 = (bf16_t*)(ws + WS_S0); bf16_t* S1 = (bf16_t*)(ws + WS_S1); bf16_t* S2 = (bf16_t*)(ws + WS_S2); bf16_t* S3 = (bf16_t*)(ws + WS_S3); \
    unsigned char* H8 = (unsigned char*)p.out + 64 * MiB; unsigned char* X8 = (unsigned char*)p.out + 96 * MiB; bf16_t* D0 = (bf16_t*)p.out; (void)X8; \
    LAS int* idxsrc = (LAS int*)(lds + LDS_IDX); LAS int* idxdst = idxsrc + 8 * 256; LAS int* tsm = (LAS int*)(lds + LDS_MISC); \
    (void)G; (void)cb; (void)S0; (void)S1; (void)S2; (void)S3; (void)H8; (void)D0; (void)idxsrc; (void)idxdst; (void)tsm;

    if (IN(0)) { PH_PTRS phase_prologue(p, lds); SEAM(0); }

#pragma unroll 1
    for (int L = 0; L < 2; ++L) {
        const int pb = 7 * L;
        if (L == 0) {
            if (IN(1)) {
                PH_PTRS SchedG1 S; S.o.init(4, 128, G, cb); S.WinT = (const char*)(ws + WS_WIN); S.xb = (const char*)S0; EpiG1 E{S1, 1.0f / W_SCALE};
                gm::gemm_phase<EpiG1, SchedG1, false, true>(lds, 1024, 1024u, 64u * 1024u, S, E, nullptr); SEAM(1); }
            if (IN(2)) {
                PH_PTRS SchedS1 S{G, cb, (const char*)(ws + WS_F1), (const char*)S1}; EpiS1 E{S0};
                gm::gemm_phase<EpiS1, SchedS1, false>(lds, 256, 256u, 256u, S, E, nullptr); SEAM(2); }
            if (IN(3)) {
                PH_PTRS SchedS2 S; S.o.init(64, 16, G, cb); S.F2 = (const char*)(ws + WS_F2); S.A1 = (const char*)S0; EpiS2 E{(unsigned char*)S1};
                gm::gemm_phase<EpiS2, SchedS2, false>(lds, 256, 256u, 256u, S, E, nullptr); SEAM(3); }
        } else {
            if (IN(9)) {
                PH_PTRS
                { SchedPlain S; S.o.init(128, 8, G, cb); S.A = (const char*)X8; S.B = (const char*)(ws + WS_WQKV); S.ldA = 1024u; S.ldB = 1024u; S.p16 = true; EpiRow8 E{(unsigned char*)S1, 1024, 4, (size_t)32 * MiB, 1.0f / W_SCALE, 1.0f / W_SCALE};
                  gm::gemm_phase<EpiRow8, SchedPlain, false, true>(lds, 1024, 1024u, 1024u, S, E, nullptr); }
                { SchedPlain S; S.o.init(4, 128, G, cb); S.A = (const char*)(ws + WS_WQKV) + (size_t)2048 * 1024; S.B = (const char*)X8; S.ldA = 1024u; S.ldB = 1024u; S.p16 = true; EpiRow8 E{(unsigned char*)S3, (size_t)T, 0, 0, 1.0f / W_SCALE, 1.0f / W_SCALE};
                  gm::gemm_phase<EpiRow8, SchedPlain, false, true>(lds, 1024, 1024u, 1024u, S, E, nullptr); }
                SEAM(9); }
            if (IN(10)) { PH_PTRS phase_attn(p, lds, (const unsigned char*)S1, (const unsigned char*)S1 + 32 * MiB, (const unsigned char*)S3, (unsigned char*)S0); SEAM(10); }
        }
        if (L == 0) { if (IN(4)) {
            PH_PTRS SchedPlain S; S.o.init(128, 4, G, cb); S.A = (const char*)S1; S.B = (const char*)(ws + WS_W2); S.ldA = 2048u; S.ldB = 2048u;
            EpiRow E{S0, 1024, 0, 0, 1.0f / (Y_SCALE * W2_SCALE), 1.f};
            gm::gemm_phase<EpiRow, SchedPlain, false, true>(lds, 2048, 2048u, 2048u, S, E, nullptr); SEAM(4); } }
        else { if (IN(11)) {
            PH_PTRS SchedPlain S; S.o.init(128, 4, G, cb); S.A = (const char*)S0; S.B = (const char*)(ws + WS_WO); S.ldA = 1024u; S.ldB = 1024u;
            EpiRow E{S1, 1024, 0, 0, 1.0f / (W_SCALE * O_SCALE), 1.f};
            gm::gemm_phase<EpiRow, SchedPlain, false, true>(lds, 1024, 1024u, 1024u, S, E, nullptr); SEAM(11); } }
        if (IN(5 + pb)) { PH_PTRS phase_lnA(p, lds, L, D0, L == 0 ? S0 : S1, S3, H8); SEAM(5 + pb); }
        if (IN(6 + pb)) {
            PH_PTRS const int ntile = moe_setup<1>(p, lds, L, tsm, idxsrc, idxdst);
            SchedMoe S; S.o.init(ntile, 4, G, cb); S.ts = tsm; S.A = (const char*)H8; S.W = (const char*)(ws + WS_WGU) + (size_t)L * 32 * 1024 * 1024; S.wstride = (size_t)1024 * 1024; S.ldB = 1024u; S.hsB128 = true; S.tileA = 0u;
            EpiGU E{(unsigned char*)S0, idxdst};
            gm::gemm_phase<EpiGU, SchedMoe, true, true>(lds, 1024, 1024u, 1024u, S, E, idxsrc); SEAM(6 + pb); }
        if (IN(7 + pb)) {
            PH_PTRS int ntile; if (IN(6 + pb)) { __syncthreads(); ntile = tsm[NE]; } else ntile = moe_setup<0>(p, lds, L, tsm, idxsrc, idxdst);
            SchedMoe S; S.o.init(ntile, 4, G, cb); S.ts = tsm; S.A = (const char*)S0; S.W = (const char*)(ws + WS_WD) + (size_t)L * 32 * 1024 * 512; S.wstride = (size_t)1024 * 512; S.ldB = 512u; S.hsB128 = false; S.tileA = 256u * 512u;
            EpiDown E{(unsigned char*)S1, idxdst};
            gm::gemm_phase<EpiDown, SchedMoe, false, true>(lds, 512, 512u, 512u, S, E, nullptr); SEAM(7 + pb); }
        if (IN(8 + pb)) { PH_PTRS phase_lnB(p, L, S3, (const unsigned char*)S1, L == 0 ? D0 : nullptr, X8, L == 0 ? nullptr : p.out); if (L == 0) SEAM(8); }
    }
#undef IN
#undef SEAM
#undef PH_PTRS
}

extern "C" void kernel_launch(void* const* d_in, const int* in_sizes, int n_in, void* d_out, int out_size, void* d_ws, size_t ws_size, hipStream_t stream) {
    static int grid = 0;
    if (grid == 0) {
        if (n_in != 13 || in_sizes[0] != T * DM || out_size != T * DM || ws_size < WS_END) { fprintf(stderr, "kernel_launch: unexpected shapes / workspace (%d inputs, in0 %d, out %d, ws %zu < %zu)\n", n_in, n_in > 0 ? in_sizes[0] : -1, out_size, ws_size, (size_t)WS_END); grid = -1; return; }
        int dev = 0, cus = 0, per_cu = 0;
        if (hipGetDevice(&dev) != hipSuccess || hipDeviceGetAttribute(&cus, hipDeviceAttributeMultiprocessorCount, dev) != hipSuccess) { grid = -1; return; }
        if (hipFuncSetAttribute((const void*)k_fwd, hipFuncAttributeMaxDynamicSharedMemorySize, LDS_BYTES) != hipSuccess) { fprintf(stderr, "kernel_launch: hipFuncSetAttribute failed\n"); grid = -1; return; }
        if (hipOccupancyMaxActiveBlocksPerMultiprocessor(&per_cu, (const void*)k_fwd, 512, LDS_BYTES) != hipSuccess || per_cu < 1) fprintf(stderr, "kernel_launch: occupancy query says %d\n", per_cu);
        (void)hipGetLastError();
        grid = cus;
    }
    if (grid < 0) return;
    (void)hipMemsetAsync((char*)d_ws + WS_CTL, 0, CTL_ZERO_BYTES, stream);
    Params a{};
    for (int i = 0; i < 13; ++i) a.in[i] = (const float*)d_in[i];
    a.out = (float*)d_out; a.ws = (unsigned char*)d_ws;
#if MK_N_LAUNCHES == 1
    a.ph_lo = 0; a.ph_hi = NPH;
    hipLaunchKernelGGL(k_fwd, dim3(grid), dim3(512), LDS_BYTES, stream, a);
#else
    for (int k = 0; k < NPH; ++k) { a.ph_lo = k; a.ph_hi = k + 1; const int reps = ((REPMASK >> k) & 1) ? 2 : 1;
        for (int r = 0; r < reps; ++r) hipLaunchKernelGGL(k_fwd, dim3(grid), dim3(512), LDS_BYTES, stream, a); }
#endif
}
```

```cpp
#include <hip/hip_runtime.h>
#include <cstdio>
#include <cstdint>

#ifndef MK_N_LAUNCHES
#define MK_N_LAUNCHES 1
#endif
#ifndef REPMASK
#define REPMASK 0x0
#endif

#define LAS __attribute__((address_space(3)))
typedef unsigned short bf16_t;
typedef short bf16x8 __attribute__((ext_vector_type(8)));
typedef short bf16x4 __attribute__((ext_vector_type(4)));
typedef float f32x4 __attribute__((ext_vector_type(4)));
typedef float f32x2 __attribute__((ext_vector_type(2)));
typedef unsigned u32x4 __attribute__((ext_vector_type(4)));
typedef unsigned u32x2 __attribute__((ext_vector_type(2)));

constexpr int T = 32768, DM = 1024, SEQ = 8192, NBATCH = 4, NE = 32, DEX = 512, NASG = 65536, NPH = 16;
constexpr float ALPHA = 1.41421356237309515f;
constexpr float LN_EPS = 1e-5f;
constexpr size_t MiB = (size_t)1 << 20;
constexpr size_t WS_CTL = 0, WS_GATE = 1 * MiB, WS_LIST = 2 * MiB, WS_WIN = 10 * MiB, WS_W2 = 12 * MiB, WS_F1 = 16 * MiB, WS_F2 = 17 * MiB, WS_WQKV = 21 * MiB, WS_WO = 27 * MiB,
                 WS_WGU = 30 * MiB, WS_WD = 158 * MiB, WS_S0 = 222 * MiB, WS_S1 = 286 * MiB, WS_S2 = 350 * MiB, WS_S3 = 414 * MiB, WS_END = 478 * MiB;
constexpr size_t CTL_ZERO_BYTES = 65536;
constexpr int CNT_WORD0 = 4096;
constexpr int LDS_BYTES = 159760;
constexpr int LDS_IDX = 131072, LDS_MISC = 131072 + 16384, LDS_BARW = LDS_BYTES - 16;

#define XB_TMO      128
#define XB_XCNT(j)  (256  + 64 * (j))
#define XB_XSUB(j)  (1280 + 64 * (j))
#define XB_XGEN(j)  (2304 + 64 * (j))
#define XB_TOP      3328
#define XB_TOPGEN   3392
#define XCD_BAR_WORDS 3456
#define XB_SPIN_CAP (1u << 18)

__device__ __forceinline__ unsigned xb_ld(unsigned* p)              { return __hip_atomic_load(p, __ATOMIC_RELAXED, __HIP_MEMORY_SCOPE_AGENT); }
__device__ __forceinline__ unsigned xb_add(unsigned* p, unsigned v) { return __hip_atomic_fetch_add(p, v, __ATOMIC_RELAXED, __HIP_MEMORY_SCOPE_AGENT); }
__device__ __forceinline__ unsigned xb_xcc_id() { return (unsigned)__builtin_amdgcn_s_getreg((3 << 11) | 20) & 0xFu; }
#define XB_SPIN(cond, bar) do { unsigned _sp = 0; while (cond) { __builtin_amdgcn_s_sleep(1); \
    if ((++_sp & 255u) == 0u) { if (xb_ld(&(bar)[XB_TMO])) break; if (_sp > XB_SPIN_CAP) { atomicAdd(&(bar)[XB_TMO], 1u); break; } } } } while (0)

struct XcdBarrier { unsigned* bar; unsigned x; volatile LAS unsigned* st; };

__device__ __forceinline__ XcdBarrier xcd_barrier_post(unsigned* bar, volatile LAS unsigned* st) {
    XcdBarrier b; b.bar = bar; b.x = xb_xcc_id(); b.st = st;
    if (threadIdx.x == 0) (void)xb_add(&bar[XB_XCNT(b.x)], 1u);
    return b;
}
__device__ __forceinline__ void xcd_barrier_complete(unsigned* bar, unsigned x, unsigned& nloc, unsigned& nx) {
    const unsigned G = gridDim.x * gridDim.y * gridDim.z;
    unsigned sum, cnt, mine, sp = 0u;
    for (;;) {
        sum = 0u; cnt = 0u; mine = 0u;
#pragma unroll
        for (unsigned j = 0; j < 16; ++j) { const unsigned c = xb_ld(&bar[XB_XCNT(j)]); sum += c; cnt += (c > 0u) ? 1u : 0u; mine = (j == x) ? c : mine; }
        if (sum == G) break;
        __builtin_amdgcn_s_sleep(1);
        if ((++sp & 255u) == 0u) { if (xb_ld(&bar[XB_TMO])) break; if (sp > XB_SPIN_CAP) { atomicAdd(&bar[XB_TMO], 1u); break; } }
    }
    nloc = mine > 0u ? mine : 1u; nx = cnt > 0u ? cnt : 1u;
}
__device__ __forceinline__ void xcd_barrier(const XcdBarrier& b) {
    asm volatile("s_waitcnt vmcnt(0)" ::: "memory");
    __syncthreads();
    if (threadIdx.x == 0) {
        unsigned* bar = b.bar;
        __builtin_amdgcn_s_waitcnt(0);
        unsigned nloc = b.st[0], nx = b.st[1];
        if (nloc == 0u) { xcd_barrier_complete(bar, b.x, nloc, nx); b.st[0] = nloc; b.st[1] = nx; }
        const unsigned old = xb_add(&bar[XB_XSUB(b.x)], 1u);
        const unsigned gen = old / nloc;
        if (old + 1u == (gen + 1u) * nloc) {
            __builtin_amdgcn_fence(__ATOMIC_RELEASE, "agent");
            asm volatile("s_waitcnt vmcnt(0)" ::: "memory");
            const unsigned og = xb_add(&bar[XB_TOP], 1u);
            const unsigned tg = og / nx;
            if (og + 1u == (tg + 1u) * nx) xb_add(&bar[XB_TOPGEN], 1u);
            else XB_SPIN(xb_ld(&bar[XB_TOPGEN]) == tg, bar);
            __builtin_amdgcn_fence(__ATOMIC_ACQUIRE, "agent");
            xb_add(&bar[XB_XGEN(b.x)], 1u);
            asm volatile("s_waitcnt vmcnt(0)" ::: "memory");
        } else {
            XB_SPIN(xb_ld(&bar[XB_XGEN(b.x)]) == gen, bar);
            __builtin_amdgcn_fence(__ATOMIC_ACQUIRE, "agent");
            asm volatile("s_waitcnt vmcnt(0)" ::: "memory");
        }
    }
    __syncthreads();
}

__device__ __forceinline__ unsigned cvt_pk_bf16(float lo, float hi) { unsigned r; asm volatile("v_cvt_pk_bf16_f32 %0, %1, %2" : "=v"(r) : "v"(lo), "v"(hi)); return r; }
__device__ __forceinline__ float bf_lo(unsigned w) { return __uint_as_float(w << 16); }
__device__ __forceinline__ float bf_hi(unsigned w) { return __uint_as_float(w & 0xffff0000u); }
__device__ __forceinline__ u32x4 pack8(const f32x4 a, const f32x4 b) { u32x4 w; w.x = cvt_pk_bf16(a[0], a[1]); w.y = cvt_pk_bf16(a[2], a[3]); w.z = cvt_pk_bf16(b[0], b[1]); w.w = cvt_pk_bf16(b[2], b[3]); return w; }
__device__ __forceinline__ int tid_fresh() { int t = threadIdx.x; asm volatile("" : "+v"(t)); return t; }
__device__ __forceinline__ void bf8_to_f32(const u32x4 w, f32x4& a, f32x4& b) { a[0] = bf_lo(w.x); a[1] = bf_hi(w.x); a[2] = bf_lo(w.y); a[3] = bf_hi(w.y); b[0] = bf_lo(w.z); b[1] = bf_hi(w.z); b[2] = bf_lo(w.w); b[3] = bf_hi(w.w); }
__device__ __forceinline__ float wave_sum(float v) {
#pragma unroll
    for (int o = 32; o >= 1; o >>= 1) v += __shfl_xor(v, o);
    return v;
}

constexpr float W_SCALE = 64.0f, H_SCALE = 4.0f, O_SCALE = 16.0f, Y_SCALE = 8.0f, W2_SCALE = 256.0f, YS_SCALE = 16.0f;
__device__ __forceinline__ f32x4 fp8x4_to_f32(unsigned w) { f32x4 r; r[0] = __builtin_amdgcn_cvt_f32_fp8(w, 0); r[1] = __builtin_amdgcn_cvt_f32_fp8(w, 1); r[2] = __builtin_amdgcn_cvt_f32_fp8(w, 2); r[3] = __builtin_amdgcn_cvt_f32_fp8(w, 3); return r; }
__device__ __forceinline__ float silu_mul(float g, float up) { return g * __builtin_amdgcn_rcpf(1.0f + __expf(-g)) * up; }
__device__ __forceinline__ unsigned pk4_fp8(float a, float b, float c, float d) { unsigned r = 0; r = __builtin_amdgcn_cvt_pk_fp8_f32(a, b, r, false); r = __builtin_amdgcn_cvt_pk_fp8_f32(c, d, r, true); return r; }
namespace gm {
constexpr int BM = 256, BK = 64, HALF = 128, HTB = HALF * BK * 2, STAGE_BYTES = 8 * HTB, NXCD = 8, WGM = 16;
__device__ __forceinline__ int lds_byte(int r, int c) { const int st = (r >> 4) * 2 + (c >> 5), rr = r & 15, cc = c & 31, ob = rr * 64 + cc * 2; return st * 1024 + (ob ^ (((ob >> 9) & 1) << 5)); }
__device__ __forceinline__ void stage_rc(int b, int& R, int& C) { const int st = b / 1024, sb = b % 1024, swz = sb ^ (((sb >> 9) & 1) << 5); R = (st >> 1) * 16 + swz / 64; C = (st & 1) * 32 + (swz % 64) / 2; }
__device__ __forceinline__ int perm32(int rho) { const int n = rho >> 4, i = rho & 15; return 8 * (i >> 2) + 4 * n + (i & 3); }

__device__ __forceinline__ void glds16(const char* sbase, unsigned voff, unsigned lds_dst) {
    unsigned keep;
    asm volatile("s_mov_b32 %0, m0\n\ts_mov_b32 m0, %3\n\ts_nop 0\n\tglobal_load_lds_dwordx4 %1, %2\n\ts_mov_b32 m0, %0" : "=&s"(keep) : "v"(voff), "s"(sbase), "s"(lds_dst) : "memory");
}
struct Unit { const char* A; const char* B; unsigned hsA, hsB; int pm, pn, x0, x1; };

struct GridOrder {
    int nM, nN, nwg, G, c;
    __device__ __forceinline__ void init(int nM_, int nN_, int G_, int c_) { nM = nM_; nN = nN_; nwg = nM * nN; G = G_; c = c_; }
    __device__ __forceinline__ bool mn(int i, int& pm, int& pn) const {
        const long L = (long)i * G + c; if (L >= nwg) return false;
        int wgid = (int)L; { const int q = nwg / NXCD, r = nwg % NXCD, xcd = wgid % NXCD, off = wgid / NXCD; wgid = (xcd < r ? xcd * (q + 1) : r * (q + 1) + (xcd - r) * q) + off; }
        const int nig = WGM * nN, gid = wgid / nig, fm = gid * WGM, gsz = (nM - fm) < WGM ? (nM - fm) : WGM;
        pm = fm + ((wgid % nig) % gsz); pn = (wgid % nig) / gsz; return true;
    }
};

typedef int i32x4v __attribute__((ext_vector_type(4)));
typedef int i32x8v __attribute__((ext_vector_type(8)));
__device__ __forceinline__ i32x8v cat8(const bf16x8 a, const bf16x8 b) { const i32x4v x = __builtin_bit_cast(i32x4v, a), y = __builtin_bit_cast(i32x4v, b); return (i32x8v){x[0], x[1], x[2], x[3], y[0], y[1], y[2], y[3]}; }
template <class E, class = void> struct epi_perm16 { static constexpr bool value = false; };
template <class E> struct epi_perm16<E, decltype((void)E::PERM16)> { static constexpr bool value = E::PERM16; };
template <class Epi, class Sched, bool GATHER, bool FP8 = false, bool SP2 = true, bool ALIGN_EPI = true>
__device__ __forceinline__ void gemm_phase(LAS unsigned char* lds, const int kbytes, const unsigned ldA, const unsigned ldB, const Sched& S, const Epi& E, const LAS int* idxsrc) {
    const int tid = tid_fresh(), wid = __builtin_amdgcn_readfirstlane(tid >> 6), lane = tid & 63, wr = wid >> 2, wc = wid & 3, fr = lane & 15, fq = lane >> 4;
    int nt = kbytes / (BK * 2); asm volatile("" : "+s"(nt));
    unsigned voffA[2][2], voffBh[2][2];
#pragma unroll
    for (int i = 0; i < 2; ++i) { int R, C; stage_rc(tid * 16 + i * 8192, R, C); const int q = perm32(R & 31); const int Rb = Epi::PERM ? ((R & ~31) + q) : R;
        voffA[0][i] = (unsigned)R * ldA + (unsigned)C * 2u; voffA[1][i] = voffA[0][i];
        if constexpr (epi_perm16<Epi>::value) { const int rb0 = 64 * (R >> 5) + 16 * (q >> 3) + (q & 7); voffBh[0][i] = (unsigned)rb0 * ldB + (unsigned)C * 2u; voffBh[1][i] = (unsigned)(rb0 + 8) * ldB + (unsigned)C * 2u; }
        else { voffBh[0][i] = (unsigned)Rb * ldB + (unsigned)C * 2u; voffBh[1][i] = voffBh[0][i]; } }
    const size_t kstep = (size_t)(BK * 2);
    const unsigned ldsw = (unsigned)wid * 1024u;
    const unsigned lds0 = (unsigned)(__UINTPTR_TYPE__)lds;
    const int aoff = lds_byte(wr * 64 + fr, fq * 8), boff = lds_byte(wc * 32 + fr, fq * 8);
#define PG8_SA(b, h) (((b) * 2 + (h)) * HTB)
#define PG8_SB(b, h) ((4 + (b) * 2 + (h)) * HTB)
#define PG8_STAGE(bufoff, gbase, voff) do { _Pragma("unroll") for (int _i = 0; _i < 2; ++_i) glds16((const char*)(gbase), (voff)[_i], lds0 + (unsigned)(bufoff) + ldsw + _i * 8192u); } while (0)
#define PG8_LDA(dst, b, h) do { _Pragma("unroll") for (int m = 0; m < 4; ++m) _Pragma("unroll") for (int k = 0; k < 2; ++k) dst[m][k] = *(const LAS bf16x8*)(lds + PG8_SA(b, h) + aoff + m * 2048 + k * 1024); } while (0)
#define PG8_LDB(dst, b, h) do { _Pragma("unroll") for (int n = 0; n < 2; ++n) _Pragma("unroll") for (int k = 0; k < 2; ++k) dst[n][k] = *(const LAS bf16x8*)(lds + PG8_SB(b, h) + boff + n * 2048 + k * 1024); } while (0)
#define PG8_MMA(ai, bj, At, Bt) do { __builtin_amdgcn_s_setprio(1); _Pragma("unroll") for (int m = 0; m < 4; ++m) _Pragma("unroll") for (int n = 0; n < 2; ++n) { \
        if constexpr (FP8) { const i32x8v b8_ = cat8(Bt[n][0], Bt[n][1]), a8_ = cat8(At[m][0], At[m][1]); \
            asm volatile("s_nop 1\n\tv_mfma_scale_f32_16x16x128_f8f6f4 %0, %1, %2, %0, %3, %3 op_sel_hi:[0,0,0]" : "+v"(acc[ai][bj][m][n]) : "v"(b8_), "v"(a8_), "v"(fp8_unit_scale)); } \
        else { _Pragma("unroll") for (int k = 0; k < 2; ++k) acc[ai][bj][m][n] = __builtin_amdgcn_mfma_f32_16x16x32_bf16(Bt[n][k], At[m][k], acc[ai][bj][m][n], 0, 0, 0); } } \
        __builtin_amdgcn_s_setprio(0); } while (0)
#define PG8_WAIT_V(n) asm volatile("s_waitcnt vmcnt(" #n ")" ::: "memory")
#define PG8_WAIT_L(n) asm volatile("s_waitcnt lgkmcnt(" #n ")" ::: "memory")
#define PG8_BAR __builtin_amdgcn_s_barrier()
#define PG8_SCHED __builtin_amdgcn_sched_barrier(0)
#define PG8_VA(h) voffA[GATHER ? (h) : 0]
#define PG8_VB(h) voffBh[epi_perm16<Epi>::value ? (h) : 0]
    const int fp8_unit_scale = 0x7f7f7f7f;
    Unit cur, nxt; int ui = 0;
    if (!S.next(0, cur)) return;
    if constexpr (GATHER) {
#pragma unroll
        for (int h = 0; h < 2; ++h)
#pragma unroll
            for (int i = 0; i < 2; ++i) { int R, C; stage_rc(tid * 16 + i * 8192, R, C); voffA[h][i] = (unsigned)idxsrc[h * 128 + R] * ldA + (unsigned)C * 2u; }
    }
    f32x4 acc[2][2][4][2];
#pragma unroll
    for (int a = 0; a < 2; ++a)
#pragma unroll
        for (int b = 0; b < 2; ++b)
#pragma unroll
            for (int m = 0; m < 4; ++m)
#pragma unroll
                for (int n = 0; n < 2; ++n) acc[a][b][m][n] = (f32x4){0.f, 0.f, 0.f, 0.f};
    bf16x8 At[4][2], B0[2][2], B1[2][2];
    const char* cA = cur.A; const char* cB = cur.B; unsigned chA = cur.hsA, chB = cur.hsB;
    if constexpr (SP2) {
        PG8_STAGE(PG8_SB(0, 0), cB, PG8_VB(0)); PG8_STAGE(PG8_SB(0, 1), cB + chB, PG8_VB(1)); PG8_STAGE(PG8_SA(0, 0), cA, PG8_VA(0)); PG8_STAGE(PG8_SA(0, 1), cA + chA, PG8_VA(1));
        if (wr == 1) PG8_BAR;
        PG8_WAIT_V(2); PG8_BAR;
        PG8_STAGE(PG8_SB(1, 0), cB + kstep, PG8_VB(0)); PG8_STAGE(PG8_SA(1, 0), cA + kstep, PG8_VA(0)); PG8_STAGE(PG8_SB(1, 1), cB + chB + kstep, PG8_VB(1));
        PG8_WAIT_V(6); PG8_BAR;
    } else {
    PG8_STAGE(PG8_SB(0, 0), cB, PG8_VB(0)); PG8_STAGE(PG8_SA(0, 0), cA, PG8_VA(0)); PG8_STAGE(PG8_SB(0, 1), cB + chB, PG8_VB(1)); PG8_STAGE(PG8_SA(0, 1), cA + chA, PG8_VA(1));
    if (wr == 1) PG8_BAR;
    PG8_WAIT_V(4); PG8_BAR;
    PG8_STAGE(PG8_SB(1, 0), cB + kstep, PG8_VB(0)); PG8_STAGE(PG8_SA(1, 0), cA + kstep, PG8_VA(0)); PG8_STAGE(PG8_SB(1, 1), cB + chB + kstep, PG8_VB(1));
    PG8_WAIT_V(6); PG8_BAR;
    }
    for (;;) {
        const bool has_next = S.next(ui + 1, nxt);
        const char* nA = has_next ? nxt.A : cA; const char* nB = has_next ? nxt.B : cB; const unsigned nhA = has_next ? nxt.hsA : chA, nhB = has_next ? nxt.hsB : chB;
#pragma unroll 1
        for (int t = 0; t < nt; t += 2) {
            const bool last = (t == nt - 2);
            const char* a1 = cA + (size_t)(t + 1) * kstep;
            const char* a2 = last ? nA : cA + (size_t)(t + 2) * kstep; const char* b2 = last ? nB : cB + (size_t)(t + 2) * kstep;
            const unsigned hA2 = last ? nhA : chA, hB2 = last ? nhB : chB;
            const char* a3 = a2 + kstep; const char* b3 = b2 + kstep;
            const bool sw = GATHER && last && has_next;
            int gi[2][2];
            if constexpr (SP2) {
            PG8_LDB(B0, 0, 0); PG8_LDB(B1, 0, 1); PG8_SCHED; PG8_LDA(At, 0, 0); PG8_STAGE(PG8_SA(1, 1), a1 + chA, PG8_VA(1));
            PG8_WAIT_V(8); PG8_WAIT_L(0); PG8_BAR; PG8_MMA(0, 0, At, B0); PG8_MMA(0, 1, At, B1); PG8_BAR; PG8_SCHED;
            if constexpr (GATHER) { if (sw) {
#pragma unroll
                for (int h = 0; h < 2; ++h)
#pragma unroll
                    for (int i = 0; i < 2; ++i) { int R, C; stage_rc(tid * 16 + i * 8192, R, C); gi[h][i] = idxsrc[(ui + 1) * 256 + h * 128 + R]; } } }
            PG8_LDA(At, 0, 1); PG8_STAGE(PG8_SB(0, 0), b2, PG8_VB(0)); PG8_STAGE(PG8_SB(0, 1), b2 + hB2, PG8_VB(1));
            if constexpr (GATHER) { if (sw) {
#pragma unroll
                for (int h = 0; h < 2; ++h)
#pragma unroll
                    for (int i = 0; i < 2; ++i) { int R, C; stage_rc(tid * 16 + i * 8192, R, C); voffA[h][i] = (unsigned)gi[h][i] * ldA + (unsigned)C * 2u; } } }
            PG8_STAGE(PG8_SA(0, 0), a2, PG8_VA(0));
            PG8_WAIT_V(8); PG8_WAIT_L(0); PG8_BAR; PG8_MMA(1, 0, At, B0); PG8_MMA(1, 1, At, B1); PG8_BAR; PG8_SCHED;
            PG8_LDB(B0, 1, 0); PG8_LDB(B1, 1, 1); PG8_SCHED; PG8_LDA(At, 1, 0); PG8_STAGE(PG8_SA(0, 1), a2 + hA2, PG8_VA(1));
            PG8_WAIT_V(8); PG8_WAIT_L(0); PG8_BAR; PG8_MMA(0, 0, At, B0); PG8_MMA(0, 1, At, B1); PG8_BAR; PG8_SCHED;
            PG8_LDA(At, 1, 1); PG8_STAGE(PG8_SB(1, 0), b3, PG8_VB(0)); PG8_STAGE(PG8_SB(1, 1), b3 + hB2, PG8_VB(1)); PG8_STAGE(PG8_SA(1, 0), a3, PG8_VA(0));
            PG8_WAIT_V(8); PG8_WAIT_L(0); PG8_BAR; PG8_MMA(1, 0, At, B0); PG8_MMA(1, 1, At, B1); PG8_BAR; PG8_SCHED;
            } else {
            PG8_LDB(B0, 0, 0); PG8_SCHED; PG8_LDA(At, 0, 0); PG8_STAGE(PG8_SA(1, 1), a1 + chA, PG8_VA(1));
            PG8_WAIT_L(8); PG8_BAR; PG8_WAIT_L(0); PG8_MMA(0, 0, At, B0); PG8_BAR; PG8_SCHED;
            if constexpr (GATHER) { if (sw) {
#pragma unroll
                for (int h = 0; h < 2; ++h)
#pragma unroll
                    for (int i = 0; i < 2; ++i) { int R, C; stage_rc(tid * 16 + i * 8192, R, C); gi[h][i] = idxsrc[(ui + 1) * 256 + h * 128 + R]; } } }
            PG8_LDB(B1, 0, 1); PG8_STAGE(PG8_SB(0, 0), b2, PG8_VB(0));
            PG8_BAR; PG8_WAIT_L(0); PG8_MMA(0, 1, At, B1); PG8_BAR;
            if constexpr (GATHER) { if (sw) {
#pragma unroll
                for (int h = 0; h < 2; ++h)
#pragma unroll
                    for (int i = 0; i < 2; ++i) { int R, C; stage_rc(tid * 16 + i * 8192, R, C); voffA[h][i] = (unsigned)gi[h][i] * ldA + (unsigned)C * 2u; } } }
            PG8_LDA(At, 0, 1); PG8_STAGE(PG8_SA(0, 0), a2, PG8_VA(0));
            PG8_BAR; PG8_WAIT_L(0); PG8_MMA(1, 0, At, B0); PG8_BAR; PG8_SCHED;
            PG8_STAGE(PG8_SB(0, 1), b2 + hB2, PG8_VB(1));
            PG8_WAIT_V(6); PG8_BAR; PG8_MMA(1, 1, At, B1); PG8_BAR;
            PG8_LDB(B0, 1, 0); PG8_SCHED; PG8_LDA(At, 1, 0); PG8_STAGE(PG8_SA(0, 1), a2 + hA2, PG8_VA(1));
            PG8_WAIT_L(8); PG8_BAR; PG8_WAIT_L(0); PG8_MMA(0, 0, At, B0); PG8_BAR; PG8_SCHED;
            PG8_LDB(B1, 1, 1); PG8_STAGE(PG8_SB(1, 0), b3, PG8_VB(0));
            PG8_BAR; PG8_WAIT_L(0); PG8_MMA(0, 1, At, B1); PG8_BAR;
            PG8_LDA(At, 1, 1); PG8_STAGE(PG8_SA(1, 0), a3, PG8_VA(0));
            PG8_BAR; PG8_WAIT_L(0); PG8_MMA(1, 0, At, B0); PG8_BAR; PG8_SCHED;
            PG8_STAGE(PG8_SB(1, 1), b3 + hB2, PG8_VB(1));
            PG8_WAIT_V(6); PG8_BAR; PG8_MMA(1, 1, At, B1); PG8_BAR;
            }
        }
        if constexpr (ALIGN_EPI) { if (wr == 0) PG8_BAR; }
        if constexpr (FP8) asm volatile("s_nop 15\n\ts_nop 15" ::: "memory");
        E(acc, cur, ui, wr, wc, fr, fq);
        if (!has_next) break;
#pragma unroll
        for (int a = 0; a < 2; ++a)
#pragma unroll
            for (int b = 0; b < 2; ++b)
#pragma unroll
                for (int m = 0; m < 4; ++m)
#pragma unroll
                    for (int n = 0; n < 2; ++n) acc[a][b][m][n] = (f32x4){0.f, 0.f, 0.f, 0.f};
        cur = nxt; cA = nA; cB = nB; chA = nhA; chB = nhB; ++ui;
        if constexpr (ALIGN_EPI) { if (wr == 1) PG8_BAR; }
    }
    PG8_WAIT_V(0);
    if constexpr (!ALIGN_EPI) { if (wr == 0) PG8_BAR; }
    PG8_BAR;
#undef PG8_SA
#undef PG8_SB
#undef PG8_STAGE
#undef PG8_LDA
#undef PG8_LDB
#undef PG8_MMA
#undef PG8_WAIT_V
#undef PG8_WAIT_L
#undef PG8_BAR
#undef PG8_SCHED
#undef PG8_VA
#undef PG8_VB
}
}
using gm::Unit;

struct Params { const float* in[13]; float* out; unsigned char* ws; int ph_lo, ph_hi; };

struct SchedPlain {
    gm::GridOrder o; const char* A; const char* B; unsigned ldA, ldB; bool p16 = false;
    __device__ __forceinline__ bool next(int i, Unit& u) const { int pm, pn; if (!o.mn(i, pm, pn)) return false;
        u.pm = pm; u.pn = pn; u.x0 = 0; u.x1 = 0; u.A = A + (size_t)pm * 256 * ldA; u.hsA = 128u * ldA; u.B = B + (size_t)pn * 256 * ldB; u.hsB = p16 ? 0u : 128u * ldB; return true; }
};
struct SchedG1 {
    gm::GridOrder o; const char* WinT; const char* xb;
    __device__ __forceinline__ bool next(int i, Unit& u) const { int pm, pn; if (!o.mn(i, pm, pn)) return false;
        const int b = pn >> 5, j = pn & 31; u.pm = pm; u.pn = pn; u.x0 = b; u.x1 = j;
        u.A = WinT + (size_t)pm * 256 * 1024; u.hsA = 128u * 1024u; u.B = xb + ((size_t)(b * SEQ + 2 * j)) * 1024; u.hsB = 1024u; return true; }
};
struct SchedS1 {
    int G, c; const char* F1; const char* Ut;
    __device__ __forceinline__ bool next(int i, Unit& u) const { const int L = i * G + c; if (L >= 1024) return false;
        u.pm = 0; u.pn = L; u.x0 = 0; u.x1 = 0; u.A = F1; u.hsA = 128u * 256u; u.B = Ut + (size_t)L * 256 * 256; u.hsB = 128u * 256u; return true; }
};
struct SchedS2 {
    gm::GridOrder o; const char* F2; const char* A1;
    __device__ __forceinline__ bool next(int i, Unit& u) const { int pm, pn; if (!o.mn(i, pm, pn)) return false;
        const int g = pm, b = pn >> 2, ct = pn & 3; u.pm = g; u.pn = ct; u.x0 = b; u.x1 = g;
        u.A = F2 + (size_t)g * 256 * 256; u.hsA = 128u * 256u; u.B = A1 + ((size_t)((b * 64 + g) * 1024 + ct * 256)) * 256; u.hsB = 0u; return true; }
};
__device__ __forceinline__ int expert_of_tile(const LAS int* ts, int pm) {
    const int ln = (int)__builtin_amdgcn_mbcnt_hi(~0u, __builtin_amdgcn_mbcnt_lo(~0u, 0u));
    const int v = ts[ln & 31];
    return (int)__builtin_popcountll(__ballot((ln >= 1) && (ln < 32) && (v <= pm)));
}
struct SchedMoe {
    gm::GridOrder o; const LAS int* ts; const char* A; const char* W; size_t wstride; unsigned ldB; bool hsB128; unsigned tileA;
    __device__ __forceinline__ bool next(int i, Unit& u) const { int pm, pn; if (!o.mn(i, pm, pn)) return false;
        const int e = expert_of_tile(ts, pm);
        u.pm = pm; u.pn = pn; u.x0 = e; u.x1 = pm - ts[e]; u.A = A + (size_t)pm * tileA; u.hsA = tileA >> 1; u.B = W + (size_t)e * wstride + (size_t)pn * 256 * ldB; u.hsB = hsB128 ? 128u * ldB : 0u; return true; }
};

typedef f32x4 Acc[2][2][4][2];
struct EpiRow {
    static constexpr bool PERM = true;
    bf16_t* O; size_t ld; int split_tiles; size_t split_stride; float scale0, scale1;
    __device__ __forceinline__ void operator()(const Acc& acc, const Unit& u, int, int wr, int wc, int fr, int fq) const {
        int pn = u.pn; bf16_t* base = O; float sc = scale0;
        if (split_tiles) { const int t = pn / split_tiles; base += (size_t)t * split_stride; pn -= t * split_tiles; if (t != 0) sc = scale1; }
        const size_t row0 = (size_t)u.pm * 256 + wr * 64 + fr; const int col0 = pn * 256 + wc * 32 + 8 * fq;
#pragma unroll
        for (int ai = 0; ai < 2; ++ai)
#pragma unroll
            for (int m = 0; m < 4; ++m) { bf16_t* rowp = base + (row0 + ai * 128 + m * 16) * ld + col0;
#pragma unroll
                for (int bj = 0; bj < 2; ++bj) *(u32x4*)(rowp + bj * 128) = pack8(acc[ai][bj][m][0] * sc, acc[ai][bj][m][1] * sc); }
    }
};
struct EpiRow8 {
    static constexpr bool PERM = true, PERM16 = true;
    unsigned char* O; size_t ld; int split_tiles; size_t split_stride; float scale0, scale1;
    __device__ __forceinline__ void operator()(const Acc& acc, const Unit& u, int, int wr, int wc, int fr, int fq) const {
        int pn = u.pn; unsigned char* base = O; float sc = scale0;
        if (split_tiles) { const int t = pn / split_tiles; base += (size_t)t * split_stride; pn -= t * split_tiles; if (t != 0) sc = scale1; }
        const size_t row0 = (size_t)u.pm * 256 + wr * 64 + fr; const int col0 = pn * 256 + wc * 64 + 16 * fq;
#pragma unroll
        for (int ai = 0; ai < 2; ++ai)
#pragma unroll
            for (int m = 0; m < 4; ++m) { u32x4 w;
                { const f32x4 v = acc[ai][0][m][0] * sc; w.x = pk4_fp8(v[0], v[1], v[2], v[3]); } { const f32x4 v = acc[ai][0][m][1] * sc; w.y = pk4_fp8(v[0], v[1], v[2], v[3]); }
                { const f32x4 v = acc[ai][1][m][0] * sc; w.z = pk4_fp8(v[0], v[1], v[2], v[3]); } { const f32x4 v = acc[ai][1][m][1] * sc; w.w = pk4_fp8(v[0], v[1], v[2], v[3]); }
                *(u32x4*)(base + (row0 + ai * 128 + m * 16) * ld + col0) = w; }
    }
};
struct EpiG1 {
    static constexpr bool PERM = true;
    bf16_t* Ut; float sc;
    __device__ __forceinline__ void operator()(const Acc& acc, const Unit& u, int, int wr, int wc, int fr, int fq) const {
#pragma unroll
        for (int ai = 0; ai < 2; ++ai)
#pragma unroll
            for (int m = 0; m < 4; ++m) { const int c = u.pm * 256 + ai * 128 + wr * 64 + m * 16 + fr;
#pragma unroll
                for (int bj = 0; bj < 2; ++bj) { const int s2 = 2 * u.x1 + bj;
                    *(u32x4*)(Ut + (((size_t)(u.x0 * 1024 + c) * 64 + s2) * 128 + wc * 32 + 8 * fq)) = pack8(acc[ai][bj][m][0] * sc, acc[ai][bj][m][1] * sc); } }
    }
};
struct EpiS1 {
    static constexpr bool PERM = true;
    bf16_t* A1;
    __device__ __forceinline__ void operator()(const Acc& acc, const Unit& u, int, int wr, int wc, int fr, int fq) const {
#pragma unroll
        for (int m = 0; m < 4; ++m) { const int m1 = wr * 64 + m * 16 + fr, g = m1 >> 1, ri = m1 & 1;
#pragma unroll
            for (int bj = 0; bj < 2; ++bj) { const int nrow = u.pn * 256 + bj * 128 + wc * 32 + 8 * fq, s2 = nrow & 63, c = (nrow >> 6) & 1023, b = nrow >> 16;
                *(u32x4*)(A1 + ((size_t)((b * 64 + g) * 1024 + c) * 128 + ri * 64 + s2)) = pack8(acc[0][bj][m][0], acc[0][bj][m][1]); } }
    }
};
struct EpiS2 {
    static constexpr bool PERM = true, PERM16 = true;
    unsigned char* Y;
    __device__ __forceinline__ void operator()(const Acc& acc, const Unit& u, int, int wr, int wc, int fr, int fq) const {
        const int g = u.x1, b = u.x0;
#pragma unroll
        for (int ai = 0; ai < 2; ++ai)
#pragma unroll
            for (int m = 0; m < 4; ++m) { const int mm = wr * 64 + m * 16 + fr, k2 = mm >> 1, rip = mm & 1;
                const int k1 = ai ? (g ? 128 - g : 64) : g, k = k1 + 128 * k2;
                { const int c = u.pn * 256 + wc * 64 + 16 * fq; u32x4 w;
                    { const f32x4 v = acc[ai][0][m][0] * Y_SCALE; w.x = pk4_fp8(v[0], v[1], v[2], v[3]); } { const f32x4 v = acc[ai][0][m][1] * Y_SCALE; w.y = pk4_fp8(v[0], v[1], v[2], v[3]); }
                    { const f32x4 v = acc[ai][1][m][0] * Y_SCALE; w.z = pk4_fp8(v[0], v[1], v[2], v[3]); } { const f32x4 v = acc[ai][1][m][1] * Y_SCALE; w.w = pk4_fp8(v[0], v[1], v[2], v[3]); }
                    *(u32x4*)(Y + ((size_t)(b * SEQ + k) * 2048 + rip * 1024 + c)) = w; } }
    }
};
struct EpiGU {
    static constexpr bool PERM = true;
    unsigned char* Hb; const LAS int* idxdst;
    __device__ __forceinline__ void operator()(const Acc& acc, const Unit& u, int ui, int wr, int wc, int fr, int fq) const {
#pragma unroll
        for (int ai = 0; ai < 2; ++ai)
#pragma unroll
            for (int m = 0; m < 4; ++m) { const int a = idxdst[ui * 256 + ai * 128 + wr * 64 + m * 16 + fr];
                if (a >= 0) { f32x4 h0, h1;
#pragma unroll
                    for (int j = 0; j < 4; ++j) { h0[j] = silu_mul(acc[ai][0][m][0][j] * (1.0f / W_SCALE), acc[ai][1][m][0][j] * (H_SCALE / W_SCALE)); h1[j] = silu_mul(acc[ai][0][m][1][j] * (1.0f / W_SCALE), acc[ai][1][m][1][j] * (H_SCALE / W_SCALE)); }
                    u32x2 w; w.x = pk4_fp8(h0[0], h0[1], h0[2], h0[3]); w.y = pk4_fp8(h1[0], h1[1], h1[2], h1[3]);
                    *(u32x2*)(Hb + ((size_t)(u.pm * 256 + ai * 128 + wr * 64 + m * 16 + fr) * DEX + u.pn * 128 + wc * 32 + 8 * fq)) = w; } }
    }
};
struct EpiDown {
    static constexpr bool PERM = true, PERM16 = true;
    unsigned char* ys; const LAS int* idxdst;
    __device__ __forceinline__ void operator()(const Acc& acc, const Unit& u, int ui, int wr, int wc, int fr, int fq) const {
#pragma unroll
        for (int ai = 0; ai < 2; ++ai)
#pragma unroll
            for (int m = 0; m < 4; ++m) { const int a = idxdst[ui * 256 + ai * 128 + wr * 64 + m * 16 + fr];
                if (a >= 0) { constexpr float sc = YS_SCALE / (W_SCALE * H_SCALE); u32x4 w;
                    { const f32x4 v = acc[ai][0][m][0] * sc; w.x = pk4_fp8(v[0], v[1], v[2], v[3]); } { const f32x4 v = acc[ai][0][m][1] * sc; w.y = pk4_fp8(v[0], v[1], v[2], v[3]); }
                    { const f32x4 v = acc[ai][1][m][0] * sc; w.z = pk4_fp8(v[0], v[1], v[2], v[3]); } { const f32x4 v = acc[ai][1][m][1] * sc; w.w = pk4_fp8(v[0], v[1], v[2], v[3]); }
                    *(u32x4*)(ys + ((size_t)a * DM + u.pn * 256 + wc * 64 + 16 * fq)) = w; } }
    }
};

struct TileDesc { const float* src; unsigned char* dst; int C, r0, c0, dld, kind; };
__device__ __forceinline__ TileDesc tile_desc(const Params& p, int tt) {
    TileDesc d; d.kind = 3; unsigned char* ws = p.ws;
    if (tt < 256) { d.src = p.in[1]; d.C = 1024; d.r0 = (tt >> 5) * 128; d.c0 = (tt & 31) * 32; d.dst = ws + WS_WIN; d.dld = 1024; }
    else if (tt < 1024) { const int t2 = tt - 256; d.src = p.in[3]; d.C = 3072; d.r0 = (t2 / 96) * 128; d.c0 = (t2 % 96) * 32; d.dst = ws + WS_WQKV; d.dld = 1024; }
    else if (tt < 1280) { const int t2 = tt - 1024; d.src = p.in[5]; d.C = 1024; d.r0 = (t2 >> 5) * 128; d.c0 = (t2 & 31) * 32; d.dst = ws + WS_WO; d.dld = 1024; }
    else { const int t3 = tt - 1280, ee = t3 >> 7, tl = t3 & 127, mat = ee & 63; d.kind = ee >> 6;
        if (d.kind < 2) { d.src = (d.kind == 0 ? p.in[8] : p.in[9]) + (size_t)mat * 1024 * 512; d.C = 512; d.r0 = (tl >> 4) * 128; d.c0 = (tl & 15) * 32; d.dst = ws + WS_WGU + (size_t)mat * 1024 * 1024; d.dld = 1024; }
        else { d.src = p.in[10] + (size_t)mat * 512 * 1024; d.C = 1024; d.r0 = (tl >> 5) * 128; d.c0 = (tl & 31) * 32; d.dst = ws + WS_WD + (size_t)mat * 1024 * 512; d.dld = 512; } }
    return d;
}
__device__ __forceinline__ void tile_load(const TileDesc& d, f32x4 (&v)[16], int lane) {
#pragma unroll
    for (int ps = 0; ps < 16; ++ps) v[ps] = __builtin_nontemporal_load((const f32x4*)(d.src + (size_t)(d.r0 + ps * 8 + (lane >> 3)) * d.C + d.c0 + (lane & 7) * 4));
}
__device__ __forceinline__ void tile_store(const TileDesc& d, const f32x4 (&v)[16], LAS float* tile, int lane) {
#pragma unroll
    for (int ps = 0; ps < 16; ++ps) { const int row = ps * 8 + (lane >> 3), col4 = (lane & 7) * 4;
        tile[row * 33 + col4 + 0] = v[ps][0]; tile[row * 33 + col4 + 1] = v[ps][1]; tile[row * 33 + col4 + 2] = v[ps][2]; tile[row * 33 + col4 + 3] = v[ps][3]; }
    __builtin_amdgcn_fence(__ATOMIC_RELEASE, "wavefront"); __builtin_amdgcn_wave_barrier(); __builtin_amdgcn_fence(__ATOMIC_ACQUIRE, "wavefront");
#pragma unroll
    for (int ps = 0; ps < 4; ++ps) { const int n = ps * 8 + (lane >> 3), kc = (lane & 7) * 16; float a[16];
#pragma unroll
        for (int j = 0; j < 16; ++j) a[j] = tile[(kc + j) * 33 + n] * W_SCALE;
        const int nn = d.c0 + n; const int drow = (d.kind == 0 || d.kind == 1) ? (256 * (nn >> 7) + (nn & 127) + 128 * d.kind) : nn;
        u32x4 w; w.x = pk4_fp8(a[0], a[1], a[2], a[3]); w.y = pk4_fp8(a[4], a[5], a[6], a[7]); w.z = pk4_fp8(a[8], a[9], a[10], a[11]); w.w = pk4_fp8(a[12], a[13], a[14], a[15]);
        *(u32x4*)(d.dst + (size_t)drow * d.dld + d.r0 + kc) = w; }
    __builtin_amdgcn_fence(__ATOMIC_RELEASE, "wavefront"); __builtin_amdgcn_wave_barrier(); __builtin_amdgcn_fence(__ATOMIC_ACQUIRE, "wavefront");
}

__device__ __forceinline__ void transpose_share(const Params& p, LAS unsigned char* lds, int wid, int lane, int nslot, int slot0) {
    LAS float* tile = (LAS float*)lds + wid * (128 * 33); constexpr int NT = 1280 + 192 * 128; const int G = gridDim.x;
    for (int rnd = 0; (rnd * G) * 22 < NT; ++rnd) { const int base = (rnd * G + (int)blockIdx.x) * 22 + slot0;
        const int t0 = base, t1 = base + 1, t2 = base + 2;
        if (t0 < NT) { const bool two = t1 < NT; const TileDesc d0 = tile_desc(p, t0), d1 = tile_desc(p, two ? t1 : t0);
            f32x4 v0[16], v1[16]; tile_load(d0, v0, lane); tile_load(d1, v1, lane);
            tile_store(d0, v0, tile, lane); if (two) tile_store(d1, v1, tile, lane); }
        if (nslot > 2 && t2 < NT) { const TileDesc d2 = tile_desc(p, t2); f32x4 v2[16]; tile_load(d2, v2, lane); tile_store(d2, v2, tile, lane); } }
}
__device__ __forceinline__ void phase_prologue(const Params& p, LAS unsigned char* lds) {
    const int tid = tid_fresh(), lane = tid & 63, wid = __builtin_amdgcn_readfirstlane(tid >> 6); unsigned char* ws = p.ws;
    if (wid < 6) {
        { const float* x = p.in[0]; unsigned char* xb = (unsigned char*)(ws + WS_S0); bf16_t* xh = (bf16_t*)p.out; const size_t stride = (size_t)gridDim.x * 384 * 8, total = (size_t)T * DM;
          for (size_t i = ((size_t)blockIdx.x * 384 + tid) * 8; i < total; i += 4 * stride) {
              f32x4 a[4], b[4];
#pragma unroll
              for (int u = 0; u < 4; ++u) { const size_t o = i + u * stride < total ? i + u * stride : i; a[u] = __builtin_nontemporal_load((const f32x4*)(x + o)); b[u] = __builtin_nontemporal_load((const f32x4*)(x + o + 4)); }
#pragma unroll
              for (int u = 0; u < 4; ++u) if (i + u * stride < total) { u32x2 w; w.x = pk4_fp8(a[u][0], a[u][1], a[u][2], a[u][3]); w.y = pk4_fp8(b[u][0], b[u][1], b[u][2], b[u][3]); *(u32x2*)(xb + i + u * stride) = w;
                  *(u32x4*)(xh + i + u * stride) = pack8(a[u], b[u]); } } }
        transpose_share(p, lds, wid, lane, 3, 3 * wid);
    } else {
        const int gw = blockIdx.x * 2 + (wid - 6), gl = gw * 64 + lane;
        { bf16_t* F1 = (bf16_t*)(ws + WS_F1); bf16_t* F2 = (bf16_t*)(ws + WS_F2);
          { const int idx = gl; const int m1 = idx >> 7, s1 = idx & 127; float v = 0.f;
            if (m1 < 128) { const int g = m1 >> 1, ri = m1 & 1;
                if (g == 0) v = ri ? ((s1 & 1) ? -1.f : 1.f) : 1.f;
                else { const float ph = (float)((s1 * g) & 127) * (1.0f / 128.0f); v = ri ? -__builtin_amdgcn_sinf(ph) : __builtin_amdgcn_cosf(ph); } }
            F1[idx] = (bf16_t)(cvt_pk_bf16(v, 0.f) & 0xffffu); }
          const float sc = 0.011048543456039806f;
          for (int idx = gl; idx < 64 * 256 * 128; idx += 32768) { const int g = idx >> 15, m2 = (idx >> 7) & 255, kk = idx & 127;
              const int hsel = m2 >> 7, k2 = (m2 & 127) >> 1, rip = m2 & 1, slot = kk >> 6, s2 = kk & 63;
              const int k1 = hsel ? (g ? 128 - g : 64) : g, k = k1 + 128 * k2;
              const float ph = (float)((s2 * k) & 8191) * (1.0f / 8192.0f); const float cs = __builtin_amdgcn_cosf(ph), sn = __builtin_amdgcn_sinf(ph);
              float v;
              if (g == 0) { v = (slot == hsel) ? (rip ? -sn : cs) : 0.f; }
              else if (hsel == 0) { v = rip ? (slot ? cs : -sn) : (slot ? sn : cs); }
              else { v = rip ? (slot ? -cs : -sn) : (slot ? -sn : cs); }
              F2[idx] = (bf16_t)(cvt_pk_bf16(v * sc, 0.f) & 0xffffu); } }
        { LAS float* ctab = (LAS float*)(lds + 135168) + (wid - 6) * 512; LAS float* stab = ctab + 256; const float* wout = p.in[2]; unsigned char* W2 = (unsigned char*)(ws + WS_W2);
#pragma unroll
          for (int u = 0; u < 4; ++u) { const float ph = (float)(lane + 64 * u) * (1.0f / 256.0f); ctab[lane + 64 * u] = __builtin_amdgcn_cosf(ph); stab[lane + 64 * u] = __builtin_amdgcn_sinf(ph); }
          __builtin_amdgcn_fence(__ATOMIC_RELEASE, "wavefront"); __builtin_amdgcn_wave_barrier(); __builtin_amdgcn_fence(__ATOMIC_ACQUIRE, "wavefront");
          for (int item = gw; item < 4 * 4 * 64; item += 512) { const int gp = item >> 8, cq = (item >> 6) & 3, n0 = (item & 63) * 16, c = cq * 64 + lane;
              float ac[16], as[16];
#pragma unroll
              for (int j = 0; j < 16; ++j) { ac[j] = 0.f; as[j] = 0.f; }
              const float* wrow = wout + (size_t)(gp * 256) * 1024 + n0 + (lane & 15);
#pragma unroll 4
              for (int k2 = 0; k2 < 256; ++k2) { const int ix = (c * k2) & 255; const float cv = ctab[ix], sv = stab[ix]; const float wv = wrow[(size_t)k2 * 1024];
#pragma unroll
                  for (int j = 0; j < 16; ++j) { const float w = __builtin_bit_cast(float, __builtin_amdgcn_readlane(__builtin_bit_cast(int, wv), j)); ac[j] += cv * w; as[j] += sv * w; } }
#pragma unroll
              for (int j = 0; j < 16; ++j) { unsigned char* o = W2 + (size_t)(n0 + j) * 2048 + gp * 256 + c;
                  o[0] = (unsigned char)(pk4_fp8(ac[j] * (0.0625f * W2_SCALE), 0.f, 0.f, 0.f) & 0xffu); o[1024] = (unsigned char)(pk4_fp8(as[j] * (0.0625f * W2_SCALE), 0.f, 0.f, 0.f) & 0xffu); } } }
        transpose_share(p, lds, wid, lane, 2, 18 + 2 * (wid - 6));
    }
    __syncthreads();
}

typedef _Float16 f16x8 __attribute__((ext_vector_type(8)));
typedef _Float16 f16x4 __attribute__((ext_vector_type(4)));
constexpr int LA_HT = 0, LA_RED = 65536, LA_SEL = 65536 + 32768, LA_ASG = LA_SEL + 8192, LA_MISC = LA_ASG + 1024;
__device__ __forceinline__ void phase_lnA(const Params& p, LAS unsigned char* lds, const int L, const bf16_t* res16, const bf16_t* ybuf, bf16_t* hb, unsigned char* h8) {
    const int tid = tid_fresh(), lane = tid & 63, wid = __builtin_amdgcn_readfirstlane(tid >> 6), fr = lane & 15, fq = lane >> 4;
    unsigned char* ws = p.ws;
    LAS unsigned char* ht = lds + LA_HT;
    LAS float* red = (LAS float*)(lds + LA_RED);
    LAS float* selL = (LAS float*)(lds + LA_SEL);
    LAS int* asgE = (LAS int*)(lds + LA_ASG);
    LAS int* misc = (LAS int*)(lds + LA_MISC);
    f16x8 wf[2][4];
    { const float* wrg = p.in[6];
#pragma unroll
      for (int eb = 0; eb < 2; ++eb)
#pragma unroll
          for (int sx = 0; sx < 4; ++sx)
#pragma unroll
              for (int j = 0; j < 8; ++j) wf[eb][sx][j] = (_Float16)wrg[(size_t)(128 * wid + 32 * sx + 8 * fq + j) * 32 + fr + 16 * eb]; }
    const float* lg = p.in[11] + (L * 2 + 0) * 1024; const float* lb = p.in[12] + (L * 2 + 0) * 1024;
    f32x4 gv[4], bv[4];
#pragma unroll
    for (int k = 0; k < 4; ++k) { gv[k] = *(const f32x4*)(lg + 512 * (k >> 1) + 8 * lane + 4 * (k & 1)); bv[k] = *(const f32x4*)(lb + 512 * (k >> 1) + 8 * lane + 4 * (k & 1)); }
    const float br = p.in[7][tid & 31];
    float* gates = (float*)(ws + WS_GATE);
    const int tok0 = blockIdx.x * 128;
#ifndef LNA_REP
#define LNA_REP 1
#endif
    u32x4 rx16[4][2], ryw[4][2];
#define LA_LOAD(gg) do { _Pragma("unroll") for (int tk = 0; tk < 4; ++tk) { const size_t rowo_ = (size_t)(tok0 + (gg) * 32 + 4 * wid + tk) * DM; _Pragma("unroll") for (int jj = 0; jj < 2; ++jj) { const size_t co_ = rowo_ + 512 * jj + 8 * lane; \
        rx16[tk][jj] = *(const u32x4*)(res16 + co_); ryw[tk][jj] = *(const u32x4*)(ybuf + co_); } } } while (0)
    LA_LOAD(0);
#pragma unroll 1
    for (int g_ = 0; g_ < 4 * LNA_REP; ++g_) { const int g = g_ & 3;
        f32x4 hv[4][4];
#pragma unroll
        for (int tk = 0; tk < 4; ++tk) {
#pragma unroll
            for (int jj = 0; jj < 2; ++jj) { f32x4 xa, xb2, ya, yb; bf8_to_f32(rx16[tk][jj], xa, xb2); bf8_to_f32(ryw[tk][jj], ya, yb);
                hv[tk][2 * jj] = ALPHA * xa + ya; hv[tk][2 * jj + 1] = ALPHA * xb2 + yb; } }
        float sm[4], qv[4];
#pragma unroll
        for (int tk = 0; tk < 4; ++tk) { float s = 0.f;
#pragma unroll
            for (int j = 0; j < 4; ++j) s += (hv[tk][j][0] + hv[tk][j][1]) + (hv[tk][j][2] + hv[tk][j][3]);
            sm[tk] = s; }
#pragma unroll
        for (int o = 32; o >= 1; o >>= 1) {
#pragma unroll
            for (int tk = 0; tk < 4; ++tk) sm[tk] += __shfl_xor(sm[tk], o); }
#pragma unroll
        for (int tk = 0; tk < 4; ++tk) { sm[tk] *= (1.0f / 1024.0f); float q = 0.f;
#pragma unroll
            for (int j = 0; j < 4; ++j) { const f32x4 d = hv[tk][j] - sm[tk]; q += (d[0] * d[0] + d[1] * d[1]) + (d[2] * d[2] + d[3] * d[3]); }
            qv[tk] = q; }
#pragma unroll
        for (int o = 32; o >= 1; o >>= 1) {
#pragma unroll
            for (int tk = 0; tk < 4; ++tk) qv[tk] += __shfl_xor(qv[tk], o); }
#pragma unroll
        for (int tk = 0; tk < 4; ++tk) { const int ts = 4 * wid + tk; const size_t rowo = (size_t)(tok0 + g * 32 + ts) * DM; const float rstd = 1.0f / sqrtf(qv[tk] * (1.0f / 1024.0f) + LN_EPS);
#pragma unroll
            for (int jj = 0; jj < 2; ++jj) { const size_t co = rowo + 512 * jj + 8 * lane;
                const f32x4 h0 = (hv[tk][2 * jj] - sm[tk]) * rstd * gv[2 * jj] + bv[2 * jj], h1 = (hv[tk][2 * jj + 1] - sm[tk]) * rstd * gv[2 * jj + 1] + bv[2 * jj + 1];
                *(u32x4*)(hb + co) = pack8(h0, h1);
                u32x2 w8; w8.x = pk4_fp8(h0[0], h0[1], h0[2], h0[3]); w8.y = pk4_fp8(h1[0], h1[1], h1[2], h1[3]); *(u32x2*)(h8 + co) = w8;
                const f16x8 hh = (f16x8){(_Float16)h0[0], (_Float16)h0[1], (_Float16)h0[2], (_Float16)h0[3], (_Float16)h1[0], (_Float16)h1[1], (_Float16)h1[2], (_Float16)h1[3]};
                const int chunk = (64 * jj + lane) ^ (ts & 15);
                *(LAS f16x8*)(ht + ts * 2048 + chunk * 16) = hh; } }
        if (g_ + 1 < 4 * LNA_REP) LA_LOAD((g_ + 1) & 3);
        __syncthreads();
#pragma unroll
        for (int tb = 0; tb < 2; ++tb) { f32x4 d0 = (f32x4){0.f, 0.f, 0.f, 0.f}, d1 = d0;
#pragma unroll
          for (int sx = 0; sx < 4; ++sx) { const int chunk = (16 * wid + 4 * sx + fq) ^ fr; const f16x8 hf = *(const LAS f16x8*)(ht + (16 * tb + fr) * 2048 + chunk * 16);
              d0 = __builtin_amdgcn_mfma_f32_16x16x32_f16(wf[0][sx], hf, d0, 0, 0, 0); d1 = __builtin_amdgcn_mfma_f32_16x16x32_f16(wf[1][sx], hf, d1, 0, 0, 0); }
          *(LAS f32x4*)(red + wid * 1024 + (16 * tb + fr) * 32 + 4 * fq) = d0; *(LAS f32x4*)(red + wid * 1024 + (16 * tb + fr) * 32 + 16 + 4 * fq) = d1; }
        __syncthreads();
#pragma unroll
        for (int u = 0; u < 2; ++u) { const int ix = tid + 512 * u; float lgt = 0.f;
#pragma unroll
          for (int w = 0; w < 8; ++w) lgt += red[w * 1024 + ix];
          const float sc = 1.0f / (1.0f + __expf(-lgt)); selL[ix] = sc + br; selL[1024 + ix] = sc; }
        __syncthreads();
        if (lane < 4) { const int tq = 4 * wid + lane; const LAS f32x4* sel4 = (const LAS f32x4*)(selL + tq * 32); float best = -3.0e38f; int bg = 0, b1 = 0, b2 = 0;
            f32x4 sv[8];
#pragma unroll
            for (int q = 0; q < 8; ++q) sv[q] = sel4[q];
#pragma unroll
            for (int gg = 0; gg < 4; ++gg) { float m1 = -3.0e38f, m2 = -3.0e38f; int i1 = 0, i2 = 0;
#pragma unroll
                for (int j = 0; j < 8; ++j) { const float v = sv[gg * 2 + (j >> 2)][j & 3]; const bool gt1 = v > m1, gt2 = v > m2;
                    m2 = gt1 ? m1 : (gt2 ? v : m2); i2 = gt1 ? i1 : (gt2 ? j : i2); m1 = gt1 ? v : m1; i1 = gt1 ? j : i1; }
                const float gs = m1 + m2; if (gs > best) { best = gs; bg = gg; b1 = i1; b2 = i2; } }
            const int e1 = bg * 8 + b1, e2 = bg * 8 + b2; const float s1 = selL[1024 + tq * 32 + e1], s2 = selL[1024 + tq * 32 + e2], inv = 1.0f / (s1 + s2);
            const int tl = g * 32 + tq; asgE[2 * tl] = e1; asgE[2 * tl + 1] = e2;
            const int t = tok0 + tl; gates[2 * t] = s1 * inv; gates[2 * t + 1] = s2 * inv; }
    }
    __syncthreads();
#undef LA_LOAD
    int my_e = 0, my_rank = 0; LAS int* cntW = misc + 32;
    if (tid < 256) { my_e = asgE[tid]; unsigned long long mym = 0ull; int cw = 0;
#pragma unroll
        for (int e = 0; e < 32; ++e) { const unsigned long long m = __ballot(my_e == e); if (my_e == e) mym = m; if (lane == e) cw = (int)__builtin_popcountll(m); }
        my_rank = (int)__builtin_popcountll(mym & ((1ull << lane) - 1ull));
        if (lane < 32) cntW[wid * 32 + lane] = cw; }
    __syncthreads();
    if (tid < 256) { for (int w = 0; w < 3; ++w) if (w < wid) my_rank += cntW[w * 32 + my_e]; }
    if (tid < 32) { const int c = cntW[tid] + cntW[32 + tid] + cntW[64 + tid] + cntW[96 + tid];
        unsigned* cnt = (unsigned*)(ws + WS_CTL) + CNT_WORD0 + (L * 32 + tid) * 64;
        misc[tid] = (int)__hip_atomic_fetch_add(cnt, (unsigned)c, __ATOMIC_RELAXED, __HIP_MEMORY_SCOPE_AGENT); }
    __syncthreads();
    if (tid < 256) { int* list = (int*)(ws + WS_LIST); list[(size_t)my_e * NASG + misc[my_e] + my_rank] = blockIdx.x * 256 + tid; }
    __syncthreads();
}

__device__ __forceinline__ void phase_lnB(const Params& p, const int L, const bf16_t* hb, const unsigned char* ys, bf16_t* xb_out, unsigned char* x8_out, float* f_out) {
    const int tid = tid_fresh(), lane = tid & 63, wid = tid >> 6;
    const float* lg = p.in[11] + (L * 2 + 1) * 1024; const float* lb = p.in[12] + (L * 2 + 1) * 1024;
    const float* gates = (const float*)(p.ws + WS_GATE);
    f32x4 gv[4], bv[4];
#pragma unroll
    for (int k = 0; k < 4; ++k) { gv[k] = *(const f32x4*)(lg + 512 * (k >> 1) + 8 * lane + 4 * (k & 1)); bv[k] = *(const f32x4*)(lb + 512 * (k >> 1) + 8 * lane + 4 * (k & 1)); }
    const int tok0 = blockIdx.x * 128 + wid * 16;
    u32x4 rh[2][2]; u32x2 ry0[2][2], ry1[2][2]; f32x2 rg[2];
#define LB_LOAD(tt) do { _Pragma("unroll") for (int u_ = 0; u_ < 2; ++u_) { const int t_ = (tt) + u_; const size_t ro_ = (size_t)t_ * DM; rg[u_] = *(const f32x2*)(gates + 2 * t_); _Pragma("unroll") for (int jj = 0; jj < 2; ++jj) { \
        const size_t co_ = 512 * jj + 8 * lane; rh[u_][jj] = *(const u32x4*)(hb + ro_ + co_); ry0[u_][jj] = *(const u32x2*)(ys + (size_t)(2 * t_) * DM + co_); ry1[u_][jj] = *(const u32x2*)(ys + (size_t)(2 * t_ + 1) * DM + co_); } } } while (0)
    LB_LOAD(tok0);
#pragma unroll 1
    for (int it = 0; it < 8; ++it) {
        u32x4 ch[2][2]; u32x2 cy0[2][2], cy1[2][2]; f32x2 cg[2];
#pragma unroll
        for (int u = 0; u < 2; ++u) { cg[u] = rg[u];
#pragma unroll
            for (int jj = 0; jj < 2; ++jj) { ch[u][jj] = rh[u][jj]; cy0[u][jj] = ry0[u][jj]; cy1[u][jj] = ry1[u][jj]; } }
        if (it < 7) LB_LOAD(tok0 + 2 * it + 2);
#pragma unroll
        for (int u = 0; u < 2; ++u) { const int t = tok0 + 2 * it + u; const size_t rowo = (size_t)t * DM; const float g0 = cg[u].x * (1.0f / YS_SCALE), g1 = cg[u].y * (1.0f / YS_SCALE);
            f32x4 v[4]; float s = 0.f;
#pragma unroll
            for (int jj = 0; jj < 2; ++jj) { f32x4 ha, hb2; bf8_to_f32(ch[u][jj], ha, hb2);
                const f32x4 ya = fp8x4_to_f32(cy0[u][jj].x), yb = fp8x4_to_f32(cy0[u][jj].y), za = fp8x4_to_f32(cy1[u][jj].x), zb = fp8x4_to_f32(cy1[u][jj].y);
                const f32x4 w0 = ALPHA * ha + g0 * ya + g1 * za, w1 = ALPHA * hb2 + g0 * yb + g1 * zb;
                v[2 * jj] = w0; v[2 * jj + 1] = w1; s += ((w0[0] + w0[1]) + (w0[2] + w0[3])) + ((w1[0] + w1[1]) + (w1[2] + w1[3])); }
            const float mean = wave_sum(s) * (1.0f / 1024.0f); float q = 0.f;
#pragma unroll
            for (int k = 0; k < 4; ++k) { const f32x4 d = v[k] - mean; q += (d[0] * d[0] + d[1] * d[1]) + (d[2] * d[2] + d[3] * d[3]); }
            const float rstd = 1.0f / sqrtf(wave_sum(q) * (1.0f / 1024.0f) + LN_EPS);
#pragma unroll
            for (int jj = 0; jj < 2; ++jj) { const size_t co = 512 * jj + 8 * lane;
                const f32x4 o0 = (v[2 * jj] - mean) * rstd * gv[2 * jj] + bv[2 * jj], o1 = (v[2 * jj + 1] - mean) * rstd * gv[2 * jj + 1] + bv[2 * jj + 1];
                if (f_out) { *(f32x4*)(f_out + rowo + co) = o0; *(f32x4*)(f_out + rowo + co + 4) = o1; }
                if (xb_out) { *(u32x4*)(xb_out + rowo + co) = pack8(o0, o1);
                    u32x2 w8; w8.x = pk4_fp8(o0[0], o0[1], o0[2], o0[3]); w8.y = pk4_fp8(o1[0], o1[1], o1[2], o1[3]); *(u32x2*)(x8_out + rowo + co) = w8; } } }
    }
#undef LB_LOAD
}

__device__ __forceinline__ void glds4(const char* sbase, unsigned voff, unsigned lds_dst) {
    unsigned keep;
    asm volatile("s_mov_b32 %0, m0\n\ts_mov_b32 m0, %3\n\ts_nop 0\n\tglobal_load_lds_dword %1, %2\n\ts_mov_b32 m0, %0" : "=&s"(keep) : "v"(voff), "s"(sbase), "s"(lds_dst) : "memory");
}
constexpr int A8_K = 0, A8_V = 81920, A8_RP = 122880, A8_KBUF = 40960;
__device__ __forceinline__ long mk64(unsigned lo, unsigned hi) { return (long)(((unsigned long long)hi << 32) | (unsigned long long)lo); }
__device__ __forceinline__ void phase_attn(const Params& p, LAS unsigned char* lds, const unsigned char* q8, const unsigned char* k8, const unsigned char* vt8, unsigned char* ob) {
    const int tid = tid_fresh(), lane = tid & 63, wid = __builtin_amdgcn_readfirstlane(tid >> 6), fr = lane & 15, fq = lane >> 4;
    const unsigned lds0 = (unsigned)(__UINTPTR_TYPE__)lds;
    const int item = (gridDim.x == 256) ? (int)((blockIdx.x & 7) * 32 + (blockIdx.x >> 3)) : (int)blockIdx.x, b = item >> 6, r0 = (item & 63) * 2;
    const int rsU = min(max(r0 - 4, 0), 118);
    const int r = r0 + (wid >> 2), jq = wid & 3;
    const int rs = min(max(r - 4, 0), 120), c0 = min(max(16 * jq - 8, 0), 32), lrow0 = rs - rsU;
    unsigned offK; { const int tokl = tid >> 2, pc = tid & 3, lc = pc ^ ((tokl >> 2) & 3); offK = (unsigned)(tokl * DM + lc * 16); }
    unsigned offV[5];
#pragma unroll
    for (int k = 0; k < 5; ++k) { const int q = k * 512 + tid, d = q / 40, pc = q - d * 40, lc = pc ^ (d & 7); offV[k] = (unsigned)(d * T + lc * 16); }
    const unsigned offR = (unsigned)min(wid * 64 + lane, 464) * 4u;
    const char* kbase0 = (const char*)k8 + ((size_t)(b * SEQ + rsU * 64) * DM);
    const char* vbase0 = (const char*)vt8 + ((size_t)(b * SEQ + rsU * 64));
    const char* rbase0 = (const char*)p.in[4];
    const size_t tokq = (size_t)b * SEQ + r * 64 + 16 * jq + fr;
    const char* qrow = (const char*)q8 + tokq * DM + 8 * fq;
#define AT_ISSUE_A(h, buf) do { const char* kb_ = kbase0 + (h) * 64; _Pragma("unroll") for (int k = 0; k < 5; ++k) gm::glds16(kb_ + (size_t)k * 131072, offK, lds0 + A8_K + (buf) * A8_KBUF + k * 8192 + wid * 1024); \
        glds4(rbase0 + (h) * 1860, offR, lds0 + A8_RP + (buf) * 2048 + wid * 256); } while (0)
#define AT_ISSUE_B(h) do { const char* vb_ = vbase0 + (size_t)(h) * 64 * T; _Pragma("unroll") for (int k = 0; k < 5; ++k) gm::glds16(vb_, offV[k], lds0 + A8_V + k * 8192 + wid * 1024); } while (0)
#define AT_LDQ(h, q0, q1) do { asm volatile("global_load_dwordx2 %0, %2, off\n\tglobal_load_dwordx2 %1, %2, off offset:32" : "=&v"(q0), "=&v"(q1) : "v"(qrow + (h) * 64) : "memory"); } while (0)
    const int swzk = ((c0 >> 2) + (fr >> 2)) & 3;
    const int kofs0 = (lrow0 * 64 + c0 + fr) * 64 + ((((fq >> 1) ^ swzk)) << 4) + (fq & 1) * 8, kofs1 = (lrow0 * 64 + c0 + fr) * 64 + (((((fq >> 1) ^ swzk)) ^ 2) << 4) + (fq & 1) * 8;
    int vo[8][2];
#pragma unroll
    for (int i = 0; i < 8; ++i)
#pragma unroll
        for (int hf = 0; hf < 2; ++hf) { const int tokoff = (lrow0 + i) * 64 + c0 + 4 * fq + 16 * hf; vo[i][hf] = fr * 640 + (((tokoff >> 4) ^ (fr & 7)) << 4) + (tokoff & 15); }
    const int qc = 16 * jq + fr, cs = min(max(qc - 8, 0), 48);
    long qn0, qn1;
    AT_LDQ(0, qn0, qn1);
    AT_ISSUE_A(0, 0); AT_ISSUE_B(0);
#pragma unroll 1
    for (int h = 0; h < 16; ++h) {
        const int hn = h < 15 ? h + 1 : 15, kb = h & 1;
        asm volatile("s_waitcnt vmcnt(5)" : "+v"(qn0), "+v"(qn1) :: "memory");
        const long q0 = qn0, q1 = qn1;
        __builtin_amdgcn_s_barrier();
        AT_LDQ(hn, qn0, qn1);
        AT_ISSUE_A(hn, kb ^ 1);
        f32x4 s[16];
#pragma unroll
        for (int kbi = 0; kbi < 16; ++kbi) { const int i = kbi >> 1, half = kbi & 1;
            const long k0 = *(const LAS long*)(lds + A8_K + kb * A8_KBUF + kofs0 + i * 4096 + half * 1024), k1 = *(const LAS long*)(lds + A8_K + kb * A8_KBUF + kofs1 + i * 4096 + half * 1024);
            f32x4 a = (f32x4){0.f, 0.f, 0.f, 0.f};
            a = __builtin_amdgcn_mfma_f32_16x16x32_fp8_fp8(k0, q0, a, 0, 0, 0); a = __builtin_amdgcn_mfma_f32_16x16x32_fp8_fp8(k1, q1, a, 0, 0, 0); s[kbi] = a; }
        const LAS float* rp = (const LAS float*)(lds + A8_RP + kb * 2048);
        float mx = -3.0e38f; const int thr = cs - c0;
#pragma unroll
        for (int i = 0; i < 8; ++i) { const int ri = rs + i - r + 7;
#pragma unroll
            for (int j = 0; j < 4; ++j) { const int pos = 4 * fq + j; const bool sel0 = pos >= thr; const int ci = min(max(c0 + pos - qc + 15 + (sel0 ? 0 : 16), 0), 30);
                float bvv = rp[ri * 31 + ci]; asm volatile("" : "+v"(bvv)); const float v = (sel0 ? s[2 * i][j] : s[2 * i + 1][j]) * 0.125f + bvv; s[2 * i][j] = v; mx = fmaxf(mx, v); } }
        mx = fmaxf(mx, __shfl_xor(mx, 16)); mx = fmaxf(mx, __shfl_xor(mx, 32));
        const float mxp = mx - 4.1588830833596715f;
        float sum = 0.f;
#pragma unroll
        for (int i = 0; i < 8; ++i)
#pragma unroll
            for (int j = 0; j < 4; ++j) { const int pos = 4 * fq + j; const bool sel0 = pos >= thr; const float e = __expf(s[2 * i][j] - mxp); sum += e; s[2 * i][j] = sel0 ? e : 0.f; s[2 * i + 1][j] = sel0 ? 0.f : e; }
        sum += __shfl_xor(sum, 16); sum += __shfl_xor(sum, 32);
        asm volatile("s_waitcnt vmcnt(8)" ::: "memory");
        __builtin_amdgcn_s_barrier();
        f32x4 oacc[4];
#pragma unroll
        for (int db = 0; db < 4; ++db) oacc[db] = (f32x4){0.f, 0.f, 0.f, 0.f};
#pragma unroll
        for (int i = 0; i < 8; ++i) { const long pf = mk64(pk4_fp8(s[2 * i][0], s[2 * i][1], s[2 * i][2], s[2 * i][3]), pk4_fp8(s[2 * i + 1][0], s[2 * i + 1][1], s[2 * i + 1][2], s[2 * i + 1][3]));
#pragma unroll
            for (int db = 0; db < 4; ++db) { const unsigned lo = *(const LAS unsigned*)(lds + A8_V + vo[i][0] + db * 10240), hi = *(const LAS unsigned*)(lds + A8_V + vo[i][1] + db * 10240);
                oacc[db] = __builtin_amdgcn_mfma_f32_16x16x32_fp8_fp8(mk64(lo, hi), pf, oacc[db], 0, 0, 0); } }
        asm volatile("s_waitcnt lgkmcnt(0)" ::: "memory");
        __builtin_amdgcn_s_barrier();
        AT_ISSUE_B(hn);
        const float inv = O_SCALE / sum;
#pragma unroll
        for (int db = 0; db < 4; ++db) *(unsigned*)(ob + tokq * DM + h * 64 + 16 * db + 4 * fq) = pk4_fp8(oacc[db][0] * inv, oacc[db][1] * inv, oacc[db][2] * inv, oacc[db][3] * inv);
    }
    asm volatile("s_waitcnt vmcnt(0)" ::: "memory");
    __builtin_amdgcn_s_barrier();
#undef AT_ISSUE_A
#undef AT_ISSUE_B
#undef AT_LDQ
}

template <int SRC_SHIFT>
__device__ __forceinline__ int moe_setup(const Params& p, LAS unsigned char* lds, const int L, LAS int* ts, LAS int* idxsrc, LAS int* idxdst) {
    const int tid = tid_fresh(), lane = tid & 63; unsigned char* ws = p.ws;
    LAS int* cn = ts + 40;
    if (tid < 64) {
        const int c = (int)__hip_atomic_load((unsigned*)(ws + WS_CTL) + CNT_WORD0 + (L * 32 + (lane & 31)) * 64, __ATOMIC_RELAXED, __HIP_MEMORY_SCOPE_AGENT);
        const int nt = (c + 255) >> 8; int incl = nt;
#pragma unroll
        for (int o = 1; o < 32; o <<= 1) { const int up = __shfl_up(incl, o); if ((lane & 31) >= o) incl += up; }
        if (lane < 32) { cn[lane] = c; ts[lane] = incl - nt; if (lane == 31) ts[32] = incl; } }
    __syncthreads();
    const int ntile = ts[NE];
    gm::GridOrder o; o.init(ntile, 4, gridDim.x, blockIdx.x);
    const int* list = (const int*)(ws + WS_LIST);
#pragma unroll
    for (int k = 0; k < 4; ++k) { const int ui = 2 * k + (tid >> 8), r = tid & 255; int pm = 0, pn = 0; const bool ok_u = o.mn(ui, pm, pn);
        const int e = expert_of_tile(ts, ok_u ? pm : 0);
        if (ok_u) { const int j = pm - ts[e], ce = cn[e]; const int pos = j * 256 + r; const bool ok = pos < ce; const int a = list[(size_t)e * NASG + (ok ? pos : j * 256)];
            idxsrc[ui * 256 + r] = a >> SRC_SHIFT; idxdst[ui * 256 + r] = ok ? a : -1; } }
    __syncthreads();
    return ntile;
}

__device__ __forceinline__ bool in_rng(int lo, int hi, int k) { asm volatile("" : "+s"(lo), "+s"(hi)); return lo <= k && k < hi; }
__device__ __forceinline__ Params params_fresh() {
    Params r{};
#if defined(__HIP_DEVICE_COMPILE__)
    auto k = __builtin_amdgcn_kernarg_segment_ptr(); asm volatile("" : "+s"(k));
    const __attribute__((address_space(4))) Params* kp = (const __attribute__((address_space(4))) Params*)k;
#pragma unroll
    for (int i = 0; i < 13; ++i) r.in[i] = kp->in[i];
    r.out = kp->out; r.ws = kp->ws; r.ph_lo = kp->ph_lo; r.ph_hi = kp->ph_hi;
#endif
    return r;
}
__global__ void __launch_bounds__(512, 2) k_fwd(Params p_unused) {
    extern __shared__ __attribute__((aligned(16))) unsigned char lds_raw[];
    LAS unsigned char* lds = (LAS unsigned char*)lds_raw;
    const Params p0 = params_fresh();
    { const int tid = tid_fresh(); if (tid < 4) ((LAS unsigned*)(lds + LDS_BARW))[tid] = 0u; }
    __syncthreads();
    XcdBarrier bar; bar.bar = (unsigned*)(p0.ws + WS_CTL); bar.x = 0; bar.st = nullptr;
    const int lo = p0.ph_lo, hi = p0.ph_hi;
    if (hi - lo > 1) bar = xcd_barrier_post((unsigned*)(p0.ws + WS_CTL), (volatile LAS unsigned*)(lds + LDS_BARW));
#ifndef PHMASK
#define PHMASK 0xffff
#endif
#define IN(k) (((PHMASK >> (k)) & 1) && in_rng(lo, hi, (k)))
#define SEAM(k) do { if (IN((k) + 1)) xcd_barrier(bar); } while (0)
#define PH_PTRS const Params p = params_fresh(); unsigned char* ws = p.ws; const int G = gridDim.x, cb = blockIdx.x; \
    bf16_t* S0 = (bf16_t*)(ws + WS_S0); bf16_t* S1 = (bf16_t*)(ws + WS_S1); bf16_t* S2 = (bf16_t*)(ws + WS_S2); bf16_t* S3 = (bf16_t*)(ws + WS_S3); \
    unsigned char* H8 = (unsigned char*)p.out + 64 * MiB; unsigned char* X8 = (unsigned char*)p.out + 96 * MiB; bf16_t* D0 = (bf16_t*)p.out; (void)X8; \
    LAS int* idxsrc = (LAS int*)(lds + LDS_IDX); LAS int* idxdst = idxsrc + 8 * 256; LAS int* tsm = (LAS int*)(lds + LDS_MISC); \
    (void)G; (void)cb; (void)S0; (void)S1; (void)S2; (void)S3; (void)H8; (void)D0; (void)idxsrc; (void)idxdst; (void)tsm;

    if (IN(0)) { PH_PTRS phase_prologue(p, lds); SEAM(0); }

#pragma unroll 1
    for (int L = 0; L < 2; ++L) {
        const int pb = 7 * L;
        if (L == 0) {
            if (IN(1)) {
                PH_PTRS SchedG1 S; S.o.init(4, 128, G, cb); S.WinT = (const char*)(ws + WS_WIN); S.xb = (const char*)S0; EpiG1 E{S1, 1.0f / W_SCALE};
                gm::gemm_phase<EpiG1, SchedG1, false, true>(lds, 1024, 1024u, 64u * 1024u, S, E, nullptr); SEAM(1); }
            if (IN(2)) {
                PH_PTRS SchedS1 S{G, cb, (const char*)(ws + WS_F1), (const char*)S1}; EpiS1 E{S0};
                gm::gemm_phase<EpiS1, SchedS1, false>(lds, 256, 256u, 256u, S, E, nullptr); SEAM(2); }
            if (IN(3)) {
                PH_PTRS SchedS2 S; S.o.init(64, 16, G, cb); S.F2 = (const char*)(ws + WS_F2); S.A1 = (const char*)S0; EpiS2 E{(unsigned char*)S1};
                gm::gemm_phase<EpiS2, SchedS2, false>(lds, 256, 256u, 256u, S, E, nullptr); SEAM(3); }
        } else {
            if (IN(9)) {
                PH_PTRS
                { SchedPlain S; S.o.init(128, 8, G, cb); S.A = (const char*)X8; S.B = (const char*)(ws + WS_WQKV); S.ldA = 1024u; S.ldB = 1024u; S.p16 = true; EpiRow8 E{(unsigned char*)S1, 1024, 4, (size_t)32 * MiB, 1.0f / W_SCALE, 1.0f / W_SCALE};
                  gm::gemm_phase<EpiRow8, SchedPlain, false, true>(lds, 1024, 1024u, 1024u, S, E, nullptr); }
                { SchedPlain S; S.o.init(4, 128, G, cb); S.A = (const char*)(ws + WS_WQKV) + (size_t)2048 * 1024; S.B = (const char*)X8; S.ldA = 1024u; S.ldB = 1024u; S.p16 = true; EpiRow8 E{(unsigned char*)S3, (size_t)T, 0, 0, 1.0f / W_SCALE, 1.0f / W_SCALE};
                  gm::gemm_phase<EpiRow8, SchedPlain, false, true>(lds, 1024, 1024u, 1024u, S, E, nullptr); }
                SEAM(9); }
            if (IN(10)) { PH_PTRS phase_attn(p, lds, (const unsigned char*)S1, (const unsigned char*)S1 + 32 * MiB, (const unsigned char*)S3, (unsigned char*)S0); SEAM(10); }
        }
        if (L == 0) { if (IN(4)) {
            PH_PTRS SchedPlain S; S.o.init(128, 4, G, cb); S.A = (const char*)S1; S.B = (const char*)(ws + WS_W2); S.ldA = 2048u; S.ldB = 2048u;
            EpiRow E{S0, 1024, 0, 0, 1.0f / (Y_SCALE * W2_SCALE), 1.f};
            gm::gemm_phase<EpiRow, SchedPlain, false, true>(lds, 2048, 2048u, 2048u, S, E, nullptr); SEAM(4); } }
        else { if (IN(11)) {
            PH_PTRS SchedPlain S; S.o.init(128, 4, G, cb); S.A = (const char*)S0; S.B = (const char*)(ws + WS_WO); S.ldA = 1024u; S.ldB = 1024u;
            EpiRow E{S1, 1024, 0, 0, 1.0f / (W_SCALE * O_SCALE), 1.f};
            gm::gemm_phase<EpiRow, SchedPlain, false, true>(lds, 1024, 1024u, 1024u, S, E, nullptr); SEAM(11); } }
        if (IN(5 + pb)) { PH_PTRS phase_lnA(p, lds, L, D0, L == 0 ? S0 : S1, S3, H8); SEAM(5 + pb); }
        if (IN(6 + pb)) {
            PH_PTRS const int ntile = moe_setup<1>(p, lds, L, tsm, idxsrc, idxdst);
            SchedMoe S; S.o.init(ntile, 4, G, cb); S.ts = tsm; S.A = (const char*)H8; S.W = (const char*)(ws + WS_WGU) + (size_t)L * 32 * 1024 * 1024; S.wstride = (size_t)1024 * 1024; S.ldB = 1024u; S.hsB128 = true; S.tileA = 0u;
            EpiGU E{(unsigned char*)S0, idxdst};
            gm::gemm_phase<EpiGU, SchedMoe, true, true>(lds, 1024, 1024u, 1024u, S, E, idxsrc); SEAM(6 + pb); }
        if (IN(7 + pb)) {
            PH_PTRS int ntile; if (IN(6 + pb)) { __syncthreads(); ntile = tsm[NE]; } else ntile = moe_setup<0>(p, lds, L, tsm, idxsrc, idxdst);
            SchedMoe S; S.o.init(ntile, 4, G, cb); S.ts = tsm; S.A = (const char*)S0; S.W = (const char*)(ws + WS_WD) + (size_t)L * 32 * 1024 * 512; S.wstride = (size_t)1024 * 512; S.ldB = 512u; S.hsB128 = false; S.tileA = 256u * 512u;
            EpiDown E{(unsigned char*)S1, idxdst};
            gm::gemm_phase<EpiDown, SchedMoe, false, true>(lds, 512, 512u, 512u, S, E, nullptr); SEAM(7 + pb); }
        if (IN(8 + pb)) { PH_PTRS phase_lnB(p, L, S3, (const unsigned char*)S1, L == 0 ? D0 : nullptr, X8, L == 0 ? nullptr : p.out); if (L == 0) SEAM(8); }
    }
#undef IN
#undef SEAM
#undef PH_PTRS
}

extern "C" void kernel_launch(void* const* d_in, const int* in_sizes, int n_in, void* d_out, int out_size, void* d_ws, size_t ws_size, hipStream_t stream) {
    static int grid = 0;
    if (grid == 0) {
        if (n_in != 13 || in_sizes[0] != T * DM || out_size != T * DM || ws_size < WS_END) { fprintf(stderr, "kernel_launch: unexpected shapes / workspace (%d inputs, in0 %d, out %d, ws %zu < %zu)\n", n_in, n_in > 0 ? in_sizes[0] : -1, out_size, ws_size, (size_t)WS_END); grid = -1; return; }
        int dev = 0, cus = 0, per_cu = 0;
        if (hipGetDevice(&dev) != hipSuccess || hipDeviceGetAttribute(&cus, hipDeviceAttributeMultiprocessorCount, dev) != hipSuccess) { grid = -1; return; }
        if (hipFuncSetAttribute((const void*)k_fwd, hipFuncAttributeMaxDynamicSharedMemorySize, LDS_BYTES) != hipSuccess) { fprintf(stderr, "kernel_launch: hipFuncSetAttribute failed\n"); grid = -1; return; }
        if (hipOccupancyMaxActiveBlocksPerMultiprocessor(&per_cu, (const void*)k_fwd, 512, LDS_BYTES) != hipSuccess || per_cu < 1) fprintf(stderr, "kernel_launch: occupancy query says %d\n", per_cu);
        (void)hipGetLastError();
        grid = cus;
    }
    if (grid < 0) return;
    (void)hipMemsetAsync((char*)d_ws + WS_CTL, 0, CTL_ZERO_BYTES, stream);
    Params a{};
    for (int i = 0; i < 13; ++i) a.in[i] = (const float*)d_in[i];
    a.out = (float*)d_out; a.ws = (unsigned char*)d_ws;
#if MK_N_LAUNCHES == 1
    a.ph_lo = 0; a.ph_hi = NPH;
    hipLaunchKernelGGL(k_fwd, dim3(grid), dim3(512), LDS_BYTES, stream, a);
#else
    for (int k = 0; k < NPH; ++k) { a.ph_lo = k; a.ph_hi = k + 1; const int reps = ((REPMASK >> k) & 1) ? 2 : 1;
        for (int r = 0; r < reps; ++r) hipLaunchKernelGGL(k_fwd, dim3(grid), dim3(512), LDS_BYTES, stream, a); }
#endif
}
```

```cpp
#include <hip/hip_runtime.h>
#include <cstdio>
#include <cstdint>

#ifndef MK_N_LAUNCHES
#define MK_N_LAUNCHES 1
#endif
#ifndef REPMASK
#define REPMASK 0x0
#endif

#define LAS __attribute__((address_space(3)))
typedef unsigned short bf16_t;
typedef short bf16x8 __attribute__((ext_vector_type(8)));
typedef short bf16x4 __attribute__((ext_vector_type(4)));
typedef float f32x4 __attribute__((ext_vector_type(4)));
typedef float f32x2 __attribute__((ext_vector_type(2)));
typedef unsigned u32x4 __attribute__((ext_vector_type(4)));
typedef unsigned u32x2 __attribute__((ext_vector_type(2)));

constexpr int T = 32768, DM = 1024, SEQ = 8192, NBATCH = 4, NE = 32, DEX = 512, NASG = 65536, NPH = 16;
constexpr float ALPHA = 1.41421356237309515f;
constexpr float LN_EPS = 1e-5f;
constexpr size_t MiB = (size_t)1 << 20;
constexpr size_t WS_CTL = 0, WS_GATE = 1 * MiB, WS_LIST = 2 * MiB, WS_WIN = 10 * MiB, WS_W2 = 12 * MiB, WS_F1 = 16 * MiB, WS_F2 = 17 * MiB, WS_WQKV = 21 * MiB, WS_WO = 27 * MiB,
                 WS_WGU = 30 * MiB, WS_WD = 158 * MiB, WS_S0 = 222 * MiB, WS_S1 = 286 * MiB, WS_S2 = 350 * MiB, WS_S3 = 414 * MiB, WS_END = 478 * MiB;
constexpr size_t CTL_ZERO_BYTES = 65536;
constexpr int CNT_WORD0 = 4096;
constexpr int LDS_BYTES = 159760;
constexpr int LDS_IDX = 131072, LDS_MISC = 131072 + 16384, LDS_BARW = LDS_BYTES - 16;

#define XB_TMO      128
#define XB_XCNT(j)  (256  + 64 * (j))
#define XB_XSUB(j)  (1280 + 64 * (j))
#define XB_XGEN(j)  (2304 + 64 * (j))
#define XB_TOP      3328
#define XB_TOPGEN   3392
#define XCD_BAR_WORDS 3456
#define XB_SPIN_CAP (1u << 18)

__device__ __forceinline__ unsigned xb_ld(unsigned* p)              { return __hip_atomic_load(p, __ATOMIC_RELAXED, __HIP_MEMORY_SCOPE_AGENT); }
__device__ __forceinline__ unsigned xb_add(unsigned* p, unsigned v) { return __hip_atomic_fetch_add(p, v, __ATOMIC_RELAXED, __HIP_MEMORY_SCOPE_AGENT); }
__device__ __forceinline__ unsigned xb_xcc_id() { return (unsigned)__builtin_amdgcn_s_getreg((3 << 11) | 20) & 0xFu; }
#define XB_SPIN(cond, bar) do { unsigned _sp = 0; while (cond) { __builtin_amdgcn_s_sleep(1); \
    if ((++_sp & 255u) == 0u) { if (xb_ld(&(bar)[XB_TMO])) break; if (_sp > XB_SPIN_CAP) { atomicAdd(&(bar)[XB_TMO], 1u); break; } } } } while (0)

struct XcdBarrier { unsigned* bar; unsigned x; volatile LAS unsigned* st; };

__device__ __forceinline__ XcdBarrier xcd_barrier_post(unsigned* bar, volatile LAS unsigned* st) {
    XcdBarrier b; b.bar = bar; b.x = xb_xcc_id(); b.st = st;
    if (threadIdx.x == 0) (void)xb_add(&bar[XB_XCNT(b.x)], 1u);
    return b;
}
__device__ __forceinline__ void xcd_barrier_complete(unsigned* bar, unsigned x, unsigned& nloc, unsigned& nx) {
    const unsigned G = gridDim.x * gridDim.y * gridDim.z;
    unsigned sum, cnt, mine, sp = 0u;
    for (;;) {
        sum = 0u; cnt = 0u; mine = 0u;
#pragma unroll
        for (unsigned j = 0; j < 16; ++j) { const unsigned c = xb_ld(&bar[XB_XCNT(j)]); sum += c; cnt += (c > 0u) ? 1u : 0u; mine = (j == x) ? c : mine; }
        if (sum == G) break;
        __builtin_amdgcn_s_sleep(1);
        if ((++sp & 255u) == 0u) { if (xb_ld(&bar[XB_TMO])) break; if (sp > XB_SPIN_CAP) { atomicAdd(&bar[XB_TMO], 1u); break; } }
    }
    nloc = mine > 0u ? mine : 1u; nx = cnt > 0u ? cnt : 1u;
}
__device__ __forceinline__ void xcd_barrier(const XcdBarrier& b) {
    asm volatile("s_waitcnt vmcnt(0)" ::: "memory");
    __syncthreads();
    if (threadIdx.x == 0) {
        unsigned* bar = b.bar;
        __builtin_amdgcn_s_waitcnt(0);
        unsigned nloc = b.st[0], nx = b.st[1];
        if (nloc == 0u) { xcd_barrier_complete(bar, b.x, nloc, nx); b.st[0] = nloc; b.st[1] = nx; }
        const unsigned old = xb_add(&bar[XB_XSUB(b.x)], 1u);
        const unsigned gen = old / nloc;
        if (old + 1u == (gen + 1u) * nloc) {
            __builtin_amdgcn_fence(__ATOMIC_RELEASE, "agent");
            asm volatile("s_waitcnt vmcnt(0)" ::: "memory");
            const unsigned og = xb_add(&bar[XB_TOP], 1u);
            const unsigned tg = og / nx;
            if (og + 1u == (tg + 1u) * nx) xb_add(&bar[XB_TOPGEN], 1u);
            else XB_SPIN(xb_ld(&bar[XB_TOPGEN]) == tg, bar);
            __builtin_amdgcn_fence(__ATOMIC_ACQUIRE, "agent");
            xb_add(&bar[XB_XGEN(b.x)], 1u);
            asm volatile("s_waitcnt vmcnt(0)" ::: "memory");
        } else {
            XB_SPIN(xb_ld(&bar[XB_XGEN(b.x)]) == gen, bar);
            __builtin_amdgcn_fence(__ATOMIC_ACQUIRE, "agent");
            asm volatile("s_waitcnt vmcnt(0)" ::: "memory");
        }
    }
    __syncthreads();
}

__device__ __forceinline__ unsigned cvt_pk_bf16(float lo, float hi) { unsigned r; asm volatile("v_cvt_pk_bf16_f32 %0, %1, %2" : "=v"(r) : "v"(lo), "v"(hi)); return r; }
__device__ __forceinline__ float bf_lo(unsigned w) { return __uint_as_float(w << 16); }
__device__ __forceinline__ float bf_hi(unsigned w) { return __uint_as_float(w & 0xffff0000u); }
__device__ __forceinline__ u32x4 pack8(const f32x4 a, const f32x4 b) { u32x4 w; w.x = cvt_pk_bf16(a[0], a[1]); w.y = cvt_pk_bf16(a[2], a[3]); w.z = cvt_pk_bf16(b[0], b[1]); w.w = cvt_pk_bf16(b[2], b[3]); return w; }
__device__ __forceinline__ int tid_fresh() { int t = threadIdx.x; asm volatile("" : "+v"(t)); return t; }
__device__ __forceinline__ void bf8_to_f32(const u32x4 w, f32x4& a, f32x4& b) { a[0] = bf_lo(w.x); a[1] = bf_hi(w.x); a[2] = bf_lo(w.y); a[3] = bf_hi(w.y); b[0] = bf_lo(w.z); b[1] = bf_hi(w.z); b[2] = bf_lo(w.w); b[3] = bf_hi(w.w); }
__device__ __forceinline__ float wave_sum(float v) {
#pragma unroll
    for (int o = 32; o >= 1; o >>= 1) v += __shfl_xor(v, o);
    return v;
}

constexpr float W_SCALE = 64.0f, H_SCALE = 4.0f, O_SCALE = 16.0f, Y_SCALE = 8.0f, W2_SCALE = 256.0f, YS_SCALE = 16.0f;
__device__ __forceinline__ f32x4 fp8x4_to_f32(unsigned w) { f32x4 r; r[0] = __builtin_amdgcn_cvt_f32_fp8(w, 0); r[1] = __builtin_amdgcn_cvt_f32_fp8(w, 1); r[2] = __builtin_amdgcn_cvt_f32_fp8(w, 2); r[3] = __builtin_amdgcn_cvt_f32_fp8(w, 3); return r; }
__device__ __forceinline__ float silu_mul(float g, float up) { return g * __builtin_amdgcn_rcpf(1.0f + __expf(-g)) * up; }
__device__ __forceinline__ unsigned pk4_fp8(float a, float b, float c, float d) { unsigned r = 0; r = __builtin_amdgcn_cvt_pk_fp8_f32(a, b, r, false); r = __builtin_amdgcn_cvt_pk_fp8_f32(c, d, r, true); return r; }
namespace gm {
constexpr int BM = 256, BK = 64, HALF = 128, HTB = HALF * BK * 2, STAGE_BYTES = 8 * HTB, NXCD = 8, WGM = 16;
__device__ __forceinline__ int lds_byte(int r, int c) { const int st = (r >> 4) * 2 + (c >> 5), rr = r & 15, cc = c & 31, ob = rr * 64 + cc * 2; return st * 1024 + (ob ^ (((ob >> 9) & 1) << 5)); }
__device__ __forceinline__ void stage_rc(int b, int& R, int& C) { const int st = b / 1024, sb = b % 1024, swz = sb ^ (((sb >> 9) & 1) << 5); R = (st >> 1) * 16 + swz / 64; C = (st & 1) * 32 + (swz % 64) / 2; }
__device__ __forceinline__ int perm32(int rho) { const int n = rho >> 4, i = rho & 15; return 8 * (i >> 2) + 4 * n + (i & 3); }

__device__ __forceinline__ void glds16(const char* sbase, unsigned voff, unsigned lds_dst) {
    unsigned keep;
    asm volatile("s_mov_b32 %0, m0\n\ts_mov_b32 m0, %3\n\ts_nop 0\n\tglobal_load_lds_dwordx4 %1, %2\n\ts_mov_b32 m0, %0" : "=&s"(keep) : "v"(voff), "s"(sbase), "s"(lds_dst) : "memory");
}
struct Unit { const char* A; const char* B; unsigned hsA, hsB; int pm, pn, x0, x1; };

struct GridOrder {
    int nM, nN, nwg, G, c;
    __device__ __forceinline__ void init(int nM_, int nN_, int G_, int c_) { nM = nM_; nN = nN_; nwg = nM * nN; G = G_; c = c_; }
    __device__ __forceinline__ bool mn(int i, int& pm, int& pn) const {
        const long L = (long)i * G + c; if (L >= nwg) return false;
        int wgid = (int)L; { const int q = nwg / NXCD, r = nwg % NXCD, xcd = wgid % NXCD, off = wgid / NXCD; wgid = (xcd < r ? xcd * (q + 1) : r * (q + 1) + (xcd - r) * q) + off; }
        const int nig = WGM * nN, gid = wgid / nig, fm = gid * WGM, gsz = (nM - fm) < WGM ? (nM - fm) : WGM;
        pm = fm + ((wgid % nig) % gsz); pn = (wgid % nig) / gsz; return true;
    }
};

typedef int i32x4v __attribute__((ext_vector_type(4)));
typedef int i32x8v __attribute__((ext_vector_type(8)));
__device__ __forceinline__ i32x8v cat8(const bf16x8 a, const bf16x8 b) { const i32x4v x = __builtin_bit_cast(i32x4v, a), y = __builtin_bit_cast(i32x4v, b); return (i32x8v){x[0], x[1], x[2], x[3], y[0], y[1], y[2], y[3]}; }
template <class E, class = void> struct epi_perm16 { static constexpr bool value = false; };
template <class E> struct epi_perm16<E, decltype((void)E::PERM16)> { static constexpr bool value = E::PERM16; };
template <class Epi, class Sched, bool GATHER, bool FP8 = false, bool SP2 = true, bool ALIGN_EPI = true>
__device__ __forceinline__ void gemm_phase(LAS unsigned char* lds, const int kbytes, const unsigned ldA, const unsigned ldB, const Sched& S, const Epi& E, const LAS int* idxsrc) {
    const int tid = tid_fresh(), wid = __builtin_amdgcn_readfirstlane(tid >> 6), lane = tid & 63, wr = wid >> 2, wc = wid & 3, fr = lane & 15, fq = lane >> 4;
    int nt = kbytes / (BK * 2); asm volatile("" : "+s"(nt));
    unsigned voffA[2][2], voffBh[2][2];
#pragma unroll
    for (int i = 0; i < 2; ++i) { int R, C; stage_rc(tid * 16 + i * 8192, R, C); const int q = perm32(R & 31); const int Rb = Epi::PERM ? ((R & ~31) + q) : R;
        voffA[0][i] = (unsigned)R * ldA + (unsigned)C * 2u; voffA[1][i] = voffA[0][i];
        if constexpr (epi_perm16<Epi>::value) { const int rb0 = 64 * (R >> 5) + 16 * (q >> 3) + (q & 7); voffBh[0][i] = (unsigned)rb0 * ldB + (unsigned)C * 2u; voffBh[1][i] = (unsigned)(rb0 + 8) * ldB + (unsigned)C * 2u; }
        else { voffBh[0][i] = (unsigned)Rb * ldB + (unsigned)C * 2u; voffBh[1][i] = voffBh[0][i]; } }
    const size_t kstep = (size_t)(BK * 2);
    const unsigned ldsw = (unsigned)wid * 1024u;
    const unsigned lds0 = (unsigned)(__UINTPTR_TYPE__)lds;
    const int aoff = lds_byte(wr * 64 + fr, fq * 8), boff = lds_byte(wc * 32 + fr, fq * 8);
#define PG8_SA(b, h) (((b) * 2 + (h)) * HTB)
#define PG8_SB(b, h) ((4 + (b) * 2 + (h)) * HTB)
#define PG8_STAGE(bufoff, gbase, voff) do { _Pragma("unroll") for (int _i = 0; _i < 2; ++_i) glds16((const char*)(gbase), (voff)[_i], lds0 + (unsigned)(bufoff) + ldsw + _i * 8192u); } while (0)
#define PG8_LDA(dst, b, h) do { _Pragma("unroll") for (int m = 0; m < 4; ++m) _Pragma("unroll") for (int k = 0; k < 2; ++k) dst[m][k] = *(const LAS bf16x8*)(lds + PG8_SA(b, h) + aoff + m * 2048 + k * 1024); } while (0)
#define PG8_LDB(dst, b, h) do { _Pragma("unroll") for (int n = 0; n < 2; ++n) _Pragma("unroll") for (int k = 0; k < 2; ++k) dst[n][k] = *(const LAS bf16x8*)(lds + PG8_SB(b, h) + boff + n * 2048 + k * 1024); } while (0)
#define PG8_MMA(ai, bj, At, Bt) do { __builtin_amdgcn_s_setprio(1); _Pragma("unroll") for (int m = 0; m < 4; ++m) _Pragma("unroll") for (int n = 0; n < 2; ++n) { \
        if constexpr (FP8) { const i32x8v b8_ = cat8(Bt[n][0], Bt[n][1]), a8_ = cat8(At[m][0], At[m][1]); \
            asm volatile("s_nop 1\n\tv_mfma_scale_f32_16x16x128_f8f6f4 %0, %1, %2, %0, %3, %3 op_sel_hi:[0,0,0]" : "+v"(acc[ai][bj][m][n]) : "v"(b8_), "v"(a8_), "v"(fp8_unit_scale)); } \
        else { _Pragma("unroll") for (int k = 0; k < 2; ++k) acc[ai][bj][m][n] = __builtin_amdgcn_mfma_f32_16x16x32_bf16(Bt[n][k], At[m][k], acc[ai][bj][m][n], 0, 0, 0); } } \
        __builtin_amdgcn_s_setprio(0); } while (0)
#define PG8_WAIT_V(n) asm volatile("s_waitcnt vmcnt(" #n ")" ::: "memory")
#define PG8_WAIT_L(n) asm volatile("s_waitcnt lgkmcnt(" #n ")" ::: "memory")
#define PG8_BAR __builtin_amdgcn_s_barrier()
#define PG8_SCHED __builtin_amdgcn_sched_barrier(0)
#define PG8_VA(h) voffA[GATHER ? (h) : 0]
#define PG8_VB(h) voffBh[epi_perm16<Epi>::value ? (h) : 0]
    const int fp8_unit_scale = 0x7f7f7f7f;
    Unit cur, nxt; int ui = 0;
    if (!S.next(0, cur)) return;
    if constexpr (GATHER) {
#pragma unroll
        for (int h = 0; h < 2; ++h)
#pragma unroll
            for (int i = 0; i < 2; ++i) { int R, C; stage_rc(tid * 16 + i * 8192, R, C); voffA[h][i] = (unsigned)idxsrc[h * 128 + R] * ldA + (unsigned)C * 2u; }
    }
    f32x4 acc[2][2][4][2];
#pragma unroll
    for (int a = 0; a < 2; ++a)
#pragma unroll
        for (int b = 0; b < 2; ++b)
#pragma unroll
            for (int m = 0; m < 4; ++m)
#pragma unroll
                for (int n = 0; n < 2; ++n) acc[a][b][m][n] = (f32x4){0.f, 0.f, 0.f, 0.f};
    bf16x8 At[4][2], B0[2][2], B1[2][2];
    const char* cA = cur.A; const char* cB = cur.B; unsigned chA = cur.hsA, chB = cur.hsB;
    if constexpr (SP2) {
        PG8_STAGE(PG8_SB(0, 0), cB, PG8_VB(0)); PG8_STAGE(PG8_SB(0, 1), cB + chB, PG8_VB(1)); PG8_STAGE(PG8_SA(0, 0), cA, PG8_VA(0)); PG8_STAGE(PG8_SA(0, 1), cA + chA, PG8_VA(1));
        if (wr == 1) PG8_BAR;
        PG8_WAIT_V(2); PG8_BAR;
        PG8_STAGE(PG8_SB(1, 0), cB + kstep, PG8_VB(0)); PG8_STAGE(PG8_SA(1, 0), cA + kstep, PG8_VA(0)); PG8_STAGE(PG8_SB(1, 1), cB + chB + kstep, PG8_VB(1));
        PG8_WAIT_V(6); PG8_BAR;
    } else {
    PG8_STAGE(PG8_SB(0, 0), cB, PG8_VB(0)); PG8_STAGE(PG8_SA(0, 0), cA, PG8_VA(0)); PG8_STAGE(PG8_SB(0, 1), cB + chB, PG8_VB(1)); PG8_STAGE(PG8_SA(0, 1), cA + chA, PG8_VA(1));
    if (wr == 1) PG8_BAR;
    PG8_WAIT_V(4); PG8_BAR;
    PG8_STAGE(PG8_SB(1, 0), cB + kstep, PG8_VB(0)); PG8_STAGE(PG8_SA(1, 0), cA + kstep, PG8_VA(0)); PG8_STAGE(PG8_SB(1, 1), cB + chB + kstep, PG8_VB(1));
    PG8_WAIT_V(6); PG8_BAR;
    }
    for (;;) {
        const bool has_next = S.next(ui + 1, nxt);
        const char* nA = has_next ? nxt.A : cA; const char* nB = has_next ? nxt.B : cB; const unsigned nhA = has_next ? nxt.hsA : chA, nhB = has_next ? nxt.hsB : chB;
#pragma unroll 1
        for (int t = 0; t < nt; t += 2) {
            const bool last = (t == nt - 2);
            const char* a1 = cA + (size_t)(t + 1) * kstep;
            const char* a2 = last ? nA : cA + (size_t)(t + 2) * kstep; const char* b2 = last ? nB : cB + (size_t)(t + 2) * kstep;
            const unsigned hA2 = last ? nhA : chA, hB2 = last ? nhB : chB;
            const char* a3 = a2 + kstep; const char* b3 = b2 + kstep;
            const bool sw = GATHER && last && has_next;
            int gi[2][2];
            if constexpr (SP2) {
            PG8_LDB(B0, 0, 0); PG8_LDB(B1, 0, 1); PG8_SCHED; PG8_LDA(At, 0, 0); PG8_STAGE(PG8_SA(1, 1), a1 + chA, PG8_VA(1));
            PG8_WAIT_V(8); PG8_WAIT_L(0); PG8_BAR; PG8_MMA(0, 0, At, B0); PG8_MMA(0, 1, At, B1); PG8_BAR; PG8_SCHED;
            if constexpr (GATHER) { if (sw) {
#pragma unroll
                for (int h = 0; h < 2; ++h)
#pragma unroll
                    for (int i = 0; i < 2; ++i) { int R, C; stage_rc(tid * 16 + i * 8192, R, C); gi[h][i] = idxsrc[(ui + 1) * 256 + h * 128 + R]; } } }
            PG8_LDA(At, 0, 1); PG8_STAGE(PG8_SB(0, 0), b2, PG8_VB(0)); PG8_STAGE(PG8_SB(0, 1), b2 + hB2, PG8_VB(1));
            if constexpr (GATHER) { if (sw) {
#pragma unroll
                for (int h = 0; h < 2; ++h)
#pragma unroll
                    for (int i = 0; i < 2; ++i) { int R, C; stage_rc(tid * 16 + i * 8192, R, C); voffA[h][i] = (unsigned)gi[h][i] * ldA + (unsigned)C * 2u; } } }
            PG8_STAGE(PG8_SA(0, 0), a2, PG8_VA(0));
            PG8_WAIT_V(8); PG8_WAIT_L(0); PG8_BAR; PG8_MMA(1, 0, At, B0); PG8_MMA(1, 1, At, B1); PG8_BAR; PG8_SCHED;
            PG8_LDB(B0, 1, 0); PG8_LDB(B1, 1, 1); PG8_SCHED; PG8_LDA(At, 1, 0); PG8_STAGE(PG8_SA(0, 1), a2 + hA2, PG8_VA(1));
            PG8_WAIT_V(8); PG8_WAIT_L(0); PG8_BAR; PG8_MMA(0, 0, At, B0); PG8_MMA(0, 1, At, B1); PG8_BAR; PG8_SCHED;
            PG8_LDA(At, 1, 1); PG8_STAGE(PG8_SB(1, 0), b3, PG8_VB(0)); PG8_STAGE(PG8_SB(1, 1), b3 + hB2, PG8_VB(1)); PG8_STAGE(PG8_SA(1, 0), a3, PG8_VA(0));
            PG8_WAIT_V(8); PG8_WAIT_L(0); PG8_BAR; PG8_MMA(1, 0, At, B0); PG8_MMA(1, 1, At, B1); PG8_BAR; PG8_SCHED;
            } else {
            PG8_LDB(B0, 0, 0); PG8_SCHED; PG8_LDA(At, 0, 0); PG8_STAGE(PG8_SA(1, 1), a1 + chA, PG8_VA(1));
            PG8_WAIT_L(8); PG8_BAR; PG8_WAIT_L(0); PG8_MMA(0, 0, At, B0); PG8_BAR; PG8_SCHED;
            if constexpr (GATHER) { if (sw) {
#pragma unroll
                for (int h = 0; h < 2; ++h)
#pragma unroll
                    for (int i = 0; i < 2; ++i) { int R, C; stage_rc(tid * 16 + i * 8192, R, C); gi[h][i] = idxsrc[(ui + 1) * 256 + h * 128 + R]; } } }
            PG8_LDB(B1, 0, 1); PG8_STAGE(PG8_SB(0, 0), b2, PG8_VB(0));
            PG8_BAR; PG8_WAIT_L(0); PG8_MMA(0, 1, At, B1); PG8_BAR;
            if constexpr (GATHER) { if (sw) {
#pragma unroll
                for (int h = 0; h < 2; ++h)
#pragma unroll
                    for (int i = 0; i < 2; ++i) { int R, C; stage_rc(tid * 16 + i * 8192, R, C); voffA[h][i] = (unsigned)gi[h][i] * ldA + (unsigned)C * 2u; } } }
            PG8_LDA(At, 0, 1); PG8_STAGE(PG8_SA(0, 0), a2, PG8_VA(0));
            PG8_BAR; PG8_WAIT_L(0); PG8_MMA(1, 0, At, B0); PG8_BAR; PG8_SCHED;
            PG8_STAGE(PG8_SB(0, 1), b2 + hB2, PG8_VB(1));
            PG8_WAIT_V(6); PG8_BAR; PG8_MMA(1, 1, At, B1); PG8_BAR;
            PG8_LDB(B0, 1, 0); PG8_SCHED; PG8_LDA(At, 1, 0); PG8_STAGE(PG8_SA(0, 1), a2 + hA2, PG8_VA(1));
            PG8_WAIT_L(8); PG8_BAR; PG8_WAIT_L(0); PG8_MMA(0, 0, At, B0); PG8_BAR; PG8_SCHED;
            PG8_LDB(B1, 1, 1); PG8_STAGE(PG8_SB(1, 0), b3, PG8_VB(0));
            PG8_BAR; PG8_WAIT_L(0); PG8_MMA(0, 1, At, B1); PG8_BAR;
            PG8_LDA(At, 1, 1); PG8_STAGE(PG8_SA(1, 0), a3, PG8_VA(0));
            PG8_BAR; PG8_WAIT_L(0); PG8_MMA(1, 0, At, B0); PG8_BAR; PG8_SCHED;
            PG8_STAGE(PG8_SB(1, 1), b3 + hB2, PG8_VB(1));
            PG8_WAIT_V(6); PG8_BAR; PG8_MMA(1, 1, At, B1); PG8_BAR;
            }
        }
        if constexpr (ALIGN_EPI) { if (wr == 0) PG8_BAR; }
        if constexpr (FP8) asm volatile("s_nop 15\n\ts_nop 15" ::: "memory");
        E(acc, cur, ui, wr, wc, fr, fq);
        if (!has_next) break;
#pragma unroll
        for (int a = 0; a < 2; ++a)
#pragma unroll
            for (int b = 0; b < 2; ++b)
#pragma unroll
                for (int m = 0; m < 4; ++m)
#pragma unroll
                    for (int n = 0; n < 2; ++n) acc[a][b][m][n] = (f32x4){0.f, 0.f, 0.f, 0.f};
        cur = nxt; cA = nA; cB = nB; chA = nhA; chB = nhB; ++ui;
        if constexpr (ALIGN_EPI) { if (wr == 1) PG8_BAR; }
    }
    PG8_WAIT_V(0);
    if constexpr (!ALIGN_EPI) { if (wr == 0) PG8_BAR; }
    PG8_BAR;
#undef PG8_SA
#undef PG8_SB
#undef PG8_STAGE
#undef PG8_LDA
#undef PG8_LDB
#undef PG8_MMA
#undef PG8_WAIT_V
#undef PG8_WAIT_L
#undef PG8_BAR
#undef PG8_SCHED
#undef PG8_VA
#undef PG8_VB
}
}
using gm::Unit;

struct Params { const float* in[13]; float* out; unsigned char* ws; int ph_lo, ph_hi; };

struct SchedPlain {
    gm::GridOrder o; const char* A; const char* B; unsigned ldA, ldB; bool p16 = false;
    __device__ __forceinline__ bool next(int i, Unit& u) const { int pm, pn; if (!o.mn(i, pm, pn)) return false;
        u.pm = pm; u.pn = pn; u.x0 = 0; u.x1 = 0; u.A = A + (size_t)pm * 256 * ldA; u.hsA = 128u * ldA; u.B = B + (size_t)pn * 256 * ldB; u.hsB = p16 ? 0u : 128u * ldB; return true; }
};
struct SchedG1 {
    gm::GridOrder o; const char* WinT; const char* xb;
    __device__ __forceinline__ bool next(int i, Unit& u) const { int pm, pn; if (!o.mn(i, pm, pn)) return false;
        const int b = pn >> 5, j = pn & 31; u.pm = pm; u.pn = pn; u.x0 = b; u.x1 = j;
        u.A = WinT + (size_t)pm * 256 * 1024; u.hsA = 128u * 1024u; u.B = xb + ((size_t)(b * SEQ + 2 * j)) * 1024; u.hsB = 1024u; return true; }
};
struct SchedS1 {
    int G, c; const char* F1; const char* Ut;
    __device__ __forceinline__ bool next(int i, Unit& u) const { const int L = i * G + c; if (L >= 1024) return false;
        u.pm = 0; u.pn = L; u.x0 = 0; u.x1 = 0; u.A = F1; u.hsA = 128u * 256u; u.B = Ut + (size_t)L * 256 * 256; u.hsB = 128u * 256u; return true; }
};
struct SchedS2 {
    gm::GridOrder o; const char* F2; const char* A1;
    __device__ __forceinline__ bool next(int i, Unit& u) const { int pm, pn; if (!o.mn(i, pm, pn)) return false;
        const int g = pm, b = pn >> 2, ct = pn & 3; u.pm = g; u.pn = ct; u.x0 = b; u.x1 = g;
        u.A = F2 + (size_t)g * 256 * 256; u.hsA = 128u * 256u; u.B = A1 + ((size_t)((b * 64 + g) * 1024 + ct * 256)) * 256; u.hsB = 0u; return true; }
};
__device__ __forceinline__ int expert_of_tile(const LAS int* ts, int pm) {
    const int ln = (int)__builtin_amdgcn_mbcnt_hi(~0u, __builtin_amdgcn_mbcnt_lo(~0u, 0u));
    const int v = ts[ln & 31];
    return (int)__builtin_popcountll(__ballot((ln >= 1) && (ln < 32) && (v <= pm)));
}
struct SchedMoe {
    gm::GridOrder o; const LAS int* ts; const char* A; const char* W; size_t wstride; unsigned ldB; bool hsB128; unsigned tileA;
    __device__ __forceinline__ bool next(int i, Unit& u) const { int pm, pn; if (!o.mn(i, pm, pn)) return false;
        const int e = expert_of_tile(ts, pm);
        u.pm = pm; u.pn = pn; u.x0 = e; u.x1 = pm - ts[e]; u.A = A + (size_t)pm * tileA; u.hsA = tileA >> 1; u.B = W + (size_t)e * wstride + (size_t)pn * 256 * ldB; u.hsB = hsB128 ? 128u * ldB : 0u; return true; }
};

typedef f32x4 Acc[2][2][4][2];
struct EpiRow {
    static constexpr bool PERM = true;
    bf16_t* O; size_t ld; int split_tiles; size_t split_stride; float scale0, scale1;
    __device__ __forceinline__ void operator()(const Acc& acc, const Unit& u, int, int wr, int wc, int fr, int fq) const {
        int pn = u.pn; bf16_t* base = O; float sc = scale0;
        if (split_tiles) { const int t = pn / split_tiles; base += (size_t)t * split_stride; pn -= t * split_tiles; if (t != 0) sc = scale1; }
        const size_t row0 = (size_t)u.pm * 256 + wr * 64 + fr; const int col0 = pn * 256 + wc * 32 + 8 * fq;
#pragma unroll
        for (int ai = 0; ai < 2; ++ai)
#pragma unroll
            for (int m = 0; m < 4; ++m) { bf16_t* rowp = base + (row0 + ai * 128 + m * 16) * ld + col0;
#pragma unroll
                for (int bj = 0; bj < 2; ++bj) *(u32x4*)(rowp + bj * 128) = pack8(acc[ai][bj][m][0] * sc, acc[ai][bj][m][1] * sc); }
    }
};
struct EpiRow8 {
    static constexpr bool PERM = true, PERM16 = true;
    unsigned char* O; size_t ld; int split_tiles; size_t split_stride; float scale0, scale1;
    __device__ __forceinline__ void operator()(const Acc& acc, const Unit& u, int, int wr, int wc, int fr, int fq) const {
        int pn = u.pn; unsigned char* base = O; float sc = scale0;
        if (split_tiles) { const int t = pn / split_tiles; base += (size_t)t * split_stride; pn -= t * split_tiles; if (t != 0) sc = scale1; }
        const size_t row0 = (size_t)u.pm * 256 + wr * 64 + fr; const int col0 = pn * 256 + wc * 64 + 16 * fq;
#pragma unroll
        for (int ai = 0; ai < 2; ++ai)
#pragma unroll
            for (int m = 0; m < 4; ++m) { u32x4 w;
                { const f32x4 v = acc[ai][0][m][0] * sc; w.x = pk4_fp8(v[0], v[1], v[2], v[3]); } { const f32x4 v = acc[ai][0][m][1] * sc; w.y = pk4_fp8(v[0], v[1], v[2], v[3]); }
                { const f32x4 v = acc[ai][1][m][0] * sc; w.z = pk4_fp8(v[0], v[1], v[2], v[3]); } { const f32x4 v = acc[ai][1][m][1] * sc; w.w = pk4_fp8(v[0], v[1], v[2], v[3]); }
                *(u32x4*)(base + (row0 + ai * 128 + m * 16) * ld + col0) = w; }
    }
};
struct EpiG1 {
    static constexpr bool PERM = true;
    bf16_t* Ut; float sc;
    __device__ __forceinline__ void operator()(const Acc& acc, const Unit& u, int, int wr, int wc, int fr, int fq) const {
#pragma unroll
        for (int ai = 0; ai < 2; ++ai)
#pragma unroll
            for (int m = 0; m < 4; ++m) { const int c = u.pm * 256 + ai * 128 + wr * 64 + m * 16 + fr;
#pragma unroll
                for (int bj = 0; bj < 2; ++bj) { const int s2 = 2 * u.x1 + bj;
                    *(u32x4*)(Ut + (((size_t)(u.x0 * 1024 + c) * 64 + s2) * 128 + wc * 32 + 8 * fq)) = pack8(acc[ai][bj][m][0] * sc, acc[ai][bj][m][1] * sc); } }
    }
};
struct EpiS1 {
    static constexpr bool PERM = true;
    bf16_t* A1;
    __device__ __forceinline__ void operator()(const Acc& acc, const Unit& u, int, int wr, int wc, int fr, int fq) const {
#pragma unroll
        for (int m = 0; m < 4; ++m) { const int m1 = wr * 64 + m * 16 + fr, g = m1 >> 1, ri = m1 & 1;
#pragma unroll
            for (int bj = 0; bj < 2; ++bj) { const int nrow = u.pn * 256 + bj * 128 + wc * 32 + 8 * fq, s2 = nrow & 63, c = (nrow >> 6) & 1023, b = nrow >> 16;
                *(u32x4*)(A1 + ((size_t)((b * 64 + g) * 1024 + c) * 128 + ri * 64 + s2)) = pack8(acc[0][bj][m][0], acc[0][bj][m][1]); } }
    }
};
struct EpiS2 {
    static constexpr bool PERM = true, PERM16 = true;
    unsigned char* Y;
    __device__ __forceinline__ void operator()(const Acc& acc, const Unit& u, int, int wr, int wc, int fr, int fq) const {
        const int g = u.x1, b = u.x0;
#pragma unroll
        for (int ai = 0; ai < 2; ++ai)
#pragma unroll
            for (int m = 0; m < 4; ++m) { const int mm = wr * 64 + m * 16 + fr, k2 = mm >> 1, rip = mm & 1;
                const int k1 = ai ? (g ? 128 - g : 64) : g, k = k1 + 128 * k2;
                { const int c = u.pn * 256 + wc * 64 + 16 * fq; u32x4 w;
                    { const f32x4 v = acc[ai][0][m][0] * Y_SCALE; w.x = pk4_fp8(v[0], v[1], v[2], v[3]); } { const f32x4 v = acc[ai][0][m][1] * Y_SCALE; w.y = pk4_fp8(v[0], v[1], v[2], v[3]); }
                    { const f32x4 v = acc[ai][1][m][0] * Y_SCALE; w.z = pk4_fp8(v[0], v[1], v[2], v[3]); } { const f32x4 v = acc[ai][1][m][1] * Y_SCALE; w.w = pk4_fp8(v[0], v[1], v[2], v[3]); }
                    *(u32x4*)(Y + ((size_t)(b * SEQ + k) * 2048 + rip * 1024 + c)) = w; } }
    }
};
struct EpiGU {
    static constexpr bool PERM = true;
    unsigned char* Hb; const LAS int* idxdst;
    __device__ __forceinline__ void operator()(const Acc& acc, const Unit& u, int ui, int wr, int wc, int fr, int fq) const {
#pragma unroll
        for (int ai = 0; ai < 2; ++ai)
#pragma unroll
            for (int m = 0; m < 4; ++m) { const int a = idxdst[ui * 256 + ai * 128 + wr * 64 + m * 16 + fr];
                if (a >= 0) { f32x4 h0, h1;
#pragma unroll
                    for (int j = 0; j < 4; ++j) { h0[j] = silu_mul(acc[ai][0][m][0][j] * (1.0f / W_SCALE), acc[ai][1][m][0][j] * (H_SCALE / W_SCALE)); h1[j] = silu_mul(acc[ai][0][m][1][j] * (1.0f / W_SCALE), acc[ai][1][m][1][j] * (H_SCALE / W_SCALE)); }
                    u32x2 w; w.x = pk4_fp8(h0[0], h0[1], h0[2], h0[3]); w.y = pk4_fp8(h1[0], h1[1], h1[2], h1[3]);
                    *(u32x2*)(Hb + ((size_t)(u.pm * 256 + ai * 128 + wr * 64 + m * 16 + fr) * DEX + u.pn * 128 + wc * 32 + 8 * fq)) = w; } }
    }
};
struct EpiDown {
    static constexpr bool PERM = true, PERM16 = true;
    unsigned char* ys; const LAS int* idxdst;
    __device__ __forceinline__ void operator()(const Acc& acc, const Unit& u, int ui, int wr, int wc, int fr, int fq) const {
#pragma unroll
        for (int ai = 0; ai < 2; ++ai)
#pragma unroll
            for (int m = 0; m < 4; ++m) { const int a = idxdst[ui * 256 + ai * 128 + wr * 64 + m * 16 + fr];
                if (a >= 0) { constexpr float sc = YS_SCALE / (W_SCALE * H_SCALE); u32x4 w;
                    { const f32x4 v = acc[ai][0][m][0] * sc; w.x = pk4_fp8(v[0], v[1], v[2], v[3]); } { const f32x4 v = acc[ai][0][m][1] * sc; w.y = pk4_fp8(v[0], v[1], v[2], v[3]); }
                    { const f32x4 v = acc[ai][1][m][0] * sc; w.z = pk4_fp8(v[0], v[1], v[2], v[3]); } { const f32x4 v = acc[ai][1][m][1] * sc; w.w = pk4_fp8(v[0], v[1], v[2], v[3]); }
                    *(u32x4*)(ys + ((size_t)a * DM + u.pn * 256 + wc * 64 + 16 * fq)) = w; } }
    }
};

struct TileDesc { const float* src; unsigned char* dst; int C, r0, c0, dld, kind; };
__device__ __forceinline__ TileDesc tile_desc(const Params& p, int tt) {
    TileDesc d; d.kind = 3; unsigned char* ws = p.ws;
    if (tt < 256) { d.src = p.in[1]; d.C = 1024; d.r0 = (tt >> 5) * 128; d.c0 = (tt & 31) * 32; d.dst = ws + WS_WIN; d.dld = 1024; }
    else if (tt < 1024) { const int t2 = tt - 256; d.src = p.in[3]; d.C = 3072; d.r0 = (t2 / 96) * 128; d.c0 = (t2 % 96) * 32; d.dst = ws + WS_WQKV; d.dld = 1024; }
    else if (tt < 1280) { const int t2 = tt - 1024; d.src = p.in[5]; d.C = 1024; d.r0 = (t2 >> 5) * 128; d.c0 = (t2 & 31) * 32; d.dst = ws + WS_WO; d.dld = 1024; }
    else { const int t3 = tt - 1280, ee = t3 >> 7, tl = t3 & 127, mat = ee & 63; d.kind = ee >> 6;
        if (d.kind < 2) { d.src = (d.kind == 0 ? p.in[8] : p.in[9]) + (size_t)mat * 1024 * 512; d.C = 512; d.r0 = (tl >> 4) * 128; d.c0 = (tl & 15) * 32; d.dst = ws + WS_WGU + (size_t)mat * 1024 * 1024; d.dld = 1024; }
        else { d.src = p.in[10] + (size_t)mat * 512 * 1024; d.C = 1024; d.r0 = (tl >> 5) * 128; d.c0 = (tl & 31) * 32; d.dst = ws + WS_WD + (size_t)mat * 1024 * 512; d.dld = 512; } }
    return d;
}
__device__ __forceinline__ void tile_load(const TileDesc& d, f32x4 (&v)[16], int lane) {
#pragma unroll
    for (int ps = 0; ps < 16; ++ps) v[ps] = __builtin_nontemporal_load((const f32x4*)(d.src + (size_t)(d.r0 + ps * 8 + (lane >> 3)) * d.C + d.c0 + (lane & 7) * 4));
}
__device__ __forceinline__ void tile_store(const TileDesc& d, const f32x4 (&v)[16], LAS float* tile, int lane) {
#pragma unroll
    for (int ps = 0; ps < 16; ++ps) { const int row = ps * 8 + (lane >> 3), col4 = (lane & 7) * 4;
        tile[row * 33 + col4 + 0] = v[ps][0]; tile[row * 33 + col4 + 1] = v[ps][1]; tile[row * 33 + col4 + 2] = v[ps][2]; tile[row * 33 + col4 + 3] = v[ps][3]; }
    __builtin_amdgcn_fence(__ATOMIC_RELEASE, "wavefront"); __builtin_amdgcn_wave_barrier(); __builtin_amdgcn_fence(__ATOMIC_ACQUIRE, "wavefront");
#pragma unroll
    for (int ps = 0; ps < 4; ++ps) { const int n = ps * 8 + (lane >> 3), kc = (lane & 7) * 16; float a[16];
#pragma unroll
        for (int j = 0; j < 16; ++j) a[j] = tile[(kc + j) * 33 + n] * W_SCALE;
        const int nn = d.c0 + n; const int drow = (d.kind == 0 || d.kind == 1) ? (256 * (nn >> 7) + (nn & 127) + 128 * d.kind) : nn;
        u32x4 w; w.x = pk4_fp8(a[0], a[1], a[2], a[3]); w.y = pk4_fp8(a[4], a[5], a[6], a[7]); w.z = pk4_fp8(a[8], a[9], a[10], a[11]); w.w = pk4_fp8(a[12], a[13], a[14], a[15]);
        *(u32x4*)(d.dst + (size_t)drow * d.dld + d.r0 + kc) = w; }
    __builtin_amdgcn_fence(__ATOMIC_RELEASE, "wavefront"); __builtin_amdgcn_wave_barrier(); __builtin_amdgcn_fence(__ATOMIC_ACQUIRE, "wavefront");
}

__device__ __forceinline__ void transpose_share(const Params& p, LAS unsigned char* lds, int wid, int lane, int nslot, int slot0) {
    LAS float* tile = (LAS float*)lds + wid * (128 * 33); constexpr int NT = 1280 + 192 * 128; const int G = gridDim.x;
    for (int rnd = 0; (rnd * G) * 22 < NT; ++rnd) { const int base = (rnd * G + (int)blockIdx.x) * 22 + slot0;
        const int t0 = base, t1 = base + 1, t2 = base + 2;
        if (t0 < NT) { const bool two = t1 < NT; const TileDesc d0 = tile_desc(p, t0), d1 = tile_desc(p, two ? t1 : t0);
            f32x4 v0[16], v1[16]; tile_load(d0, v0, lane); tile_load(d1, v1, lane);
            tile_store(d0, v0, tile, lane); if (two) tile_store(d1, v1, tile, lane); }
        if (nslot > 2 && t2 < NT) { const TileDesc d2 = tile_desc(p, t2); f32x4 v2[16]; tile_load(d2, v2, lane); tile_store(d2, v2, tile, lane); } }
}
__device__ __forceinline__ void phase_prologue(const Params& p, LAS unsigned char* lds) {
    const int tid = tid_fresh(), lane = tid & 63, wid = __builtin_amdgcn_readfirstlane(tid >> 6); unsigned char* ws = p.ws;
    if (wid < 6) {
        { const float* x = p.in[0]; unsigned char* xb = (unsigned char*)(ws + WS_S0); bf16_t* xh = (bf16_t*)p.out; const size_t stride = (size_t)gridDim.x * 384 * 8, total = (size_t)T * DM;
          for (size_t i = ((size_t)blockIdx.x * 384 + tid) * 8; i < total; i += 4 * stride) {
              f32x4 a[4], b[4];
#pragma unroll
              for (int u = 0; u < 4; ++u) { const size_t o = i + u * stride < total ? i + u * stride : i; a[u] = __builtin_nontemporal_load((const f32x4*)(x + o)); b[u] = __builtin_nontemporal_load((const f32x4*)(x + o + 4)); }
#pragma unroll
              for (int u = 0; u < 4; ++u) if (i + u * stride < total) { u32x2 w; w.x = pk4_fp8(a[u][0], a[u][1], a[u][2], a[u][3]); w.y = pk4_fp8(b[u][0], b[u][1], b[u][2], b[u][3]); *(u32x2*)(xb + i + u * stride) = w;
                  *(u32x4*)(xh + i + u * stride) = pack8(a[u], b[u]); } } }
        transpose_share(p, lds, wid, lane, 3, 3 * wid);
    } else {
        const int gw = blockIdx.x * 2 + (wid - 6), gl = gw * 64 + lane;
        { bf16_t* F1 = (bf16_t*)(ws + WS_F1); bf16_t* F2 = (bf16_t*)(ws + WS_F2);
          { const int idx = gl; const int m1 = idx >> 7, s1 = idx & 127; float v = 0.f;
            if (m1 < 128) { const int g = m1 >> 1, ri = m1 & 1;
                if (g == 0) v = ri ? ((s1 & 1) ? -1.f : 1.f) : 1.f;
                else { const float ph = (float)((s1 * g) & 127) * (1.0f / 128.0f); v = ri ? -__builtin_amdgcn_sinf(ph) : __builtin_amdgcn_cosf(ph); } }
            F1[idx] = (bf16_t)(cvt_pk_bf16(v, 0.f) & 0xffffu); }
          const float sc = 0.011048543456039806f;
          for (int idx = gl; idx < 64 * 256 * 128; idx += 32768) { const int g = idx >> 15, m2 = (idx >> 7) & 255, kk = idx & 127;
              const int hsel = m2 >> 7, k2 = (m2 & 127) >> 1, rip = m2 & 1, slot = kk >> 6, s2 = kk & 63;
              const int k1 = hsel ? (g ? 128 - g : 64) : g, k = k1 + 128 * k2;
              const float ph = (float)((s2 * k) & 8191) * (1.0f / 8192.0f); const float cs = __builtin_amdgcn_cosf(ph), sn = __builtin_amdgcn_sinf(ph);
              float v;
              if (g == 0) { v = (slot == hsel) ? (rip ? -sn : cs) : 0.f; }
              else if (hsel == 0) { v = rip ? (slot ? cs : -sn) : (slot ? sn : cs); }
              else { v = rip ? (slot ? -cs : -sn) : (slot ? -sn : cs); }
              F2[idx] = (bf16_t)(cvt_pk_bf16(v * sc, 0.f) & 0xffffu); } }
        { LAS float* ctab = (LAS float*)(lds + 135168) + (wid - 6) * 512; LAS float* stab = ctab + 256; const float* wout = p.in[2]; unsigned char* W2 = (unsigned char*)(ws + WS_W2);
#pragma unroll
          for (int u = 0; u < 4; ++u) { const float ph = (float)(lane + 64 * u) * (1.0f / 256.0f); ctab[lane + 64 * u] = __builtin_amdgcn_cosf(ph); stab[lane + 64 * u] = __builtin_amdgcn_sinf(ph); }
          __builtin_amdgcn_fence(__ATOMIC_RELEASE, "wavefront"); __builtin_amdgcn_wave_barrier(); __builtin_amdgcn_fence(__ATOMIC_ACQUIRE, "wavefront");
          { LAS float* wt = (LAS float*)lds + wid * (128 * 33); f32x4 wv[16];
            { const int gp = gw >> 8, n0 = (gw & 63) * 16; const float* wsrc = wout + (size_t)(gp * 256 + (lane >> 2)) * 1024 + n0 + (lane & 3) * 4;
#pragma unroll
              for (int it = 0; it < 16; ++it) wv[it] = *(const f32x4*)(wsrc + (size_t)it * 16 * 1024); }
#pragma unroll 1
            for (int item = gw; item < 4 * 4 * 64; item += 512) { const int gp = item >> 8, cq = (item >> 6) & 3, n0 = (item & 63) * 16, c = cq * 64 + lane;
#pragma unroll
              for (int it = 0; it < 16; ++it) *(LAS f32x4*)(wt + (it * 16 + (lane >> 2)) * 16 + (lane & 3) * 4) = wv[it];
              __builtin_amdgcn_fence(__ATOMIC_RELEASE, "wavefront"); __builtin_amdgcn_wave_barrier(); __builtin_amdgcn_fence(__ATOMIC_ACQUIRE, "wavefront");
              if (item + 512 < 4 * 4 * 64) { const int gp2 = (item + 512) >> 8; const float* wsrc = wout + (size_t)(gp2 * 256 + (lane >> 2)) * 1024 + n0 + (lane & 3) * 4;
#pragma unroll
                  for (int it = 0; it < 16; ++it) wv[it] = *(const f32x4*)(wsrc + (size_t)it * 16 * 1024); }
              float ac[16], as[16];
#pragma unroll
              for (int j = 0; j < 16; ++j) { ac[j] = 0.f; as[j] = 0.f; }
#pragma unroll 4
              for (int k2 = 0; k2 < 256; ++k2) { const int ix = (c * k2) & 255; const float cv = ctab[ix], sv = stab[ix];
#pragma unroll
                  for (int q = 0; q < 4; ++q) { const f32x4 w4 = *(const LAS f32x4*)(wt + k2 * 16 + q * 4);
#pragma unroll
                      for (int j = 0; j < 4; ++j) { ac[q * 4 + j] += cv * w4[j]; as[q * 4 + j] += sv * w4[j]; } } }
#pragma unroll
              for (int j = 0; j < 16; ++j) { unsigned char* o = W2 + (size_t)(n0 + j) * 2048 + gp * 256 + c;
                  o[0] = (unsigned char)(pk4_fp8(ac[j] * (0.0625f * W2_SCALE), 0.f, 0.f, 0.f) & 0xffu); o[1024] = (unsigned char)(pk4_fp8(as[j] * (0.0625f * W2_SCALE), 0.f, 0.f, 0.f) & 0xffu); }
              __builtin_amdgcn_fence(__ATOMIC_RELEASE, "wavefront"); __builtin_amdgcn_wave_barrier(); __builtin_amdgcn_fence(__ATOMIC_ACQUIRE, "wavefront"); } } }
        transpose_share(p, lds, wid, lane, 2, 18 + 2 * (wid - 6));
    }
    __syncthreads();
}

typedef _Float16 f16x8 __attribute__((ext_vector_type(8)));
typedef _Float16 f16x4 __attribute__((ext_vector_type(4)));
constexpr int LA_HT = 0, LA_RED = 65536, LA_SEL = 65536 + 32768, LA_ASG = LA_SEL + 8192, LA_MISC = LA_ASG + 1024;
__device__ __forceinline__ void phase_lnA(const Params& p, LAS unsigned char* lds, const int L, const bf16_t* res16, const bf16_t* ybuf, bf16_t* hb, unsigned char* h8) {
    const int tid = tid_fresh(), lane = tid & 63, wid = __builtin_amdgcn_readfirstlane(tid >> 6), fr = lane & 15, fq = lane >> 4;
    unsigned char* ws = p.ws;
    LAS unsigned char* ht = lds + LA_HT;
    LAS float* red = (LAS float*)(lds + LA_RED);
    LAS float* selL = (LAS float*)(lds + LA_SEL);
    LAS int* asgE = (LAS int*)(lds + LA_ASG);
    LAS int* misc = (LAS int*)(lds + LA_MISC);
    f16x8 wf[2][4];
    { const float* wrg = p.in[6];
#pragma unroll
      for (int eb = 0; eb < 2; ++eb)
#pragma unroll
          for (int sx = 0; sx < 4; ++sx)
#pragma unroll
              for (int j = 0; j < 8; ++j) wf[eb][sx][j] = (_Float16)wrg[(size_t)(128 * wid + 32 * sx + 8 * fq + j) * 32 + fr + 16 * eb]; }
    const float* lg = p.in[11] + (L * 2 + 0) * 1024; const float* lb = p.in[12] + (L * 2 + 0) * 1024;
    f32x4 gv[4], bv[4];
#pragma unroll
    for (int k = 0; k < 4; ++k) { gv[k] = *(const f32x4*)(lg + 512 * (k >> 1) + 8 * lane + 4 * (k & 1)); bv[k] = *(const f32x4*)(lb + 512 * (k >> 1) + 8 * lane + 4 * (k & 1)); }
    const float br = p.in[7][tid & 31];
    float* gates = (float*)(ws + WS_GATE);
    const int tok0 = blockIdx.x * 128;
#ifndef LNA_REP
#define LNA_REP 1
#endif
    u32x4 rx16[4][2], ryw[4][2];
#define LA_LOAD(gg) do { _Pragma("unroll") for (int tk = 0; tk < 4; ++tk) { const size_t rowo_ = (size_t)(tok0 + (gg) * 32 + 4 * wid + tk) * DM; _Pragma("unroll") for (int jj = 0; jj < 2; ++jj) { const size_t co_ = rowo_ + 512 * jj + 8 * lane; \
        rx16[tk][jj] = *(const u32x4*)(res16 + co_); ryw[tk][jj] = *(const u32x4*)(ybuf + co_); } } } while (0)
    LA_LOAD(0);
#pragma unroll 1
    for (int g_ = 0; g_ < 4 * LNA_REP; ++g_) { const int g = g_ & 3;
        f32x4 hv[4][4];
#pragma unroll
        for (int tk = 0; tk < 4; ++tk) {
#pragma unroll
            for (int jj = 0; jj < 2; ++jj) { f32x4 xa, xb2, ya, yb; bf8_to_f32(rx16[tk][jj], xa, xb2); bf8_to_f32(ryw[tk][jj], ya, yb);
                hv[tk][2 * jj] = ALPHA * xa + ya; hv[tk][2 * jj + 1] = ALPHA * xb2 + yb; } }
        float sm[4], qv[4];
#pragma unroll
        for (int tk = 0; tk < 4; ++tk) { float s = 0.f;
#pragma unroll
            for (int j = 0; j < 4; ++j) s += (hv[tk][j][0] + hv[tk][j][1]) + (hv[tk][j][2] + hv[tk][j][3]);
            sm[tk] = s; }
#pragma unroll
        for (int o = 32; o >= 1; o >>= 1) {
#pragma unroll
            for (int tk = 0; tk < 4; ++tk) sm[tk] += __shfl_xor(sm[tk], o); }
#pragma unroll
        for (int tk = 0; tk < 4; ++tk) { sm[tk] *= (1.0f / 1024.0f); float q = 0.f;
#pragma unroll
            for (int j = 0; j < 4; ++j) { const f32x4 d = hv[tk][j] - sm[tk]; q += (d[0] * d[0] + d[1] * d[1]) + (d[2] * d[2] + d[3] * d[3]); }
            qv[tk] = q; }
#pragma unroll
        for (int o = 32; o >= 1; o >>= 1) {
#pragma unroll
            for (int tk = 0; tk < 4; ++tk) qv[tk] += __shfl_xor(qv[tk], o); }
#pragma unroll
        for (int tk = 0; tk < 4; ++tk) { const int ts = 4 * wid + tk; const size_t rowo = (size_t)(tok0 + g * 32 + ts) * DM; const float rstd = 1.0f / sqrtf(qv[tk] * (1.0f / 1024.0f) + LN_EPS);
#pragma unroll
            for (int jj = 0; jj < 2; ++jj) { const size_t co = rowo + 512 * jj + 8 * lane;
                const f32x4 h0 = (hv[tk][2 * jj] - sm[tk]) * rstd * gv[2 * jj] + bv[2 * jj], h1 = (hv[tk][2 * jj + 1] - sm[tk]) * rstd * gv[2 * jj + 1] + bv[2 * jj + 1];
                *(u32x4*)(hb + co) = pack8(h0, h1);
                u32x2 w8; w8.x = pk4_fp8(h0[0], h0[1], h0[2], h0[3]); w8.y = pk4_fp8(h1[0], h1[1], h1[2], h1[3]); *(u32x2*)(h8 + co) = w8;
                const f16x8 hh = (f16x8){(_Float16)h0[0], (_Float16)h0[1], (_Float16)h0[2], (_Float16)h0[3], (_Float16)h1[0], (_Float16)h1[1], (_Float16)h1[2], (_Float16)h1[3]};
                const int chunk = (64 * jj + lane) ^ (ts & 15);
                *(LAS f16x8*)(ht + ts * 2048 + chunk * 16) = hh; } }
        if (g_ + 1 < 4 * LNA_REP) LA_LOAD((g_ + 1) & 3);
        __syncthreads();
#pragma unroll
        for (int tb = 0; tb < 2; ++tb) { f32x4 d0 = (f32x4){0.f, 0.f, 0.f, 0.f}, d1 = d0;
#pragma unroll
          for (int sx = 0; sx < 4; ++sx) { const int chunk = (16 * wid + 4 * sx + fq) ^ fr; const f16x8 hf = *(const LAS f16x8*)(ht + (16 * tb + fr) * 2048 + chunk * 16);
              d0 = __builtin_amdgcn_mfma_f32_16x16x32_f16(wf[0][sx], hf, d0, 0, 0, 0); d1 = __builtin_amdgcn_mfma_f32_16x16x32_f16(wf[1][sx], hf, d1, 0, 0, 0); }
          *(LAS f32x4*)(red + wid * 1024 + (16 * tb + fr) * 32 + 4 * fq) = d0; *(LAS f32x4*)(red + wid * 1024 + (16 * tb + fr) * 32 + 16 + 4 * fq) = d1; }
        __syncthreads();
#pragma unroll
        for (int u = 0; u < 2; ++u) { const int ix = tid + 512 * u; float lgt = 0.f;
#pragma unroll
          for (int w = 0; w < 8; ++w) lgt += red[w * 1024 + ix];
          const float sc = 1.0f / (1.0f + __expf(-lgt)); selL[ix] = sc + br; selL[1024 + ix] = sc; }
        __syncthreads();
        if (lane < 4) { const int tq = 4 * wid + lane; const LAS f32x4* sel4 = (const LAS f32x4*)(selL + tq * 32); float best = -3.0e38f; int bg = 0, b1 = 0, b2 = 0;
            f32x4 sv[8];
#pragma unroll
            for (int q = 0; q < 8; ++q) sv[q] = sel4[q];
#pragma unroll
            for (int gg = 0; gg < 4; ++gg) { float m1 = -3.0e38f, m2 = -3.0e38f; int i1 = 0, i2 = 0;
#pragma unroll
                for (int j = 0; j < 8; ++j) { const float v = sv[gg * 2 + (j >> 2)][j & 3]; const bool gt1 = v > m1, gt2 = v > m2;
                    m2 = gt1 ? m1 : (gt2 ? v : m2); i2 = gt1 ? i1 : (gt2 ? j : i2); m1 = gt1 ? v : m1; i1 = gt1 ? j : i1; }
                const float gs = m1 + m2; if (gs > best) { best = gs; bg = gg; b1 = i1; b2 = i2; } }
            const int e1 = bg * 8 + b1, e2 = bg * 8 + b2; const float s1 = selL[1024 + tq * 32 + e1], s2 = selL[1024 + tq * 32 + e2], inv = 1.0f / (s1 + s2);
            const int tl = g * 32 + tq; asgE[2 * tl] = e1; asgE[2 * tl + 1] = e2;
            const int t = tok0 + tl; gates[2 * t] = s1 * inv; gates[2 * t + 1] = s2 * inv; }
    }
    __syncthreads();
#undef LA_LOAD
    int my_e = 0, my_rank = 0; LAS int* cntW = misc + 32;
    if (tid < 256) { my_e = asgE[tid]; unsigned long long mym = 0ull; int cw = 0;
#pragma unroll
        for (int e = 0; e < 32; ++e) { const unsigned long long m = __ballot(my_e == e); if (my_e == e) mym = m; if (lane == e) cw = (int)__builtin_popcountll(m); }
        my_rank = (int)__builtin_popcountll(mym & ((1ull << lane) - 1ull));
        if (lane < 32) cntW[wid * 32 + lane] = cw; }
    __syncthreads();
    if (tid < 256) { for (int w = 0; w < 3; ++w) if (w < wid) my_rank += cntW[w * 32 + my_e]; }
    if (tid < 32) { const int c = cntW[tid] + cntW[32 + tid] + cntW[64 + tid] + cntW[96 + tid];
        unsigned* cnt = (unsigned*)(ws + WS_CTL) + CNT_WORD0 + (L * 32 + tid) * 64;
        misc[tid] = (int)__hip_atomic_fetch_add(cnt, (unsigned)c, __ATOMIC_RELAXED, __HIP_MEMORY_SCOPE_AGENT); }
    __syncthreads();
    if (tid < 256) { int* list = (int*)(ws + WS_LIST); list[(size_t)my_e * NASG + misc[my_e] + my_rank] = blockIdx.x * 256 + tid; }
    __syncthreads();
}

__device__ __forceinline__ void phase_lnB(const Params& p, const int L, const bf16_t* hb, const unsigned char* ys, bf16_t* xb_out, unsigned char* x8_out, float* f_out) {
    const int tid = tid_fresh(), lane = tid & 63, wid = tid >> 6;
    const float* lg = p.in[11] + (L * 2 + 1) * 1024; const float* lb = p.in[12] + (L * 2 + 1) * 1024;
    const float* gates = (const float*)(p.ws + WS_GATE);
    f32x4 gv[4], bv[4];
#pragma unroll
    for (int k = 0; k < 4; ++k) { gv[k] = *(const f32x4*)(lg + 512 * (k >> 1) + 8 * lane + 4 * (k & 1)); bv[k] = *(const f32x4*)(lb + 512 * (k >> 1) + 8 * lane + 4 * (k & 1)); }
    const int tok0 = blockIdx.x * 128 + wid * 16;
    u32x4 rh[2][2]; u32x2 ry0[2][2], ry1[2][2]; f32x2 rg[2];
#define LB_LOAD(tt) do { _Pragma("unroll") for (int u_ = 0; u_ < 2; ++u_) { const int t_ = (tt) + u_; const size_t ro_ = (size_t)t_ * DM; rg[u_] = *(const f32x2*)(gates + 2 * t_); _Pragma("unroll") for (int jj = 0; jj < 2; ++jj) { \
        const size_t co_ = 512 * jj + 8 * lane; rh[u_][jj] = *(const u32x4*)(hb + ro_ + co_); ry0[u_][jj] = *(const u32x2*)(ys + (size_t)(2 * t_) * DM + co_); ry1[u_][jj] = *(const u32x2*)(ys + (size_t)(2 * t_ + 1) * DM + co_); } } } while (0)
    LB_LOAD(tok0);
#pragma unroll 1
    for (int it = 0; it < 8; ++it) {
        u32x4 ch[2][2]; u32x2 cy0[2][2], cy1[2][2]; f32x2 cg[2];
#pragma unroll
        for (int u = 0; u < 2; ++u) { cg[u] = rg[u];
#pragma unroll
            for (int jj = 0; jj < 2; ++jj) { ch[u][jj] = rh[u][jj]; cy0[u][jj] = ry0[u][jj]; cy1[u][jj] = ry1[u][jj]; } }
        if (it < 7) LB_LOAD(tok0 + 2 * it + 2);
#pragma unroll
        for (int u = 0; u < 2; ++u) { const int t = tok0 + 2 * it + u; const size_t rowo = (size_t)t * DM; const float g0 = cg[u].x * (1.0f / YS_SCALE), g1 = cg[u].y * (1.0f / YS_SCALE);
            f32x4 v[4]; float s = 0.f;
#pragma unroll
            for (int jj = 0; jj < 2; ++jj) { f32x4 ha, hb2; bf8_to_f32(ch[u][jj], ha, hb2);
                const f32x4 ya = fp8x4_to_f32(cy0[u][jj].x), yb = fp8x4_to_f32(cy0[u][jj].y), za = fp8x4_to_f32(cy1[u][jj].x), zb = fp8x4_to_f32(cy1[u][jj].y);
                const f32x4 w0 = ALPHA * ha + g0 * ya + g1 * za, w1 = ALPHA * hb2 + g0 * yb + g1 * zb;
                v[2 * jj] = w0; v[2 * jj + 1] = w1; s += ((w0[0] + w0[1]) + (w0[2] + w0[3])) + ((w1[0] + w1[1]) + (w1[2] + w1[3])); }
            const float mean = wave_sum(s) * (1.0f / 1024.0f); float q = 0.f;
#pragma unroll
            for (int k = 0; k < 4; ++k) { const f32x4 d = v[k] - mean; q += (d[0] * d[0] + d[1] * d[1]) + (d[2] * d[2] + d[3] * d[3]); }
            const float rstd = 1.0f / sqrtf(wave_sum(q) * (1.0f / 1024.0f) + LN_EPS);
#pragma unroll
            for (int jj = 0; jj < 2; ++jj) { const size_t co = 512 * jj + 8 * lane;
                const f32x4 o0 = (v[2 * jj] - mean) * rstd * gv[2 * jj] + bv[2 * jj], o1 = (v[2 * jj + 1] - mean) * rstd * gv[2 * jj + 1] + bv[2 * jj + 1];
                if (f_out) { *(f32x4*)(f_out + rowo + co) = o0; *(f32x4*)(f_out + rowo + co + 4) = o1; }
                if (xb_out) { *(u32x4*)(xb_out + rowo + co) = pack8(o0, o1);
                    u32x2 w8; w8.x = pk4_fp8(o0[0], o0[1], o0[2], o0[3]); w8.y = pk4_fp8(o1[0], o1[1], o1[2], o1[3]); *(u32x2*)(x8_out + rowo + co) = w8; } } }
    }
#undef LB_LOAD
}

__device__ __forceinline__ void glds4(const char* sbase, unsigned voff, unsigned lds_dst) {
    unsigned keep;
    asm volatile("s_mov_b32 %0, m0\n\ts_mov_b32 m0, %3\n\ts_nop 0\n\tglobal_load_lds_dword %1, %2\n\ts_mov_b32 m0, %0" : "=&s"(keep) : "v"(voff), "s"(sbase), "s"(lds_dst) : "memory");
}
constexpr int A8_K = 0, A8_V = 81920, A8_RP = 122880, A8_KBUF = 40960;
__device__ __forceinline__ long mk64(unsigned lo, unsigned hi) { return (long)(((unsigned long long)hi << 32) | (unsigned long long)lo); }
__device__ __forceinline__ void phase_attn(const Params& p, LAS unsigned char* lds, const unsigned char* q8, const unsigned char* k8, const unsigned char* vt8, unsigned char* ob) {
    const int tid = tid_fresh(), lane = tid & 63, wid = __builtin_amdgcn_readfirstlane(tid >> 6), fr = lane & 15, fq = lane >> 4;
    const unsigned lds0 = (unsigned)(__UINTPTR_TYPE__)lds;
    const int item = (gridDim.x == 256) ? (int)((blockIdx.x & 7) * 32 + (blockIdx.x >> 3)) : (int)blockIdx.x, b = item >> 6, r0 = (item & 63) * 2;
    const int rsU = min(max(r0 - 4, 0), 118);
    const int r = r0 + (wid >> 2), jq = wid & 3;
    const int rs = min(max(r - 4, 0), 120), c0 = min(max(16 * jq - 8, 0), 32), lrow0 = rs - rsU;
    unsigned offK; { const int tokl = tid >> 2, pc = tid & 3, lc = pc ^ ((tokl >> 2) & 3); offK = (unsigned)(tokl * DM + lc * 16); }
    unsigned offV[5];
#pragma unroll
    for (int k = 0; k < 5; ++k) { const int q = k * 512 + tid, d = q / 40, pc = q - d * 40, lc = pc ^ (d & 7); offV[k] = (unsigned)(d * T + lc * 16); }
    const unsigned offR = (unsigned)min(wid * 64 + lane, 464) * 4u;
    const char* kbase0 = (const char*)k8 + ((size_t)(b * SEQ + rsU * 64) * DM);
    const char* vbase0 = (const char*)vt8 + ((size_t)(b * SEQ + rsU * 64));
    const char* rbase0 = (const char*)p.in[4];
    const size_t tokq = (size_t)b * SEQ + r * 64 + 16 * jq + fr;
    const char* qrow = (const char*)q8 + tokq * DM + 8 * fq;
#define AT_ISSUE_A(h, buf) do { const char* kb_ = kbase0 + (h) * 64; _Pragma("unroll") for (int k = 0; k < 5; ++k) gm::glds16(kb_ + (size_t)k * 131072, offK, lds0 + A8_K + (buf) * A8_KBUF + k * 8192 + wid * 1024); \
        glds4(rbase0 + (h) * 1860, offR, lds0 + A8_RP + (buf) * 2048 + wid * 256); } while (0)
#define AT_ISSUE_B(h) do { const char* vb_ = vbase0 + (size_t)(h) * 64 * T; _Pragma("unroll") for (int k = 0; k < 5; ++k) gm::glds16(vb_, offV[k], lds0 + A8_V + k * 8192 + wid * 1024); } while (0)
#define AT_LDQ(h, q0, q1) do { asm volatile("global_load_dwordx2 %0, %2, off\n\tglobal_load_dwordx2 %1, %2, off offset:32" : "=&v"(q0), "=&v"(q1) : "v"(qrow + (h) * 64) : "memory"); } while (0)
    const int swzk = ((c0 >> 2) + (fr >> 2)) & 3;
    const int kofs0 = (lrow0 * 64 + c0 + fr) * 64 + ((((fq >> 1) ^ swzk)) << 4) + (fq & 1) * 8, kofs1 = (lrow0 * 64 + c0 + fr) * 64 + (((((fq >> 1) ^ swzk)) ^ 2) << 4) + (fq & 1) * 8;
    int vo[8][2];
#pragma unroll
    for (int i = 0; i < 8; ++i)
#pragma unroll
        for (int hf = 0; hf < 2; ++hf) { const int tokoff = (lrow0 + i) * 64 + c0 + 4 * fq + 16 * hf; vo[i][hf] = fr * 640 + (((tokoff >> 4) ^ (fr & 7)) << 4) + (tokoff & 15); }
    const int qc = 16 * jq + fr, cs = min(max(qc - 8, 0), 48);
    long qn0, qn1;
    AT_LDQ(0, qn0, qn1);
    AT_ISSUE_A(0, 0); AT_ISSUE_B(0);
#pragma unroll 1
    for (int h = 0; h < 16; ++h) {
        const int hn = h < 15 ? h + 1 : 15, kb = h & 1;
        asm volatile("s_waitcnt vmcnt(5)" : "+v"(qn0), "+v"(qn1) :: "memory");
        const long q0 = qn0, q1 = qn1;
        __builtin_amdgcn_s_barrier();
        AT_LDQ(hn, qn0, qn1);
        AT_ISSUE_A(hn, kb ^ 1);
        f32x4 s[16];
#pragma unroll
        for (int kbi = 0; kbi < 16; ++kbi) { const int i = kbi >> 1, half = kbi & 1;
            const long k0 = *(const LAS long*)(lds + A8_K + kb * A8_KBUF + kofs0 + i * 4096 + half * 1024), k1 = *(const LAS long*)(lds + A8_K + kb * A8_KBUF + kofs1 + i * 4096 + half * 1024);
            f32x4 a = (f32x4){0.f, 0.f, 0.f, 0.f};
            a = __builtin_amdgcn_mfma_f32_16x16x32_fp8_fp8(k0, q0, a, 0, 0, 0); a = __builtin_amdgcn_mfma_f32_16x16x32_fp8_fp8(k1, q1, a, 0, 0, 0); s[kbi] = a; }
        const LAS float* rp = (const LAS float*)(lds + A8_RP + kb * 2048);
        float mx = -3.0e38f; const int thr = cs - c0;
#pragma unroll
        for (int i = 0; i < 8; ++i) { const int ri = rs + i - r + 7;
#pragma unroll
            for (int j = 0; j < 4; ++j) { const int pos = 4 * fq + j; const bool sel0 = pos >= thr; const int ci = min(max(c0 + pos - qc + 15 + (sel0 ? 0 : 16), 0), 30);
                float bvv = rp[ri * 31 + ci]; asm volatile("" : "+v"(bvv)); const float v = (sel0 ? s[2 * i][j] : s[2 * i + 1][j]) * 0.125f + bvv; s[2 * i][j] = v; mx = fmaxf(mx, v); } }
        mx = fmaxf(mx, __shfl_xor(mx, 16)); mx = fmaxf(mx, __shfl_xor(mx, 32));
        const float mxp = mx - 4.1588830833596715f;
        float sum = 0.f;
#pragma unroll
        for (int i = 0; i < 8; ++i)
#pragma unroll
            for (int j = 0; j < 4; ++j) { const int pos = 4 * fq + j; const bool sel0 = pos >= thr; const float e = __expf(s[2 * i][j] - mxp); sum += e; s[2 * i][j] = sel0 ? e : 0.f; s[2 * i + 1][j] = sel0 ? 0.f : e; }
        sum += __shfl_xor(sum, 16); sum += __shfl_xor(sum, 32);
        asm volatile("s_waitcnt vmcnt(8)" ::: "memory");
        __builtin_amdgcn_s_barrier();
        f32x4 oacc[4];
#pragma unroll
        for (int db = 0; db < 4; ++db) oacc[db] = (f32x4){0.f, 0.f, 0.f, 0.f};
#pragma unroll
        for (int i = 0; i < 8; ++i) { const long pf = mk64(pk4_fp8(s[2 * i][0], s[2 * i][1], s[2 * i][2], s[2 * i][3]), pk4_fp8(s[2 * i + 1][0], s[2 * i + 1][1], s[2 * i + 1][2], s[2 * i + 1][3]));
#pragma unroll
            for (int db = 0; db < 4; ++db) { const unsigned lo = *(const LAS unsigned*)(lds + A8_V + vo[i][0] + db * 10240), hi = *(const LAS unsigned*)(lds + A8_V + vo[i][1] + db * 10240);
                oacc[db] = __builtin_amdgcn_mfma_f32_16x16x32_fp8_fp8(mk64(lo, hi), pf, oacc[db], 0, 0, 0); } }
        asm volatile("s_waitcnt lgkmcnt(0)" ::: "memory");
        __builtin_amdgcn_s_barrier();
        AT_ISSUE_B(hn);
        const float inv = O_SCALE / sum;
#pragma unroll
        for (int db = 0; db < 4; ++db) *(unsigned*)(ob + tokq * DM + h * 64 + 16 * db + 4 * fq) = pk4_fp8(oacc[db][0] * inv, oacc[db][1] * inv, oacc[db][2] * inv, oacc[db][3] * inv);
    }
    asm volatile("s_waitcnt vmcnt(0)" ::: "memory");
    __builtin_amdgcn_s_barrier();
#undef AT_ISSUE_A
#undef AT_ISSUE_B
#undef AT_LDQ
}

template <int SRC_SHIFT>
__device__ __forceinline__ int moe_setup(const Params& p, LAS unsigned char* lds, const int L, LAS int* ts, LAS int* idxsrc, LAS int* idxdst) {
    const int tid = tid_fresh(), lane = tid & 63; unsigned char* ws = p.ws;
    LAS int* cn = ts + 40;
    if (tid < 64) {
        const int c = (int)__hip_atomic_load((unsigned*)(ws + WS_CTL) + CNT_WORD0 + (L * 32 + (lane & 31)) * 64, __ATOMIC_RELAXED, __HIP_MEMORY_SCOPE_AGENT);
        const int nt = (c + 255) >> 8; int incl = nt;
#pragma unroll
        for (int o = 1; o < 32; o <<= 1) { const int up = __shfl_up(incl, o); if ((lane & 31) >= o) incl += up; }
        if (lane < 32) { cn[lane] = c; ts[lane] = incl - nt; if (lane == 31) ts[32] = incl; } }
    __syncthreads();
    const int ntile = ts[NE];
    gm::GridOrder o; o.init(ntile, 4, gridDim.x, blockIdx.x);
    const int* list = (const int*)(ws + WS_LIST);
#pragma unroll
    for (int k = 0; k < 4; ++k) { const int ui = 2 * k + (tid >> 8), r = tid & 255; int pm = 0, pn = 0; const bool ok_u = o.mn(ui, pm, pn);
        const int e = expert_of_tile(ts, ok_u ? pm : 0);
        if (ok_u) { const int j = pm - ts[e], ce = cn[e]; const int pos = j * 256 + r; const bool ok = pos < ce; const int a = list[(size_t)e * NASG + (ok ? pos : j * 256)];
            idxsrc[ui * 256 + r] = a >> SRC_SHIFT; idxdst[ui * 256 + r] = ok ? a : -1; } }
    __syncthreads();
    return ntile;
}

__device__ __forceinline__ bool in_rng(int lo, int hi, int k) { asm volatile("" : "+s"(lo), "+s"(hi)); return lo <= k && k < hi; }
__device__ __forceinline__ Params params_fresh() {
    Params r{};
#if defined(__HIP_DEVICE_COMPILE__)
    auto k = __builtin_amdgcn_kernarg_segment_ptr(); asm volatile("" : "+s"(k));
    const __attribute__((address_space(4))) Params* kp = (const __attribute__((address_space(4))) Params*)k;
#pragma unroll
    for (int i = 0; i < 13; ++i) r.in[i] = kp->in[i];
    r.out = kp->out; r.ws = kp->ws; r.ph_lo = kp->ph_lo; r.ph_hi = kp->ph_hi;
#endif
    return r;
}
__global__ void __launch_bounds__(512, 2) k_fwd(Params p_unused) {
    extern __shared__ __attribute__((aligned(16))) unsigned char lds_raw[];
    LAS unsigned char* lds = (LAS unsigned char*)lds_raw;
    const Params p0 = params_fresh();
    { const int tid = tid_fresh(); if (tid < 4) ((LAS unsigned*)(lds + LDS_BARW))[tid] = 0u; }
    __syncthreads();
    XcdBarrier bar; bar.bar = (unsigned*)(p0.ws + WS_CTL); bar.x = 0; bar.st = nullptr;
    const int lo = p0.ph_lo, hi = p0.ph_hi;
    if (hi - lo > 1) bar = xcd_barrier_post((unsigned*)(p0.ws + WS_CTL), (volatile LAS unsigned*)(lds + LDS_BARW));
#ifndef PHMASK
#define PHMASK 0xffff
#endif
#define IN(k) (((PHMASK >> (k)) & 1) && in_rng(lo, hi, (k)))
#define SEAM(k) do { if (IN((k) + 1)) xcd_barrier(bar); } while (0)
#define PH_PTRS const Params p = params_fresh(); unsigned char* ws = p.ws; const int G = gridDim.x, cb = blockIdx.x; \
    bf16_t* S0 = (bf16_t*)(ws + WS_S0); bf16_t* S1 = (bf16_t*)(ws + WS_S1); bf16_t* S2 = (bf16_t*)(ws + WS_S2); bf16_t* S3 = (bf16_t*)(ws + WS_S3); \
    unsigned char* H8 = (unsigned char*)p.out + 64 * MiB; unsigned char* X8 = (unsigned char*)p.out + 96 * MiB; bf16_t* D0 = (bf16_t*)p.out; (void)X8; \
    LAS int* idxsrc = (LAS int*)(lds + LDS_IDX); LAS int* idxdst = idxsrc + 8 * 256; LAS int* tsm = (LAS int*)(lds + LDS_MISC); \
    (void)G; (void)cb; (void)S0; (void)S1; (void)S2; (void)S3; (void)H8; (void)D0; (void)idxsrc; (void)idxdst; (void)tsm;

    if (IN(0)) { PH_PTRS phase_prologue(p, lds); SEAM(0); }

#pragma unroll 1
    for (int L = 0; L < 2; ++L) {
        const int pb = 7 * L;
        if (L == 0) {
            if (IN(1)) {
                PH_PTRS SchedG1 S; S.o.init(4, 128, G, cb); S.WinT = (const char*)(ws + WS_WIN); S.xb = (const char*)S0; EpiG1 E{S1, 1.0f / W_SCALE};
                gm::gemm_phase<EpiG1, SchedG1, false, true>(lds, 1024, 1024u, 64u * 1024u, S, E, nullptr); SEAM(1); }
            if (IN(2)) {
                PH_PTRS SchedS1 S{G, cb, (const char*)(ws + WS_F1), (const char*)S1}; EpiS1 E{S0};
                gm::gemm_phase<EpiS1, SchedS1, false>(lds, 256, 256u, 256u, S, E, nullptr); SEAM(2); }
            if (IN(3)) {
                PH_PTRS SchedS2 S; S.o.init(64, 16, G, cb); S.F2 = (const char*)(ws + WS_F2); S.A1 = (const char*)S0; EpiS2 E{(unsigned char*)S1};
                gm::gemm_phase<EpiS2, SchedS2, false>(lds, 256, 256u, 256u, S, E, nullptr); SEAM(3); }
        } else {
            if (IN(9)) {
                PH_PTRS
                { SchedPlain S; S.o.init(128, 8, G, cb); S.A = (const char*)X8; S.B = (const char*)(ws + WS_WQKV); S.ldA = 1024u; S.ldB = 1024u; S.p16 = true; EpiRow8 E{(unsigned char*)S1, 1024, 4, (size_t)32 * MiB, 1.0f / W_SCALE, 1.0f / W_SCALE};
                  gm::gemm_phase<EpiRow8, SchedPlain, false, true>(lds, 1024, 1024u, 1024u, S, E, nullptr); }
                { SchedPlain S; S.o.init(4, 128, G, cb); S.A = (const char*)(ws + WS_WQKV) + (size_t)2048 * 1024; S.B = (const char*)X8; S.ldA = 1024u; S.ldB = 1024u; S.p16 = true; EpiRow8 E{(unsigned char*)S3, (size_t)T, 0, 0, 1.0f / W_SCALE, 1.0f / W_SCALE};
                  gm::gemm_phase<EpiRow8, SchedPlain, false, true>(lds, 1024, 1024u, 1024u, S, E, nullptr); }
                SEAM(9); }
            if (IN(10)) { PH_PTRS phase_attn(p, lds, (const unsigned char*)S1, (const unsigned char*)S1 + 32 * MiB, (const unsigned char*)S3, (unsigned char*)S0); SEAM(10); }
        }
        if (L == 0) { if (IN(4)) {
            PH_PTRS SchedPlain S; S.o.init(128, 4, G, cb); S.A = (const char*)S1; S.B = (const char*)(ws + WS_W2); S.ldA = 2048u; S.ldB = 2048u;
            EpiRow E{S0, 1024, 0, 0, 1.0f / (Y_SCALE * W2_SCALE), 1.f};
            gm::gemm_phase<EpiRow, SchedPlain, false, true>(lds, 2048, 2048u, 2048u, S, E, nullptr); SEAM(4); } }
        else { if (IN(11)) {
            PH_PTRS SchedPlain S; S.o.init(128, 4, G, cb); S.A = (const char*)S0; S.B = (const char*)(ws + WS_WO); S.ldA = 1024u; S.ldB = 1024u;
            EpiRow E{S1, 1024, 0, 0, 1.0f / (W_SCALE * O_SCALE), 1.f};
            gm::gemm_phase<EpiRow, SchedPlain, false, true>(lds, 1024, 1024u, 1024u, S, E, nullptr); SEAM(11); } }
        if (IN(5 + pb)) { PH_PTRS phase_lnA(p, lds, L, D0, L == 0 ? S0 : S1, S3, H8); SEAM(5 + pb); }
        if (IN(6 + pb)) {
            PH_PTRS const int ntile = moe_setup<1>(p, lds, L, tsm, idxsrc, idxdst);
            SchedMoe S; S.o.init(ntile, 4, G, cb); S.ts = tsm; S.A = (const char*)H8; S.W = (const char*)(ws + WS_WGU) + (size_t)L * 32 * 1024 * 1024; S.wstride = (size_t)1024 * 1024; S.ldB = 1024u; S.hsB128 = true; S.tileA = 0u;
            EpiGU E{(unsigned char*)S0, idxdst};
            gm::gemm_phase<EpiGU, SchedMoe, true, true>(lds, 1024, 1024u, 1024u, S, E, idxsrc); SEAM(6 + pb); }
        if (IN(7 + pb)) {
            PH_PTRS int ntile; if (IN(6 + pb)) { __syncthreads(); ntile = tsm[NE]; } else ntile = moe_setup<0>(p, lds, L, tsm, idxsrc, idxdst);
            SchedMoe S; S.o.init(ntile, 4, G, cb); S.ts = tsm; S.A = (const char*)S0; S.W = (const char*)(ws + WS_WD) + (size_t)L * 32 * 1024 * 512; S.wstride = (size_t)1024 * 512; S.ldB = 512u; S.hsB128 = false; S.tileA = 256u * 512u;
            EpiDown E{(unsigned char*)S1, idxdst};
            gm::gemm_phase<EpiDown, SchedMoe, false, true>(lds, 512, 512u, 512u, S, E, nullptr); SEAM(7 + pb); }
        if (IN(8 + pb)) { PH_PTRS phase_lnB(p, L, S3, (const unsigned char*)S1, L == 0 ? D0 : nullptr, X8, L == 0 ? nullptr : p.out); if (L == 0) SEAM(8); }
    }
#undef IN
#undef SEAM
#undef PH_PTRS
}

extern "C" void kernel_launch(void* const* d_in, const int* in_sizes, int n_in, void* d_out, int out_size, void* d_ws, size_t ws_size, hipStream_t stream) {
    static int grid = 0;
    if (grid == 0) {
        if (n_in != 13 || in_sizes[0] != T * DM || out_size != T * DM || ws_size < WS_END) { fprintf(stderr, "kernel_launch: unexpected shapes / workspace (%d inputs, in0 %d, out %d, ws %zu < %zu)\n", n_in, n_in > 0 ? in_sizes[0] : -1, out_size, ws_size, (size_t)WS_END); grid = -1; return; }
        int dev = 0, cus = 0, per_cu = 0;
        if (hipGetDevice(&dev) != hipSuccess || hipDeviceGetAttribute(&cus, hipDeviceAttributeMultiprocessorCount, dev) != hipSuccess) { grid = -1; return; }
        if (hipFuncSetAttribute((const void*)k_fwd, hipFuncAttributeMaxDynamicSharedMemorySize, LDS_BYTES) != hipSuccess) { fprintf(stderr, "kernel_launch: hipFuncSetAttribute failed\n"); grid = -1; return; }
        if (hipOccupancyMaxActiveBlocksPerMultiprocessor(&per_cu, (const void*)k_fwd, 512, LDS_BYTES) != hipSuccess || per_cu < 1) fprintf(stderr, "kernel_launch: occupancy query says %d\n", per_cu);
        (void)hipGetLastError();
        grid = cus;
    }
    if (grid < 0) return;
    (void)hipMemsetAsync((char*)d_ws + WS_CTL, 0, CTL_ZERO_BYTES, stream);
    Params a{};
    for (int i = 0; i < 13; ++i) a.in[i] = (const float*)d_in[i];
    a.out = (float*)d_out; a.ws = (unsigned char*)d_ws;
#if MK_N_LAUNCHES == 1
    a.ph_lo = 0; a.ph_hi = NPH;
    hipLaunchKernelGGL(k_fwd, dim3(grid), dim3(512), LDS_BYTES, stream, a);
#else
    for (int k = 0; k < NPH; ++k) { a.ph_lo = k; a.ph_hi = k + 1; const int reps = ((REPMASK >> k) & 1) ? 2 : 1;
        for (int r = 0; r < reps; ++r) hipLaunchKernelGGL(k_fwd, dim3(grid), dim3(512), LDS_BYTES, stream, a); }
#endif
}
```

```cpp
#include <hip/hip_runtime.h>
#include <cstdio>
#include <cstdint>

#ifndef MK_N_LAUNCHES
#define MK_N_LAUNCHES 1
#endif
#ifndef REPMASK
#define REPMASK 0x0
#endif

#define LAS __attribute__((address_space(3)))
typedef unsigned short bf16_t;
typedef short bf16x8 __attribute__((ext_vector_type(8)));
typedef short bf16x4 __attribute__((ext_vector_type(4)));
typedef float f32x4 __attribute__((ext_vector_type(4)));
typedef float f32x2 __attribute__((ext_vector_type(2)));
typedef unsigned u32x4 __attribute__((ext_vector_type(4)));
typedef unsigned u32x2 __attribute__((ext_vector_type(2)));

constexpr int T = 32768, DM = 1024, SEQ = 8192, NBATCH = 4, NE = 32, DEX = 512, NASG = 65536, NPH = 16;
constexpr float ALPHA = 1.41421356237309515f;
constexpr float LN_EPS = 1e-5f;
constexpr size_t MiB = (size_t)1 << 20;
constexpr size_t WS_CTL = 0, WS_GATE = 1 * MiB, WS_LIST = 2 * MiB, WS_WIN = 10 * MiB, WS_W2 = 12 * MiB, WS_F1 = 16 * MiB, WS_F2 = 17 * MiB, WS_WQKV = 21 * MiB, WS_WO = 27 * MiB,
                 WS_WGU = 30 * MiB, WS_WD = 158 * MiB, WS_S0 = 222 * MiB, WS_S1 = 286 * MiB, WS_S2 = 350 * MiB, WS_S3 = 414 * MiB, WS_END = 478 * MiB;
constexpr size_t CTL_ZERO_BYTES = 65536;
constexpr int CNT_WORD0 = 4096;
constexpr int LDS_BYTES = 159760;
constexpr int LDS_IDX = 131072, LDS_MISC = 131072 + 16384, LDS_BARW = LDS_BYTES - 16;

#define XB_TMO      128
#define XB_XCNT(j)  (256  + 64 * (j))
#define XB_XSUB(j)  (1280 + 64 * (j))
#define XB_XGEN(j)  (2304 + 64 * (j))
#define XB_TOP      3328
#define XB_TOPGEN   3392
#define XCD_BAR_WORDS 3456
#define XB_SPIN_CAP (1u << 18)

__device__ __forceinline__ unsigned xb_ld(unsigned* p)              { return __hip_atomic_load(p, __ATOMIC_RELAXED, __HIP_MEMORY_SCOPE_AGENT); }
__device__ __forceinline__ unsigned xb_add(unsigned* p, unsigned v) { return __hip_atomic_fetch_add(p, v, __ATOMIC_RELAXED, __HIP_MEMORY_SCOPE_AGENT); }
__device__ __forceinline__ unsigned xb_xcc_id() { return (unsigned)__builtin_amdgcn_s_getreg((3 << 11) | 20) & 0xFu; }
#define XB_SPIN(cond, bar) do { unsigned _sp = 0; while (cond) { __builtin_amdgcn_s_sleep(1); \
    if ((++_sp & 255u) == 0u) { if (xb_ld(&(bar)[XB_TMO])) break; if (_sp > XB_SPIN_CAP) { atomicAdd(&(bar)[XB_TMO], 1u); break; } } } } while (0)

struct XcdBarrier { unsigned* bar; unsigned x; volatile LAS unsigned* st; };

__device__ __forceinline__ XcdBarrier xcd_barrier_post(unsigned* bar, volatile LAS unsigned* st) {
    XcdBarrier b; b.bar = bar; b.x = xb_xcc_id(); b.st = st;
    if (threadIdx.x == 0) (void)xb_add(&bar[XB_XCNT(b.x)], 1u);
    return b;
}
__device__ __forceinline__ void xcd_barrier_complete(unsigned* bar, unsigned x, unsigned& nloc, unsigned& nx) {
    const unsigned G = gridDim.x * gridDim.y * gridDim.z;
    unsigned sum, cnt, mine, sp = 0u;
    for (;;) {
        sum = 0u; cnt = 0u; mine = 0u;
#pragma unroll
        for (unsigned j = 0; j < 16; ++j) { const unsigned c = xb_ld(&bar[XB_XCNT(j)]); sum += c; cnt += (c > 0u) ? 1u : 0u; mine = (j == x) ? c : mine; }
        if (sum == G) break;
        __builtin_amdgcn_s_sleep(1);
        if ((++sp & 255u) == 0u) { if (xb_ld(&bar[XB_TMO])) break; if (sp > XB_SPIN_CAP) { atomicAdd(&bar[XB_TMO], 1u); break; } }
    }
    nloc = mine > 0u ? mine : 1u; nx = cnt > 0u ? cnt : 1u;
}
__device__ __forceinline__ void xcd_barrier(const XcdBarrier& b) {
    asm volatile("s_waitcnt vmcnt(0)" ::: "memory");
    __syncthreads();
    if (threadIdx.x == 0) {
        unsigned* bar = b.bar;
        __builtin_amdgcn_s_waitcnt(0);
        unsigned nloc = b.st[0], nx = b.st[1];
        if (nloc == 0u) { xcd_barrier_complete(bar, b.x, nloc, nx); b.st[0] = nloc; b.st[1] = nx; }
        const unsigned old = xb_add(&bar[XB_XSUB(b.x)], 1u);
        const unsigned gen = old / nloc;
        if (old + 1u == (gen + 1u) * nloc) {
            __builtin_amdgcn_fence(__ATOMIC_RELEASE, "agent");
            asm volatile("s_waitcnt vmcnt(0)" ::: "memory");
            const unsigned og = xb_add(&bar[XB_TOP], 1u);
            const unsigned tg = og / nx;
            if (og + 1u == (tg + 1u) * nx) xb_add(&bar[XB_TOPGEN], 1u);
            else XB_SPIN(xb_ld(&bar[XB_TOPGEN]) == tg, bar);
            __builtin_amdgcn_fence(__ATOMIC_ACQUIRE, "agent");
            xb_add(&bar[XB_XGEN(b.x)], 1u);
            asm volatile("s_waitcnt vmcnt(0)" ::: "memory");
        } else {
            XB_SPIN(xb_ld(&bar[XB_XGEN(b.x)]) == gen, bar);
            __builtin_amdgcn_fence(__ATOMIC_ACQUIRE, "agent");
            asm volatile("s_waitcnt vmcnt(0)" ::: "memory");
        }
    }
    __syncthreads();
}

__device__ __forceinline__ unsigned cvt_pk_bf16_t(float lo, float hi) { unsigned r; asm volatile("s_nop 0\n\tv_cvt_pk_bf16_f32 %0, %1, %2" : "=v"(r) : "v"(lo), "v"(hi)); return r; }
__device__ __forceinline__ unsigned cvt_pk_bf16(float lo, float hi) { unsigned r; asm volatile("v_cvt_pk_bf16_f32 %0, %1, %2" : "=v"(r) : "v"(lo), "v"(hi)); return r; }
__device__ __forceinline__ float bf_lo(unsigned w) { return __uint_as_float(w << 16); }
__device__ __forceinline__ float bf_hi(unsigned w) { return __uint_as_float(w & 0xffff0000u); }
__device__ __forceinline__ u32x4 pack8(const f32x4 a, const f32x4 b) { u32x4 w; w.x = cvt_pk_bf16(a[0], a[1]); w.y = cvt_pk_bf16(a[2], a[3]); w.z = cvt_pk_bf16(b[0], b[1]); w.w = cvt_pk_bf16(b[2], b[3]); return w; }
__device__ __forceinline__ int tid_fresh() { int t = threadIdx.x; asm volatile("" : "+v"(t)); return t; }
__device__ __forceinline__ void bf8_to_f32(const u32x4 w, f32x4& a, f32x4& b) { a[0] = bf_lo(w.x); a[1] = bf_hi(w.x); a[2] = bf_lo(w.y); a[3] = bf_hi(w.y); b[0] = bf_lo(w.z); b[1] = bf_hi(w.z); b[2] = bf_lo(w.w); b[3] = bf_hi(w.w); }
__device__ __forceinline__ float wave_sum(float v) {
#pragma unroll
    for (int o = 32; o >= 1; o >>= 1) v += __shfl_xor(v, o);
    return v;
}

constexpr float W_SCALE = 64.0f, H_SCALE = 4.0f, O_SCALE = 16.0f, Y_SCALE = 8.0f, W2_SCALE = 256.0f, YS_SCALE = 16.0f;
__device__ __forceinline__ f32x4 fp8x4_to_f32(unsigned w) { f32x4 r; r[0] = __builtin_amdgcn_cvt_f32_fp8(w, 0); r[1] = __builtin_amdgcn_cvt_f32_fp8(w, 1); r[2] = __builtin_amdgcn_cvt_f32_fp8(w, 2); r[3] = __builtin_amdgcn_cvt_f32_fp8(w, 3); return r; }
__device__ __forceinline__ float silu_mul(float g, float up) { return g * __builtin_amdgcn_rcpf(1.0f + __expf(-g)) * up; }
__device__ __forceinline__ unsigned pk4_fp8(float a, float b, float c, float d) { unsigned r = 0; r = __builtin_amdgcn_cvt_pk_fp8_f32(a, b, r, false); r = __builtin_amdgcn_cvt_pk_fp8_f32(c, d, r, true); return r; }
namespace gm {
constexpr int BM = 256, BK = 64, HALF = 128, HTB = HALF * BK * 2, STAGE_BYTES = 8 * HTB, NXCD = 8, WGM = 16;
__device__ __forceinline__ int lds_byte(int r, int c) { const int st = (r >> 4) * 2 + (c >> 5), rr = r & 15, cc = c & 31, ob = rr * 64 + cc * 2; return st * 1024 + (ob ^ (((ob >> 9) & 1) << 5)); }
__device__ __forceinline__ void stage_rc(int b, int& R, int& C) { const int st = b / 1024, sb = b % 1024, swz = sb ^ (((sb >> 9) & 1) << 5); R = (st >> 1) * 16 + swz / 64; C = (st & 1) * 32 + (swz % 64) / 2; }
__device__ __forceinline__ int perm32(int rho) { const int n = rho >> 4, i = rho & 15; return 8 * (i >> 2) + 4 * n + (i & 3); }

__device__ __forceinline__ void glds16(const char* sbase, unsigned voff, unsigned lds_dst) {
    unsigned keep;
    asm volatile("s_mov_b32 %0, m0\n\ts_mov_b32 m0, %3\n\ts_nop 0\n\tglobal_load_lds_dwordx4 %1, %2\n\ts_mov_b32 m0, %0" : "=&s"(keep) : "v"(voff), "s"(sbase), "s"(lds_dst) : "memory");
}
struct Unit { const char* A; const char* B; unsigned hsA, hsB; int pm, pn, x0, x1; };

struct GridOrder {
    int nM, nN, nwg, G, c;
    __device__ __forceinline__ void init(int nM_, int nN_, int G_, int c_) { nM = nM_; nN = nN_; nwg = nM * nN; G = G_; c = c_; }
    __device__ __forceinline__ bool mn(int i, int& pm, int& pn) const {
        const long L = (long)i * G + c; if (L >= nwg) return false;
        int wgid = (int)L; { const int q = nwg / NXCD, r = nwg % NXCD, xcd = wgid % NXCD, off = wgid / NXCD; wgid = (xcd < r ? xcd * (q + 1) : r * (q + 1) + (xcd - r) * q) + off; }
        const int nig = WGM * nN, gid = wgid / nig, fm = gid * WGM, gsz = (nM - fm) < WGM ? (nM - fm) : WGM;
        pm = fm + ((wgid % nig) % gsz); pn = (wgid % nig) / gsz; return true;
    }
};

typedef int i32x4v __attribute__((ext_vector_type(4)));
typedef int i32x8v __attribute__((ext_vector_type(8)));
__device__ __forceinline__ i32x8v cat8(const bf16x8 a, const bf16x8 b) { const i32x4v x = __builtin_bit_cast(i32x4v, a), y = __builtin_bit_cast(i32x4v, b); return (i32x8v){x[0], x[1], x[2], x[3], y[0], y[1], y[2], y[3]}; }
template <class E, class = void> struct epi_perm16 { static constexpr bool value = false; };
template <class E> struct epi_perm16<E, decltype((void)E::PERM16)> { static constexpr bool value = E::PERM16; };
template <class Epi, class Sched, bool GATHER, bool FP8 = false, bool SP2 = true, bool ALIGN_EPI = true>
__device__ __forceinline__ void gemm_phase(LAS unsigned char* lds, const int kbytes, const unsigned ldA, const unsigned ldB, const Sched& S, const Epi& E, const LAS int* idxsrc) {
    const int tid = tid_fresh(), wid = __builtin_amdgcn_readfirstlane(tid >> 6), lane = tid & 63, wr = wid >> 2, wc = wid & 3, fr = lane & 15, fq = lane >> 4;
    int nt = kbytes / (BK * 2); asm volatile("" : "+s"(nt));
    unsigned voffA[2][2], voffBh[2][2];
#pragma unroll
    for (int i = 0; i < 2; ++i) { int R, C; stage_rc(tid * 16 + i * 8192, R, C); const int q = perm32(R & 31); const int Rb = Epi::PERM ? ((R & ~31) + q) : R;
        voffA[0][i] = (unsigned)R * ldA + (unsigned)C * 2u; voffA[1][i] = voffA[0][i];
        if constexpr (epi_perm16<Epi>::value) { const int rb0 = 64 * (R >> 5) + 16 * (q >> 3) + (q & 7); voffBh[0][i] = (unsigned)rb0 * ldB + (unsigned)C * 2u; voffBh[1][i] = (unsigned)(rb0 + 8) * ldB + (unsigned)C * 2u; }
        else { voffBh[0][i] = (unsigned)Rb * ldB + (unsigned)C * 2u; voffBh[1][i] = voffBh[0][i]; } }
    const size_t kstep = (size_t)(BK * 2);
    const unsigned ldsw = (unsigned)wid * 1024u;
    const unsigned lds0 = (unsigned)(__UINTPTR_TYPE__)lds;
    const int aoff = lds_byte(wr * 64 + fr, fq * 8), boff = lds_byte(wc * 32 + fr, fq * 8);
#define PG8_SA(b, h) (((b) * 2 + (h)) * HTB)
#define PG8_SB(b, h) ((4 + (b) * 2 + (h)) * HTB)
#define PG8_STAGE(bufoff, gbase, voff) do { _Pragma("unroll") for (int _i = 0; _i < 2; ++_i) glds16((const char*)(gbase), (voff)[_i], lds0 + (unsigned)(bufoff) + ldsw + _i * 8192u); } while (0)
#define PG8_LDA(dst, b, h) do { _Pragma("unroll") for (int m = 0; m < 4; ++m) _Pragma("unroll") for (int k = 0; k < 2; ++k) dst[m][k] = *(const LAS bf16x8*)(lds + PG8_SA(b, h) + aoff + m * 2048 + k * 1024); } while (0)
#define PG8_LDB(dst, b, h) do { _Pragma("unroll") for (int n = 0; n < 2; ++n) _Pragma("unroll") for (int k = 0; k < 2; ++k) dst[n][k] = *(const LAS bf16x8*)(lds + PG8_SB(b, h) + boff + n * 2048 + k * 1024); } while (0)
#define PG8_MMA(ai, bj, At, Bt) do { __builtin_amdgcn_s_setprio(1); _Pragma("unroll") for (int m = 0; m < 4; ++m) _Pragma("unroll") for (int n = 0; n < 2; ++n) { \
        if constexpr (FP8) { const i32x8v b8_ = cat8(Bt[n][0], Bt[n][1]), a8_ = cat8(At[m][0], At[m][1]); \
            asm volatile("s_nop 1\n\tv_mfma_scale_f32_16x16x128_f8f6f4 %0, %1, %2, %0, %3, %3 op_sel_hi:[0,0,0]" : "+v"(acc[ai][bj][m][n]) : "v"(b8_), "v"(a8_), "v"(fp8_unit_scale)); } \
        else { _Pragma("unroll") for (int k = 0; k < 2; ++k) acc[ai][bj][m][n] = __builtin_amdgcn_mfma_f32_16x16x32_bf16(Bt[n][k], At[m][k], acc[ai][bj][m][n], 0, 0, 0); } } \
        __builtin_amdgcn_s_setprio(0); } while (0)
#define PG8_WAIT_V(n) asm volatile("s_waitcnt vmcnt(" #n ")" ::: "memory")
#define PG8_WAIT_L(n) asm volatile("s_waitcnt lgkmcnt(" #n ")" ::: "memory")
#define PG8_BAR __builtin_amdgcn_s_barrier()
#define PG8_SCHED __builtin_amdgcn_sched_barrier(0)
#define PG8_VA(h) voffA[GATHER ? (h) : 0]
#define PG8_VB(h) voffBh[epi_perm16<Epi>::value ? (h) : 0]
    const int fp8_unit_scale = 0x7f7f7f7f;
    Unit cur, nxt; int ui = 0;
    if (!S.next(0, cur)) return;
    if constexpr (GATHER) {
#pragma unroll
        for (int h = 0; h < 2; ++h)
#pragma unroll
            for (int i = 0; i < 2; ++i) { int R, C; stage_rc(tid * 16 + i * 8192, R, C); voffA[h][i] = (unsigned)idxsrc[h * 128 + R] * ldA + (unsigned)C * 2u; }
    }
    f32x4 acc[2][2][4][2];
#pragma unroll
    for (int a = 0; a < 2; ++a)
#pragma unroll
        for (int b = 0; b < 2; ++b)
#pragma unroll
            for (int m = 0; m < 4; ++m)
#pragma unroll
                for (int n = 0; n < 2; ++n) acc[a][b][m][n] = (f32x4){0.f, 0.f, 0.f, 0.f};
    bf16x8 At[4][2], B0[2][2], B1[2][2];
    const char* cA = cur.A; const char* cB = cur.B; unsigned chA = cur.hsA, chB = cur.hsB;
    if constexpr (SP2) {
        PG8_STAGE(PG8_SB(0, 0), cB, PG8_VB(0)); PG8_STAGE(PG8_SB(0, 1), cB + chB, PG8_VB(1)); PG8_STAGE(PG8_SA(0, 0), cA, PG8_VA(0)); PG8_STAGE(PG8_SA(0, 1), cA + chA, PG8_VA(1));
        if (wr == 1) PG8_BAR;
        PG8_WAIT_V(2); PG8_BAR;
        PG8_STAGE(PG8_SB(1, 0), cB + kstep, PG8_VB(0)); PG8_STAGE(PG8_SA(1, 0), cA + kstep, PG8_VA(0)); PG8_STAGE(PG8_SB(1, 1), cB + chB + kstep, PG8_VB(1));
        PG8_WAIT_V(6); PG8_BAR;
    } else {
    PG8_STAGE(PG8_SB(0, 0), cB, PG8_VB(0)); PG8_STAGE(PG8_SA(0, 0), cA, PG8_VA(0)); PG8_STAGE(PG8_SB(0, 1), cB + chB, PG8_VB(1)); PG8_STAGE(PG8_SA(0, 1), cA + chA, PG8_VA(1));
    if (wr == 1) PG8_BAR;
    PG8_WAIT_V(4); PG8_BAR;
    PG8_STAGE(PG8_SB(1, 0), cB + kstep, PG8_VB(0)); PG8_STAGE(PG8_SA(1, 0), cA + kstep, PG8_VA(0)); PG8_STAGE(PG8_SB(1, 1), cB + chB + kstep, PG8_VB(1));
    PG8_WAIT_V(6); PG8_BAR;
    }
    for (;;) {
        const bool has_next = S.next(ui + 1, nxt);
        const char* nA = has_next ? nxt.A : cA; const char* nB = has_next ? nxt.B : cB; const unsigned nhA = has_next ? nxt.hsA : chA, nhB = has_next ? nxt.hsB : chB;
#pragma unroll 1
        for (int t = 0; t < nt; t += 2) {
            const bool last = (t == nt - 2);
            const char* a1 = cA + (size_t)(t + 1) * kstep;
            const char* a2 = last ? nA : cA + (size_t)(t + 2) * kstep; const char* b2 = last ? nB : cB + (size_t)(t + 2) * kstep;
            const unsigned hA2 = last ? nhA : chA, hB2 = last ? nhB : chB;
            const char* a3 = a2 + kstep; const char* b3 = b2 + kstep;
            const bool sw = GATHER && last && has_next;
            int gi[2][2];
            if constexpr (SP2) {
            PG8_LDB(B0, 0, 0); PG8_LDB(B1, 0, 1); PG8_SCHED; PG8_LDA(At, 0, 0); PG8_STAGE(PG8_SA(1, 1), a1 + chA, PG8_VA(1));
            PG8_WAIT_V(8); PG8_WAIT_L(0); PG8_BAR; PG8_MMA(0, 0, At, B0); PG8_MMA(0, 1, At, B1); PG8_BAR; PG8_SCHED;
            if constexpr (GATHER) { if (sw) {
#pragma unroll
                for (int h = 0; h < 2; ++h)
#pragma unroll
                    for (int i = 0; i < 2; ++i) { int R, C; stage_rc(tid * 16 + i * 8192, R, C); gi[h][i] = idxsrc[(ui + 1) * 256 + h * 128 + R]; } } }
            PG8_LDA(At, 0, 1); PG8_STAGE(PG8_SB(0, 0), b2, PG8_VB(0)); PG8_STAGE(PG8_SB(0, 1), b2 + hB2, PG8_VB(1));
            if constexpr (GATHER) { if (sw) {
#pragma unroll
                for (int h = 0; h < 2; ++h)
#pragma unroll
                    for (int i = 0; i < 2; ++i) { int R, C; stage_rc(tid * 16 + i * 8192, R, C); voffA[h][i] = (unsigned)gi[h][i] * ldA + (unsigned)C * 2u; } } }
            PG8_STAGE(PG8_SA(0, 0), a2, PG8_VA(0));
            PG8_WAIT_V(8); PG8_WAIT_L(0); PG8_BAR; PG8_MMA(1, 0, At, B0); PG8_MMA(1, 1, At, B1); PG8_BAR; PG8_SCHED;
            PG8_LDB(B0, 1, 0); PG8_LDB(B1, 1, 1); PG8_SCHED; PG8_LDA(At, 1, 0); PG8_STAGE(PG8_SA(0, 1), a2 + hA2, PG8_VA(1));
            PG8_WAIT_V(8); PG8_WAIT_L(0); PG8_BAR; PG8_MMA(0, 0, At, B0); PG8_MMA(0, 1, At, B1); PG8_BAR; PG8_SCHED;
            PG8_LDA(At, 1, 1); PG8_STAGE(PG8_SB(1, 0), b3, PG8_VB(0)); PG8_STAGE(PG8_SB(1, 1), b3 + hB2, PG8_VB(1)); PG8_STAGE(PG8_SA(1, 0), a3, PG8_VA(0));
            PG8_WAIT_V(8); PG8_WAIT_L(0); PG8_BAR; PG8_MMA(1, 0, At, B0); PG8_MMA(1, 1, At, B1); PG8_BAR; PG8_SCHED;
            } else {
            PG8_LDB(B0, 0, 0); PG8_SCHED; PG8_LDA(At, 0, 0); PG8_STAGE(PG8_SA(1, 1), a1 + chA, PG8_VA(1));
            PG8_WAIT_L(8); PG8_BAR; PG8_WAIT_L(0); PG8_MMA(0, 0, At, B0); PG8_BAR; PG8_SCHED;
            if constexpr (GATHER) { if (sw) {
#pragma unroll
                for (int h = 0; h < 2; ++h)
#pragma unroll
                    for (int i = 0; i < 2; ++i) { int R, C; stage_rc(tid * 16 + i * 8192, R, C); gi[h][i] = idxsrc[(ui + 1) * 256 + h * 128 + R]; } } }
            PG8_LDB(B1, 0, 1); PG8_STAGE(PG8_SB(0, 0), b2, PG8_VB(0));
            PG8_BAR; PG8_WAIT_L(0); PG8_MMA(0, 1, At, B1); PG8_BAR;
            if constexpr (GATHER) { if (sw) {
#pragma unroll
                for (int h = 0; h < 2; ++h)
#pragma unroll
                    for (int i = 0; i < 2; ++i) { int R, C; stage_rc(tid * 16 + i * 8192, R, C); voffA[h][i] = (unsigned)gi[h][i] * ldA + (unsigned)C * 2u; } } }
            PG8_LDA(At, 0, 1); PG8_STAGE(PG8_SA(0, 0), a2, PG8_VA(0));
            PG8_BAR; PG8_WAIT_L(0); PG8_MMA(1, 0, At, B0); PG8_BAR; PG8_SCHED;
            PG8_STAGE(PG8_SB(0, 1), b2 + hB2, PG8_VB(1));
            PG8_WAIT_V(6); PG8_BAR; PG8_MMA(1, 1, At, B1); PG8_BAR;
            PG8_LDB(B0, 1, 0); PG8_SCHED; PG8_LDA(At, 1, 0); PG8_STAGE(PG8_SA(0, 1), a2 + hA2, PG8_VA(1));
            PG8_WAIT_L(8); PG8_BAR; PG8_WAIT_L(0); PG8_MMA(0, 0, At, B0); PG8_BAR; PG8_SCHED;
            PG8_LDB(B1, 1, 1); PG8_STAGE(PG8_SB(1, 0), b3, PG8_VB(0));
            PG8_BAR; PG8_WAIT_L(0); PG8_MMA(0, 1, At, B1); PG8_BAR;
            PG8_LDA(At, 1, 1); PG8_STAGE(PG8_SA(1, 0), a3, PG8_VA(0));
            PG8_BAR; PG8_WAIT_L(0); PG8_MMA(1, 0, At, B0); PG8_BAR; PG8_SCHED;
            PG8_STAGE(PG8_SB(1, 1), b3 + hB2, PG8_VB(1));
            PG8_WAIT_V(6); PG8_BAR; PG8_MMA(1, 1, At, B1); PG8_BAR;
            }
        }
        if constexpr (ALIGN_EPI) { if (wr == 0) PG8_BAR; }
        if constexpr (FP8) asm volatile("s_nop 15\n\ts_nop 15" ::: "memory");
        E(acc, cur, ui, wr, wc, fr, fq);
        if (!has_next) break;
#pragma unroll
        for (int a = 0; a < 2; ++a)
#pragma unroll
            for (int b = 0; b < 2; ++b)
#pragma unroll
                for (int m = 0; m < 4; ++m)
#pragma unroll
                    for (int n = 0; n < 2; ++n) acc[a][b][m][n] = (f32x4){0.f, 0.f, 0.f, 0.f};
        cur = nxt; cA = nA; cB = nB; chA = nhA; chB = nhB; ++ui;
        if constexpr (ALIGN_EPI) { if (wr == 1) PG8_BAR; }
    }
    PG8_WAIT_V(0);
    if constexpr (!ALIGN_EPI) { if (wr == 0) PG8_BAR; }
    PG8_BAR;
#undef PG8_SA
#undef PG8_SB
#undef PG8_STAGE
#undef PG8_LDA
#undef PG8_LDB
#undef PG8_MMA
#undef PG8_WAIT_V
#undef PG8_WAIT_L
#undef PG8_BAR
#undef PG8_SCHED
#undef PG8_VA
#undef PG8_VB
}
}
using gm::Unit;

struct Params { const float* in[13]; float* out; unsigned char* ws; int ph_lo, ph_hi; };

struct SchedPlain {
    gm::GridOrder o; const char* A; const char* B; unsigned ldA, ldB; bool p16 = false;
    __device__ __forceinline__ bool next(int i, Unit& u) const { int pm, pn; if (!o.mn(i, pm, pn)) return false;
        u.pm = pm; u.pn = pn; u.x0 = 0; u.x1 = 0; u.A = A + (size_t)pm * 256 * ldA; u.hsA = 128u * ldA; u.B = B + (size_t)pn * 256 * ldB; u.hsB = p16 ? 0u : 128u * ldB; return true; }
};
struct SchedG1 {
    gm::GridOrder o; const char* WinT; const char* xb;
    __device__ __forceinline__ bool next(int i, Unit& u) const { int pm, pn; if (!o.mn(i, pm, pn)) return false;
        const int b = pn >> 5, j = pn & 31; u.pm = pm; u.pn = pn; u.x0 = b; u.x1 = j;
        u.A = WinT + (size_t)pm * 256 * 1024; u.hsA = 128u * 1024u; u.B = xb + ((size_t)(b * SEQ + 2 * j)) * 1024; u.hsB = 1024u; return true; }
};
struct SchedS1 {
    int G, c; const char* F1; const char* Ut;
    __device__ __forceinline__ bool next(int i, Unit& u) const { const int L = i * G + c; if (L >= 1024) return false;
        u.pm = 0; u.pn = L; u.x0 = 0; u.x1 = 0; u.A = F1; u.hsA = 128u * 256u; u.B = Ut + (size_t)L * 256 * 256; u.hsB = 128u * 256u; return true; }
};
struct SchedS2 {
    gm::GridOrder o; const char* F2; const char* A1;
    __device__ __forceinline__ bool next(int i, Unit& u) const { int pm, pn; if (!o.mn(i, pm, pn)) return false;
        const int g = pm, b = pn >> 2, ct = pn & 3; u.pm = g; u.pn = ct; u.x0 = b; u.x1 = g;
        u.A = F2 + (size_t)g * 256 * 256; u.hsA = 128u * 256u; u.B = A1 + ((size_t)((b * 64 + g) * 1024 + ct * 256)) * 256; u.hsB = 0u; return true; }
};
__device__ __forceinline__ int expert_of_tile(const LAS int* ts, int pm) {
    const int ln = (int)__builtin_amdgcn_mbcnt_hi(~0u, __builtin_amdgcn_mbcnt_lo(~0u, 0u));
    const int v = ts[ln & 31];
    return (int)__builtin_popcountll(__ballot((ln >= 1) && (ln < 32) && (v <= pm)));
}
struct SchedMoe {
    gm::GridOrder o; const LAS int* ts; const char* A; const char* W; size_t wstride; unsigned ldB; bool hsB128; unsigned tileA;
    __device__ __forceinline__ bool next(int i, Unit& u) const { int pm, pn; if (!o.mn(i, pm, pn)) return false;
        const int e = expert_of_tile(ts, pm);
        u.pm = pm; u.pn = pn; u.x0 = e; u.x1 = pm - ts[e]; u.A = A + (size_t)pm * tileA; u.hsA = tileA >> 1; u.B = W + (size_t)e * wstride + (size_t)pn * 256 * ldB; u.hsB = hsB128 ? 128u * ldB : 0u; return true; }
};

typedef f32x4 Acc[2][2][4][2];
struct EpiRow {
    static constexpr bool PERM = true;
    bf16_t* O; size_t ld; int split_tiles; size_t split_stride; float scale0, scale1;
    __device__ __forceinline__ void operator()(const Acc& acc, const Unit& u, int, int wr, int wc, int fr, int fq) const {
        int pn = u.pn; bf16_t* base = O; float sc = scale0;
        if (split_tiles) { const int t = pn / split_tiles; base += (size_t)t * split_stride; pn -= t * split_tiles; if (t != 0) sc = scale1; }
        const size_t row0 = (size_t)u.pm * 256 + wr * 64 + fr; const int col0 = pn * 256 + wc * 32 + 8 * fq;
#pragma unroll
        for (int ai = 0; ai < 2; ++ai)
#pragma unroll
            for (int m = 0; m < 4; ++m) { bf16_t* rowp = base + (row0 + ai * 128 + m * 16) * ld + col0;
#pragma unroll
                for (int bj = 0; bj < 2; ++bj) *(u32x4*)(rowp + bj * 128) = pack8(acc[ai][bj][m][0] * sc, acc[ai][bj][m][1] * sc); }
    }
};
struct EpiRow8 {
    static constexpr bool PERM = true, PERM16 = true;
    unsigned char* O; size_t ld; int split_tiles; size_t split_stride; float scale0, scale1;
    __device__ __forceinline__ void operator()(const Acc& acc, const Unit& u, int, int wr, int wc, int fr, int fq) const {
        int pn = u.pn; unsigned char* base = O; float sc = scale0;
        if (split_tiles) { const int t = pn / split_tiles; base += (size_t)t * split_stride; pn -= t * split_tiles; if (t != 0) sc = scale1; }
        const size_t row0 = (size_t)u.pm * 256 + wr * 64 + fr; const int col0 = pn * 256 + wc * 64 + 16 * fq;
#pragma unroll
        for (int ai = 0; ai < 2; ++ai)
#pragma unroll
            for (int m = 0; m < 4; ++m) { u32x4 w;
                { const f32x4 v = acc[ai][0][m][0] * sc; w.x = pk4_fp8(v[0], v[1], v[2], v[3]); } { const f32x4 v = acc[ai][0][m][1] * sc; w.y = pk4_fp8(v[0], v[1], v[2], v[3]); }
                { const f32x4 v = acc[ai][1][m][0] * sc; w.z = pk4_fp8(v[0], v[1], v[2], v[3]); } { const f32x4 v = acc[ai][1][m][1] * sc; w.w = pk4_fp8(v[0], v[1], v[2], v[3]); }
                *(u32x4*)(base + (row0 + ai * 128 + m * 16) * ld + col0) = w; }
    }
};
struct EpiG1 {
    static constexpr bool PERM = true;
    bf16_t* Ut; float sc;
    __device__ __forceinline__ void operator()(const Acc& acc, const Unit& u, int, int wr, int wc, int fr, int fq) const {
#pragma unroll
        for (int ai = 0; ai < 2; ++ai)
#pragma unroll
            for (int m = 0; m < 4; ++m) { const int c = u.pm * 256 + ai * 128 + wr * 64 + m * 16 + fr;
#pragma unroll
                for (int bj = 0; bj < 2; ++bj) { const int s2 = 2 * u.x1 + bj;
                    *(u32x4*)(Ut + (((size_t)(u.x0 * 1024 + c) * 64 + s2) * 128 + wc * 32 + 8 * fq)) = pack8(acc[ai][bj][m][0] * sc, acc[ai][bj][m][1] * sc); } }
    }
};
struct EpiS1 {
    static constexpr bool PERM = true;
    bf16_t* A1;
    __device__ __forceinline__ void operator()(const Acc& acc, const Unit& u, int, int wr, int wc, int fr, int fq) const {
#pragma unroll
        for (int m = 0; m < 4; ++m) { const int m1 = wr * 64 + m * 16 + fr, g = m1 >> 1, ri = m1 & 1;
#pragma unroll
            for (int bj = 0; bj < 2; ++bj) { const int nrow = u.pn * 256 + bj * 128 + wc * 32 + 8 * fq, s2 = nrow & 63, c = (nrow >> 6) & 1023, b = nrow >> 16;
                *(u32x4*)(A1 + ((size_t)((b * 64 + g) * 1024 + c) * 128 + ri * 64 + s2)) = pack8(acc[0][bj][m][0], acc[0][bj][m][1]); } }
    }
};
struct EpiS2 {
    static constexpr bool PERM = true, PERM16 = true;
    unsigned char* Y;
    __device__ __forceinline__ void operator()(const Acc& acc, const Unit& u, int, int wr, int wc, int fr, int fq) const {
        const int g = u.x1, b = u.x0;
#pragma unroll
        for (int ai = 0; ai < 2; ++ai)
#pragma unroll
            for (int m = 0; m < 4; ++m) { const int mm = wr * 64 + m * 16 + fr, k2 = mm >> 1, rip = mm & 1;
                const int k1 = ai ? (g ? 128 - g : 64) : g, k = k1 + 128 * k2;
                { const int c = u.pn * 256 + wc * 64 + 16 * fq; u32x4 w;
                    { const f32x4 v = acc[ai][0][m][0] * Y_SCALE; w.x = pk4_fp8(v[0], v[1], v[2], v[3]); } { const f32x4 v = acc[ai][0][m][1] * Y_SCALE; w.y = pk4_fp8(v[0], v[1], v[2], v[3]); }
                    { const f32x4 v = acc[ai][1][m][0] * Y_SCALE; w.z = pk4_fp8(v[0], v[1], v[2], v[3]); } { const f32x4 v = acc[ai][1][m][1] * Y_SCALE; w.w = pk4_fp8(v[0], v[1], v[2], v[3]); }
                    *(u32x4*)(Y + ((size_t)(b * SEQ + k) * 2048 + rip * 1024 + c)) = w; } }
    }
};
struct EpiGU {
    static constexpr bool PERM = true;
    unsigned char* Hb; const LAS int* idxdst;
    __device__ __forceinline__ void operator()(const Acc& acc, const Unit& u, int ui, int wr, int wc, int fr, int fq) const {
#pragma unroll
        for (int ai = 0; ai < 2; ++ai)
#pragma unroll
            for (int m = 0; m < 4; ++m) { const int a = idxdst[ui * 256 + ai * 128 + wr * 64 + m * 16 + fr];
                if (a >= 0) { f32x4 h0, h1;
#pragma unroll
                    for (int j = 0; j < 4; ++j) { h0[j] = silu_mul(acc[ai][0][m][0][j] * (1.0f / W_SCALE), acc[ai][1][m][0][j] * (H_SCALE / W_SCALE)); h1[j] = silu_mul(acc[ai][0][m][1][j] * (1.0f / W_SCALE), acc[ai][1][m][1][j] * (H_SCALE / W_SCALE)); }
                    u32x2 w; w.x = pk4_fp8(h0[0], h0[1], h0[2], h0[3]); w.y = pk4_fp8(h1[0], h1[1], h1[2], h1[3]);
                    *(u32x2*)(Hb + ((size_t)(u.pm * 256 + ai * 128 + wr * 64 + m * 16 + fr) * DEX + u.pn * 128 + wc * 32 + 8 * fq)) = w; } }
    }
};
struct EpiDown {
    static constexpr bool PERM = true, PERM16 = true;
    unsigned char* ys; const LAS int* idxdst;
    __device__ __forceinline__ void operator()(const Acc& acc, const Unit& u, int ui, int wr, int wc, int fr, int fq) const {
#pragma unroll
        for (int ai = 0; ai < 2; ++ai)
#pragma unroll
            for (int m = 0; m < 4; ++m) { const int a = idxdst[ui * 256 + ai * 128 + wr * 64 + m * 16 + fr];
                if (a >= 0) { constexpr float sc = YS_SCALE / (W_SCALE * H_SCALE); u32x4 w;
                    { const f32x4 v = acc[ai][0][m][0] * sc; w.x = pk4_fp8(v[0], v[1], v[2], v[3]); } { const f32x4 v = acc[ai][0][m][1] * sc; w.y = pk4_fp8(v[0], v[1], v[2], v[3]); }
                    { const f32x4 v = acc[ai][1][m][0] * sc; w.z = pk4_fp8(v[0], v[1], v[2], v[3]); } { const f32x4 v = acc[ai][1][m][1] * sc; w.w = pk4_fp8(v[0], v[1], v[2], v[3]); }
                    *(u32x4*)(ys + ((size_t)a * DM + u.pn * 256 + wc * 64 + 16 * fq)) = w; } }
    }
};

constexpr int LDS_P0CTR = 140288;
struct TileDesc { const float* src; unsigned char* dst; int C, r0, c0, dld, kind; };
__device__ __forceinline__ TileDesc tile_desc(const Params& p, int tt) {
    TileDesc d; d.kind = 3; unsigned char* ws = p.ws;
    if (tt < 256) { d.src = p.in[1]; d.C = 1024; d.r0 = (tt >> 5) * 128; d.c0 = (tt & 31) * 32; d.dst = ws + WS_WIN; d.dld = 1024; }
    else if (tt < 1024) { const int t2 = tt - 256; d.src = p.in[3]; d.C = 3072; d.r0 = (t2 / 96) * 128; d.c0 = (t2 % 96) * 32; d.dst = ws + WS_WQKV; d.dld = 1024; }
    else if (tt < 1280) { const int t2 = tt - 1024; d.src = p.in[5]; d.C = 1024; d.r0 = (t2 >> 5) * 128; d.c0 = (t2 & 31) * 32; d.dst = ws + WS_WO; d.dld = 1024; }
    else { const int t3 = tt - 1280, ee = t3 >> 7, tl = t3 & 127, mat = ee & 63; d.kind = ee >> 6;
        if (d.kind < 2) { d.src = (d.kind == 0 ? p.in[8] : p.in[9]) + (size_t)mat * 1024 * 512; d.C = 512; d.r0 = (tl >> 4) * 128; d.c0 = (tl & 15) * 32; d.dst = ws + WS_WGU + (size_t)mat * 1024 * 1024; d.dld = 1024; }
        else { d.src = p.in[10] + (size_t)mat * 512 * 1024; d.C = 1024; d.r0 = (tl >> 5) * 128; d.c0 = (tl & 31) * 32; d.dst = ws + WS_WD + (size_t)mat * 1024 * 512; d.dld = 512; } }
    return d;
}
__device__ __forceinline__ void tile_load(const TileDesc& d, f32x4 (&v)[16], int lane) {
#pragma unroll
    for (int ps = 0; ps < 16; ++ps) v[ps] = __builtin_nontemporal_load((const f32x4*)(d.src + (size_t)(d.r0 + ps * 8 + (lane >> 3)) * d.C + d.c0 + (lane & 7) * 4));
}
__device__ __forceinline__ void tile_store(const TileDesc& d, const f32x4 (&v)[16], LAS float* tile, int lane) {
#pragma unroll
    for (int ps = 0; ps < 16; ++ps) { const int row = ps * 8 + (lane >> 3), col4 = (lane & 7) * 4;
        tile[row * 33 + col4 + 0] = v[ps][0]; tile[row * 33 + col4 + 1] = v[ps][1]; tile[row * 33 + col4 + 2] = v[ps][2]; tile[row * 33 + col4 + 3] = v[ps][3]; }
    __builtin_amdgcn_fence(__ATOMIC_RELEASE, "wavefront"); __builtin_amdgcn_wave_barrier(); __builtin_amdgcn_fence(__ATOMIC_ACQUIRE, "wavefront");
#pragma unroll
    for (int ps = 0; ps < 4; ++ps) { const int n = ps * 8 + (lane >> 3), kc = (lane & 7) * 16; float a[16];
#pragma unroll
        for (int j = 0; j < 16; ++j) a[j] = tile[(kc + j) * 33 + n] * W_SCALE;
        const int nn = d.c0 + n; const int drow = (d.kind == 0 || d.kind == 1) ? (256 * (nn >> 7) + (nn & 127) + 128 * d.kind) : nn;
        u32x4 w; w.x = pk4_fp8(a[0], a[1], a[2], a[3]); w.y = pk4_fp8(a[4], a[5], a[6], a[7]); w.z = pk4_fp8(a[8], a[9], a[10], a[11]); w.w = pk4_fp8(a[12], a[13], a[14], a[15]);
        *(u32x4*)(d.dst + (size_t)drow * d.dld + d.r0 + kc) = w; }
    __builtin_amdgcn_fence(__ATOMIC_RELEASE, "wavefront"); __builtin_amdgcn_wave_barrier(); __builtin_amdgcn_fence(__ATOMIC_ACQUIRE, "wavefront");
}

__device__ __forceinline__ void transpose_share(const Params& p, LAS unsigned char* lds, int wid, int lane) {
    LAS float* tile = (LAS float*)lds + wid * (128 * 33); constexpr int NT = 1280 + 192 * 128; const int G = gridDim.x, per = (NT + G - 1) / G;
    const int lo = (int)blockIdx.x * per, hi = lo + per < NT ? lo + per : NT; LAS unsigned* ctr = (LAS unsigned*)(lds + LDS_P0CTR);
    for (;;) { unsigned g = 0u; if (lane == 0) g = __hip_atomic_fetch_add(ctr, 2u, __ATOMIC_RELAXED, __HIP_MEMORY_SCOPE_WORKGROUP);
        const int t0 = lo + (int)__builtin_amdgcn_readfirstlane(g); if (t0 >= hi) break;
        const bool two = t0 + 1 < hi; const TileDesc d0 = tile_desc(p, t0), d1 = tile_desc(p, two ? t0 + 1 : t0);
        f32x4 v0[16], v1[16]; tile_load(d0, v0, lane); tile_load(d1, v1, lane);
        tile_store(d0, v0, tile, lane); if (two) tile_store(d1, v1, tile, lane); }
}
__device__ __forceinline__ void phase_prologue(const Params& p, LAS unsigned char* lds) {
    const int tid = tid_fresh(), lane = tid & 63, wid = __builtin_amdgcn_readfirstlane(tid >> 6); unsigned char* ws = p.ws;
    if (tid == 0) *(LAS unsigned*)(lds + LDS_P0CTR) = 0u;
    __syncthreads();
    if (wid < 6) {
        { const float* x = p.in[0]; unsigned char* xb = (unsigned char*)(ws + WS_S0); bf16_t* xh = (bf16_t*)p.out; const size_t stride = (size_t)gridDim.x * 384 * 8, total = (size_t)T * DM;
          for (size_t i = ((size_t)blockIdx.x * 384 + tid) * 8; i < total; i += 4 * stride) {
              f32x4 a[4], b[4];
#pragma unroll
              for (int u = 0; u < 4; ++u) { const size_t o = i + u * stride < total ? i + u * stride : i; a[u] = __builtin_nontemporal_load((const f32x4*)(x + o)); b[u] = __builtin_nontemporal_load((const f32x4*)(x + o + 4)); }
#pragma unroll
              for (int u = 0; u < 4; ++u) if (i + u * stride < total) { u32x2 w; w.x = pk4_fp8(a[u][0], a[u][1], a[u][2], a[u][3]); w.y = pk4_fp8(b[u][0], b[u][1], b[u][2], b[u][3]); *(u32x2*)(xb + i + u * stride) = w;
                  *(u32x4*)(xh + i + u * stride) = pack8(a[u], b[u]); } } }
        transpose_share(p, lds, wid, lane);
    } else {
        const int gw = blockIdx.x * 2 + (wid - 6), gl = gw * 64 + lane;
        { bf16_t* F1 = (bf16_t*)(ws + WS_F1); bf16_t* F2 = (bf16_t*)(ws + WS_F2);
          { const int idx = gl; const int m1 = idx >> 7, s1 = idx & 127; float v = 0.f;
            if (m1 < 128) { const int g = m1 >> 1, ri = m1 & 1;
                if (g == 0) v = ri ? ((s1 & 1) ? -1.f : 1.f) : 1.f;
                else { const float ph = (float)((s1 * g) & 127) * (1.0f / 128.0f); v = ri ? -__builtin_amdgcn_sinf(ph) : __builtin_amdgcn_cosf(ph); } }
            F1[idx] = (bf16_t)(cvt_pk_bf16(v, 0.f) & 0xffffu); }
          const float sc = 0.011048543456039806f;
          for (int idx = gl; idx < 64 * 256 * 128; idx += 32768) { const int g = idx >> 15, m2 = (idx >> 7) & 255, kk = idx & 127;
              const int hsel = m2 >> 7, k2 = (m2 & 127) >> 1, rip = m2 & 1, slot = kk >> 6, s2 = kk & 63;
              const int k1 = hsel ? (g ? 128 - g : 64) : g, k = k1 + 128 * k2;
              const float ph = (float)((s2 * k) & 8191) * (1.0f / 8192.0f); const float cs = __builtin_amdgcn_cosf(ph), sn = __builtin_amdgcn_sinf(ph);
              float v;
              if (g == 0) { v = (slot == hsel) ? (rip ? -sn : cs) : 0.f; }
              else if (hsel == 0) { v = rip ? (slot ? cs : -sn) : (slot ? sn : cs); }
              else { v = rip ? (slot ? -cs : -sn) : (slot ? -sn : cs); }
              F2[idx] = (bf16_t)(cvt_pk_bf16(v * sc, 0.f) & 0xffffu); } }
        { const float* wout = p.in[2]; unsigned char* W2 = (unsigned char*)(ws + WS_W2); LAS unsigned char* bt = lds + wid * 16896; const int r8 = lane >> 3, c4 = (lane & 7) * 4, fr = lane & 15, fq = lane >> 4;
#pragma unroll 1
          for (int item = gw; item < 512; item += 2 * (int)gridDim.x) { const int gp = item >> 7, n0 = ((item >> 2) & 31) * 32, cq = item & 3;
              const float* wsrc = wout + (size_t)(gp * 256 + 32 * r8) * 1024 + n0 + c4;
#pragma unroll
              for (int half = 0; half < 2; ++half) { f32x4 wv[16];
#pragma unroll
                  for (int it = 0; it < 16; ++it) wv[it] = *(const f32x4*)(wsrc + (size_t)(half * 16 + it) * 1024);
#pragma unroll
                  for (int j = 0; j < 4; ++j)
#pragma unroll
                      for (int q = 0; q < 2; ++q) { u32x4 w; w.x = cvt_pk_bf16(wv[8 * q][j], wv[8 * q + 1][j]); w.y = cvt_pk_bf16(wv[8 * q + 2][j], wv[8 * q + 3][j]); w.z = cvt_pk_bf16(wv[8 * q + 4][j], wv[8 * q + 5][j]); w.w = cvt_pk_bf16(wv[8 * q + 6][j], wv[8 * q + 7][j]);
                          *(LAS u32x4*)(bt + (c4 + j) * 528 + (32 * r8 + half * 16 + 8 * q) * 2) = w; } }
              __builtin_amdgcn_fence(__ATOMIC_RELEASE, "wavefront"); __builtin_amdgcn_wave_barrier(); __builtin_amdgcn_fence(__ATOMIC_ACQUIRE, "wavefront");
              f32x4 acc[4][2][2];
#pragma unroll
              for (int ct = 0; ct < 4; ++ct)
#pragma unroll
                  for (int tr = 0; tr < 2; ++tr) { acc[ct][tr][0] = (f32x4){0.f, 0.f, 0.f, 0.f}; acc[ct][tr][1] = (f32x4){0.f, 0.f, 0.f, 0.f}; }
#pragma unroll 2
              for (int ks = 0; ks < 8; ++ks) { bf16x8 bf[2];
#pragma unroll
                  for (int nt = 0; nt < 2; ++nt) bf[nt] = *(const LAS bf16x8*)(bt + (nt * 16 + fr) * 528 + (ks * 32 + 8 * fq) * 2);
#pragma unroll
                  for (int ct = 0; ct < 4; ++ct) { const int c = cq * 64 + ct * 16 + fr; u32x4 ca, sa;
#pragma unroll
                      for (int e2 = 0; e2 < 4; ++e2) { const int k2a = ks * 32 + 8 * fq + 2 * e2; const float ph0 = (float)((c * k2a) & 255) * (1.0f / 256.0f), ph1 = (float)((c * (k2a + 1)) & 255) * (1.0f / 256.0f);
                          ca[e2] = cvt_pk_bf16_t(__builtin_amdgcn_cosf(ph0), __builtin_amdgcn_cosf(ph1)); sa[e2] = cvt_pk_bf16_t(__builtin_amdgcn_sinf(ph0), __builtin_amdgcn_sinf(ph1)); }
#pragma unroll
                      for (int nt = 0; nt < 2; ++nt) { acc[ct][0][nt] = __builtin_amdgcn_mfma_f32_16x16x32_bf16(__builtin_bit_cast(bf16x8, ca), bf[nt], acc[ct][0][nt], 0, 0, 0);
                          acc[ct][1][nt] = __builtin_amdgcn_mfma_f32_16x16x32_bf16(__builtin_bit_cast(bf16x8, sa), bf[nt], acc[ct][1][nt], 0, 0, 0); } } }
#pragma unroll
              for (int ct = 0; ct < 4; ++ct)
#pragma unroll
                  for (int tr = 0; tr < 2; ++tr)
#pragma unroll
                      for (int nt = 0; nt < 2; ++nt) { const f32x4 v = acc[ct][tr][nt] * (0.0625f * W2_SCALE); const int n = n0 + nt * 16 + fr, c = cq * 64 + ct * 16 + 4 * fq;
                          *(unsigned*)(W2 + (size_t)n * 2048 + tr * 1024 + gp * 256 + c) = pk4_fp8(v[0], v[1], v[2], v[3]); }
              __builtin_amdgcn_fence(__ATOMIC_RELEASE, "wavefront"); __builtin_amdgcn_wave_barrier(); __builtin_amdgcn_fence(__ATOMIC_ACQUIRE, "wavefront"); } }
        transpose_share(p, lds, wid, lane);
    }
    __syncthreads();
}

typedef _Float16 f16x8 __attribute__((ext_vector_type(8)));
typedef _Float16 f16x4 __attribute__((ext_vector_type(4)));
constexpr int LA_HT = 0, LA_RED = 65536, LA_SEL = 65536 + 32768, LA_ASG = LA_SEL + 8192, LA_MISC = LA_ASG + 1024;
__device__ __forceinline__ void phase_lnA(const Params& p, LAS unsigned char* lds, const int L, const bf16_t* res16, const bf16_t* ybuf, bf16_t* hb, unsigned char* h8) {
    const int tid = tid_fresh(), lane = tid & 63, wid = __builtin_amdgcn_readfirstlane(tid >> 6), fr = lane & 15, fq = lane >> 4;
    unsigned char* ws = p.ws;
    LAS unsigned char* ht = lds + LA_HT;
    LAS float* red = (LAS float*)(lds + LA_RED);
    LAS float* selL = (LAS float*)(lds + LA_SEL);
    LAS int* asgE = (LAS int*)(lds + LA_ASG);
    LAS int* misc = (LAS int*)(lds + LA_MISC);
    f16x8 wf[2][4];
    { const float* wrg = p.in[6];
#pragma unroll
      for (int eb = 0; eb < 2; ++eb)
#pragma unroll
          for (int sx = 0; sx < 4; ++sx)
#pragma unroll
              for (int j = 0; j < 8; ++j) wf[eb][sx][j] = (_Float16)wrg[(size_t)(128 * wid + 32 * sx + 8 * fq + j) * 32 + fr + 16 * eb]; }
    const float* lg = p.in[11] + (L * 2 + 0) * 1024; const float* lb = p.in[12] + (L * 2 + 0) * 1024;
    f32x4 gv[4], bv[4];
#pragma unroll
    for (int k = 0; k < 4; ++k) { gv[k] = *(const f32x4*)(lg + 512 * (k >> 1) + 8 * lane + 4 * (k & 1)); bv[k] = *(const f32x4*)(lb + 512 * (k >> 1) + 8 * lane + 4 * (k & 1)); }
    const float br = p.in[7][tid & 31];
    float* gates = (float*)(ws + WS_GATE);
    const int tok0 = blockIdx.x * 128;
#ifndef LNA_REP
#define LNA_REP 1
#endif
    u32x4 rx16[4][2], ryw[4][2];
#define LA_LOAD(gg) do { _Pragma("unroll") for (int tk = 0; tk < 4; ++tk) { const size_t rowo_ = (size_t)(tok0 + (gg) * 32 + 4 * wid + tk) * DM; _Pragma("unroll") for (int jj = 0; jj < 2; ++jj) { const size_t co_ = rowo_ + 512 * jj + 8 * lane; \
        rx16[tk][jj] = *(const u32x4*)(res16 + co_); ryw[tk][jj] = *(const u32x4*)(ybuf + co_); } } } while (0)
    LA_LOAD(0);
#pragma unroll 1
    for (int g_ = 0; g_ < 4 * LNA_REP; ++g_) { const int g = g_ & 3;
        f32x4 hv[4][4];
#pragma unroll
        for (int tk = 0; tk < 4; ++tk) {
#pragma unroll
            for (int jj = 0; jj < 2; ++jj) { f32x4 xa, xb2, ya, yb; bf8_to_f32(rx16[tk][jj], xa, xb2); bf8_to_f32(ryw[tk][jj], ya, yb);
                hv[tk][2 * jj] = ALPHA * xa + ya; hv[tk][2 * jj + 1] = ALPHA * xb2 + yb; } }
        float sm[4], qv[4];
#pragma unroll
        for (int tk = 0; tk < 4; ++tk) { float s = 0.f;
#pragma unroll
            for (int j = 0; j < 4; ++j) s += (hv[tk][j][0] + hv[tk][j][1]) + (hv[tk][j][2] + hv[tk][j][3]);
            sm[tk] = s; }
#pragma unroll
        for (int o = 32; o >= 1; o >>= 1) {
#pragma unroll
            for (int tk = 0; tk < 4; ++tk) sm[tk] += __shfl_xor(sm[tk], o); }
#pragma unroll
        for (int tk = 0; tk < 4; ++tk) { sm[tk] *= (1.0f / 1024.0f); float q = 0.f;
#pragma unroll
            for (int j = 0; j < 4; ++j) { const f32x4 d = hv[tk][j] - sm[tk]; q += (d[0] * d[0] + d[1] * d[1]) + (d[2] * d[2] + d[3] * d[3]); }
            qv[tk] = q; }
#pragma unroll
        for (int o = 32; o >= 1; o >>= 1) {
#pragma unroll
            for (int tk = 0; tk < 4; ++tk) qv[tk] += __shfl_xor(qv[tk], o); }
#pragma unroll
        for (int tk = 0; tk < 4; ++tk) { const int ts = 4 * wid + tk; const size_t rowo = (size_t)(tok0 + g * 32 + ts) * DM; const float rstd = 1.0f / sqrtf(qv[tk] * (1.0f / 1024.0f) + LN_EPS);
#pragma unroll
            for (int jj = 0; jj < 2; ++jj) { const size_t co = rowo + 512 * jj + 8 * lane;
                const f32x4 h0 = (hv[tk][2 * jj] - sm[tk]) * rstd * gv[2 * jj] + bv[2 * jj], h1 = (hv[tk][2 * jj + 1] - sm[tk]) * rstd * gv[2 * jj + 1] + bv[2 * jj + 1];
                *(u32x4*)(hb + co) = pack8(h0, h1);
                u32x2 w8; w8.x = pk4_fp8(h0[0], h0[1], h0[2], h0[3]); w8.y = pk4_fp8(h1[0], h1[1], h1[2], h1[3]); *(u32x2*)(h8 + co) = w8;
                const f16x8 hh = (f16x8){(_Float16)h0[0], (_Float16)h0[1], (_Float16)h0[2], (_Float16)h0[3], (_Float16)h1[0], (_Float16)h1[1], (_Float16)h1[2], (_Float16)h1[3]};
                const int chunk = (64 * jj + lane) ^ (ts & 15);
                *(LAS f16x8*)(ht + ts * 2048 + chunk * 16) = hh; } }
        if (g_ + 1 < 4 * LNA_REP) LA_LOAD((g_ + 1) & 3);
        __syncthreads();
#pragma unroll
        for (int tb = 0; tb < 2; ++tb) { f32x4 d0 = (f32x4){0.f, 0.f, 0.f, 0.f}, d1 = d0;
#pragma unroll
          for (int sx = 0; sx < 4; ++sx) { const int chunk = (16 * wid + 4 * sx + fq) ^ fr; const f16x8 hf = *(const LAS f16x8*)(ht + (16 * tb + fr) * 2048 + chunk * 16);
              d0 = __builtin_amdgcn_mfma_f32_16x16x32_f16(wf[0][sx], hf, d0, 0, 0, 0); d1 = __builtin_amdgcn_mfma_f32_16x16x32_f16(wf[1][sx], hf, d1, 0, 0, 0); }
          *(LAS f32x4*)(red + wid * 1024 + (16 * tb + fr) * 32 + 4 * fq) = d0; *(LAS f32x4*)(red + wid * 1024 + (16 * tb + fr) * 32 + 16 + 4 * fq) = d1; }
        __syncthreads();
#pragma unroll
        for (int u = 0; u < 2; ++u) { const int ix = tid + 512 * u; float lgt = 0.f;
#pragma unroll
          for (int w = 0; w < 8; ++w) lgt += red[w * 1024 + ix];
          const float sc = 1.0f / (1.0f + __expf(-lgt)); selL[ix] = sc + br; selL[1024 + ix] = sc; }
        __syncthreads();
        if (lane < 4) { const int tq = 4 * wid + lane; const LAS f32x4* sel4 = (const LAS f32x4*)(selL + tq * 32); float best = -3.0e38f; int bg = 0, b1 = 0, b2 = 0;
            f32x4 sv[8];
#pragma unroll
            for (int q = 0; q < 8; ++q) sv[q] = sel4[q];
#pragma unroll
            for (int gg = 0; gg < 4; ++gg) { float m1 = -3.0e38f, m2 = -3.0e38f; int i1 = 0, i2 = 0;
#pragma unroll
                for (int j = 0; j < 8; ++j) { const float v = sv[gg * 2 + (j >> 2)][j & 3]; const bool gt1 = v > m1, gt2 = v > m2;
                    m2 = gt1 ? m1 : (gt2 ? v : m2); i2 = gt1 ? i1 : (gt2 ? j : i2); m1 = gt1 ? v : m1; i1 = gt1 ? j : i1; }
                const float gs = m1 + m2; if (gs > best) { best = gs; bg = gg; b1 = i1; b2 = i2; } }
            const int e1 = bg * 8 + b1, e2 = bg * 8 + b2; const float s1 = selL[1024 + tq * 32 + e1], s2 = selL[1024 + tq * 32 + e2], inv = 1.0f / (s1 + s2);
            const int tl = g * 32 + tq; asgE[2 * tl] = e1; asgE[2 * tl + 1] = e2;
            const int t = tok0 + tl; gates[2 * t] = s1 * inv; gates[2 * t + 1] = s2 * inv; }
    }
    __syncthreads();
#undef LA_LOAD
    int my_e = 0, my_rank = 0; LAS int* cntW = misc + 32;
    if (tid < 256) { my_e = asgE[tid]; unsigned long long mym = 0ull; int cw = 0;
#pragma unroll
        for (int e = 0; e < 32; ++e) { const unsigned long long m = __ballot(my_e == e); if (my_e == e) mym = m; if (lane == e) cw = (int)__builtin_popcountll(m); }
        my_rank = (int)__builtin_popcountll(mym & ((1ull << lane) - 1ull));
        if (lane < 32) cntW[wid * 32 + lane] = cw; }
    __syncthreads();
    if (tid < 256) { for (int w = 0; w < 3; ++w) if (w < wid) my_rank += cntW[w * 32 + my_e]; }
    if (tid < 32) { const int c = cntW[tid] + cntW[32 + tid] + cntW[64 + tid] + cntW[96 + tid];
        unsigned* cnt = (unsigned*)(ws + WS_CTL) + CNT_WORD0 + (L * 32 + tid) * 64;
        misc[tid] = (int)__hip_atomic_fetch_add(cnt, (unsigned)c, __ATOMIC_RELAXED, __HIP_MEMORY_SCOPE_AGENT); }
    __syncthreads();
    if (tid < 256) { int* list = (int*)(ws + WS_LIST); list[(size_t)my_e * NASG + misc[my_e] + my_rank] = blockIdx.x * 256 + tid; }
    __syncthreads();
}

__device__ __forceinline__ void phase_lnB(const Params& p, const int L, const bf16_t* hb, const unsigned char* ys, bf16_t* xb_out, unsigned char* x8_out, float* f_out) {
    const int tid = tid_fresh(), lane = tid & 63, wid = tid >> 6;
    const float* lg = p.in[11] + (L * 2 + 1) * 1024; const float* lb = p.in[12] + (L * 2 + 1) * 1024;
    const float* gates = (const float*)(p.ws + WS_GATE);
    f32x4 gv[4], bv[4];
#pragma unroll
    for (int k = 0; k < 4; ++k) { gv[k] = *(const f32x4*)(lg + 512 * (k >> 1) + 8 * lane + 4 * (k & 1)); bv[k] = *(const f32x4*)(lb + 512 * (k >> 1) + 8 * lane + 4 * (k & 1)); }
    const int tok0 = blockIdx.x * 128 + wid * 16;
    u32x4 rh[2][2]; u32x2 ry0[2][2], ry1[2][2]; f32x2 rg[2];
#define LB_LOAD(tt) do { _Pragma("unroll") for (int u_ = 0; u_ < 2; ++u_) { const int t_ = (tt) + u_; const size_t ro_ = (size_t)t_ * DM; rg[u_] = *(const f32x2*)(gates + 2 * t_); _Pragma("unroll") for (int jj = 0; jj < 2; ++jj) { \
        const size_t co_ = 512 * jj + 8 * lane; rh[u_][jj] = *(const u32x4*)(hb + ro_ + co_); ry0[u_][jj] = *(const u32x2*)(ys + (size_t)(2 * t_) * DM + co_); ry1[u_][jj] = *(const u32x2*)(ys + (size_t)(2 * t_ + 1) * DM + co_); } } } while (0)
    LB_LOAD(tok0);
#pragma unroll 1
    for (int it = 0; it < 8; ++it) {
        u32x4 ch[2][2]; u32x2 cy0[2][2], cy1[2][2]; f32x2 cg[2];
#pragma unroll
        for (int u = 0; u < 2; ++u) { cg[u] = rg[u];
#pragma unroll
            for (int jj = 0; jj < 2; ++jj) { ch[u][jj] = rh[u][jj]; cy0[u][jj] = ry0[u][jj]; cy1[u][jj] = ry1[u][jj]; } }
        if (it < 7) LB_LOAD(tok0 + 2 * it + 2);
#pragma unroll
        for (int u = 0; u < 2; ++u) { const int t = tok0 + 2 * it + u; const size_t rowo = (size_t)t * DM; const float g0 = cg[u].x * (1.0f / YS_SCALE), g1 = cg[u].y * (1.0f / YS_SCALE);
            f32x4 v[4]; float s = 0.f;
#pragma unroll
            for (int jj = 0; jj < 2; ++jj) { f32x4 ha, hb2; bf8_to_f32(ch[u][jj], ha, hb2);
                const f32x4 ya = fp8x4_to_f32(cy0[u][jj].x), yb = fp8x4_to_f32(cy0[u][jj].y), za = fp8x4_to_f32(cy1[u][jj].x), zb = fp8x4_to_f32(cy1[u][jj].y);
                const f32x4 w0 = ALPHA * ha + g0 * ya + g1 * za, w1 = ALPHA * hb2 + g0 * yb + g1 * zb;
                v[2 * jj] = w0; v[2 * jj + 1] = w1; s += ((w0[0] + w0[1]) + (w0[2] + w0[3])) + ((w1[0] + w1[1]) + (w1[2] + w1[3])); }
            const float mean = wave_sum(s) * (1.0f / 1024.0f); float q = 0.f;
#pragma unroll
            for (int k = 0; k < 4; ++k) { const f32x4 d = v[k] - mean; q += (d[0] * d[0] + d[1] * d[1]) + (d[2] * d[2] + d[3] * d[3]); }
            const float rstd = 1.0f / sqrtf(wave_sum(q) * (1.0f / 1024.0f) + LN_EPS);
#pragma unroll
            for (int jj = 0; jj < 2; ++jj) { const size_t co = 512 * jj + 8 * lane;
                const f32x4 o0 = (v[2 * jj] - mean) * rstd * gv[2 * jj] + bv[2 * jj], o1 = (v[2 * jj + 1] - mean) * rstd * gv[2 * jj + 1] + bv[2 * jj + 1];
                if (f_out) { *(f32x4*)(f_out + rowo + co) = o0; *(f32x4*)(f_out + rowo + co + 4) = o1; }
                if (xb_out) { *(u32x4*)(xb_out + rowo + co) = pack8(o0, o1);
                    u32x2 w8; w8.x = pk4_fp8(o0[0], o0[1], o0[2], o0[3]); w8.y = pk4_fp8(o1[0], o1[1], o1[2], o1[3]); *(u32x2*)(x8_out + rowo + co) = w8; } } }
    }
#undef LB_LOAD
}

__device__ __forceinline__ void glds4(const char* sbase, unsigned voff, unsigned lds_dst) {
    unsigned keep;
    asm volatile("s_mov_b32 %0, m0\n\ts_mov_b32 m0, %3\n\ts_nop 0\n\tglobal_load_lds_dword %1, %2\n\ts_mov_b32 m0, %0" : "=&s"(keep) : "v"(voff), "s"(sbase), "s"(lds_dst) : "memory");
}
constexpr int A8_K = 0, A8_V = 81920, A8_RP = 122880, A8_KBUF = 40960;
__device__ __forceinline__ long mk64(unsigned lo, unsigned hi) { return (long)(((unsigned long long)hi << 32) | (unsigned long long)lo); }
__device__ __forceinline__ void phase_attn(const Params& p, LAS unsigned char* lds, const unsigned char* q8, const unsigned char* k8, const unsigned char* vt8, unsigned char* ob) {
    const int tid = tid_fresh(), lane = tid & 63, wid = __builtin_amdgcn_readfirstlane(tid >> 6), fr = lane & 15, fq = lane >> 4;
    const unsigned lds0 = (unsigned)(__UINTPTR_TYPE__)lds;
    const int item = (gridDim.x == 256) ? (int)((blockIdx.x & 7) * 32 + (blockIdx.x >> 3)) : (int)blockIdx.x, b = item >> 6, r0 = (item & 63) * 2;
    const int rsU = min(max(r0 - 4, 0), 118);
    const int r = r0 + (wid >> 2), jq = wid & 3;
    const int rs = min(max(r - 4, 0), 120), c0 = min(max(16 * jq - 8, 0), 32), lrow0 = rs - rsU;
    unsigned offK; { const int tokl = tid >> 2, pc = tid & 3, lc = pc ^ ((tokl >> 2) & 3); offK = (unsigned)(tokl * DM + lc * 16); }
    unsigned offV[5];
#pragma unroll
    for (int k = 0; k < 5; ++k) { const int q = k * 512 + tid, d = q / 40, pc = q - d * 40, lc = pc ^ (d & 7); offV[k] = (unsigned)(d * T + lc * 16); }
    const unsigned offR = (unsigned)min(wid * 64 + lane, 464) * 4u;
    const char* kbase0 = (const char*)k8 + ((size_t)(b * SEQ + rsU * 64) * DM);
    const char* vbase0 = (const char*)vt8 + ((size_t)(b * SEQ + rsU * 64));
    const char* rbase0 = (const char*)p.in[4];
    const size_t tokq = (size_t)b * SEQ + r * 64 + 16 * jq + fr;
    const char* qrow = (const char*)q8 + tokq * DM + 8 * fq;
#define AT_ISSUE_A(h, buf) do { const char* kb_ = kbase0 + (h) * 64; _Pragma("unroll") for (int k = 0; k < 5; ++k) gm::glds16(kb_ + (size_t)k * 131072, offK, lds0 + A8_K + (buf) * A8_KBUF + k * 8192 + wid * 1024); \
        glds4(rbase0 + (h) * 1860, offR, lds0 + A8_RP + (buf) * 2048 + wid * 256); } while (0)
#define AT_ISSUE_B(h) do { const char* vb_ = vbase0 + (size_t)(h) * 64 * T; _Pragma("unroll") for (int k = 0; k < 5; ++k) gm::glds16(vb_, offV[k], lds0 + A8_V + k * 8192 + wid * 1024); } while (0)
#define AT_LDQ(h, q0, q1) do { asm volatile("global_load_dwordx2 %0, %2, off\n\tglobal_load_dwordx2 %1, %2, off offset:32" : "=&v"(q0), "=&v"(q1) : "v"(qrow + (h) * 64) : "memory"); } while (0)
    const int swzk = ((c0 >> 2) + (fr >> 2)) & 3;
    const int kofs0 = (lrow0 * 64 + c0 + fr) * 64 + ((((fq >> 1) ^ swzk)) << 4) + (fq & 1) * 8, kofs1 = (lrow0 * 64 + c0 + fr) * 64 + (((((fq >> 1) ^ swzk)) ^ 2) << 4) + (fq & 1) * 8;
    int vo[8][2];
#pragma unroll
    for (int i = 0; i < 8; ++i)
#pragma unroll
        for (int hf = 0; hf < 2; ++hf) { const int tokoff = (lrow0 + i) * 64 + c0 + 4 * fq + 16 * hf; vo[i][hf] = fr * 640 + (((tokoff >> 4) ^ (fr & 7)) << 4) + (tokoff & 15); }
    const int qc = 16 * jq + fr, cs = min(max(qc - 8, 0), 48);
    long qn0, qn1;
    AT_LDQ(0, qn0, qn1);
    AT_ISSUE_A(0, 0); AT_ISSUE_B(0);
#pragma unroll 1
    for (int h = 0; h < 16; ++h) {
        const int hn = h < 15 ? h + 1 : 15, kb = h & 1;
        asm volatile("s_waitcnt vmcnt(5)" : "+v"(qn0), "+v"(qn1) :: "memory");
        const long q0 = qn0, q1 = qn1;
        __builtin_amdgcn_s_barrier();
        AT_LDQ(hn, qn0, qn1);
        AT_ISSUE_A(hn, kb ^ 1);
        f32x4 s[16];
#pragma unroll
        for (int kbi = 0; kbi < 16; ++kbi) { const int i = kbi >> 1, half = kbi & 1;
            const long k0 = *(const LAS long*)(lds + A8_K + kb * A8_KBUF + kofs0 + i * 4096 + half * 1024), k1 = *(const LAS long*)(lds + A8_K + kb * A8_KBUF + kofs1 + i * 4096 + half * 1024);
            f32x4 a = (f32x4){0.f, 0.f, 0.f, 0.f};
            a = __builtin_amdgcn_mfma_f32_16x16x32_fp8_fp8(k0, q0, a, 0, 0, 0); a = __builtin_amdgcn_mfma_f32_16x16x32_fp8_fp8(k1, q1, a, 0, 0, 0); s[kbi] = a; }
        const LAS float* rp = (const LAS float*)(lds + A8_RP + kb * 2048);
        float mx = -3.0e38f; const int thr = cs - c0;
#pragma unroll
        for (int i = 0; i < 8; ++i) { const int ri = rs + i - r + 7;
#pragma unroll
            for (int j = 0; j < 4; ++j) { const int pos = 4 * fq + j; const bool sel0 = pos >= thr; const int ci = min(max(c0 + pos - qc + 15 + (sel0 ? 0 : 16), 0), 30);
                float bvv = rp[ri * 31 + ci]; asm volatile("" : "+v"(bvv)); const float v = (sel0 ? s[2 * i][j] : s[2 * i + 1][j]) * 0.125f + bvv; s[2 * i][j] = v; mx = fmaxf(mx, v); } }
        mx = fmaxf(mx, __shfl_xor(mx, 16)); mx = fmaxf(mx, __shfl_xor(mx, 32));
        const float mxp = mx - 4.1588830833596715f;
        float sum = 0.f;
#pragma unroll
        for (int i = 0; i < 8; ++i)
#pragma unroll
            for (int j = 0; j < 4; ++j) { const int pos = 4 * fq + j; const bool sel0 = pos >= thr; const float e = __expf(s[2 * i][j] - mxp); sum += e; s[2 * i][j] = sel0 ? e : 0.f; s[2 * i + 1][j] = sel0 ? 0.f : e; }
        sum += __shfl_xor(sum, 16); sum += __shfl_xor(sum, 32);
        asm volatile("s_waitcnt vmcnt(8)" ::: "memory");
        __builtin_amdgcn_s_barrier();
        f32x4 oacc[4];
#pragma unroll
        for (int db = 0; db < 4; ++db) oacc[db] = (f32x4){0.f, 0.f, 0.f, 0.f};
#pragma unroll
        for (int i = 0; i < 8; ++i) { const long pf = mk64(pk4_fp8(s[2 * i][0], s[2 * i][1], s[2 * i][2], s[2 * i][3]), pk4_fp8(s[2 * i + 1][0], s[2 * i + 1][1], s[2 * i + 1][2], s[2 * i + 1][3]));
#pragma unroll
            for (int db = 0; db < 4; ++db) { const unsigned lo = *(const LAS unsigned*)(lds + A8_V + vo[i][0] + db * 10240), hi = *(const LAS unsigned*)(lds + A8_V + vo[i][1] + db * 10240);
                oacc[db] = __builtin_amdgcn_mfma_f32_16x16x32_fp8_fp8(mk64(lo, hi), pf, oacc[db], 0, 0, 0); } }
        asm volatile("s_waitcnt lgkmcnt(0)" ::: "memory");
        __builtin_amdgcn_s_barrier();
        AT_ISSUE_B(hn);
        const float inv = O_SCALE / sum;
#pragma unroll
        for (int db = 0; db < 4; ++db) *(unsigned*)(ob + tokq * DM + h * 64 + 16 * db + 4 * fq) = pk4_fp8(oacc[db][0] * inv, oacc[db][1] * inv, oacc[db][2] * inv, oacc[db][3] * inv);
    }
    asm volatile("s_waitcnt vmcnt(0)" ::: "memory");
    __builtin_amdgcn_s_barrier();
#undef AT_ISSUE_A
#undef AT_ISSUE_B
#undef AT_LDQ
}

template <int SRC_SHIFT>
__device__ __forceinline__ int moe_setup(const Params& p, LAS unsigned char* lds, const int L, LAS int* ts, LAS int* idxsrc, LAS int* idxdst) {
    const int tid = tid_fresh(), lane = tid & 63; unsigned char* ws = p.ws;
    LAS int* cn = ts + 40;
    if (tid < 64) {
        const int c = (int)__hip_atomic_load((unsigned*)(ws + WS_CTL) + CNT_WORD0 + (L * 32 + (lane & 31)) * 64, __ATOMIC_RELAXED, __HIP_MEMORY_SCOPE_AGENT);
        const int nt = (c + 255) >> 8; int incl = nt;
#pragma unroll
        for (int o = 1; o < 32; o <<= 1) { const int up = __shfl_up(incl, o); if ((lane & 31) >= o) incl += up; }
        if (lane < 32) { cn[lane] = c; ts[lane] = incl - nt; if (lane == 31) ts[32] = incl; } }
    __syncthreads();
    const int ntile = ts[NE];
    gm::GridOrder o; o.init(ntile, 4, gridDim.x, blockIdx.x);
    const int* list = (const int*)(ws + WS_LIST);
#pragma unroll
    for (int k = 0; k < 4; ++k) { const int ui = 2 * k + (tid >> 8), r = tid & 255; int pm = 0, pn = 0; const bool ok_u = o.mn(ui, pm, pn);
        const int e = expert_of_tile(ts, ok_u ? pm : 0);
        if (ok_u) { const int j = pm - ts[e], ce = cn[e]; const int pos = j * 256 + r; const bool ok = pos < ce; const int a = list[(size_t)e * NASG + (ok ? pos : j * 256)];
            idxsrc[ui * 256 + r] = a >> SRC_SHIFT; idxdst[ui * 256 + r] = ok ? a : -1; } }
    __syncthreads();
    return ntile;
}

__device__ __forceinline__ bool in_rng(int lo, int hi, int k) { asm volatile("" : "+s"(lo), "+s"(hi)); return lo <= k && k < hi; }
__device__ __forceinline__ Params params_fresh() {
    Params r{};
#if defined(__HIP_DEVICE_COMPILE__)
    auto k = __builtin_amdgcn_kernarg_segment_ptr(); asm volatile("" : "+s"(k));
    const __attribute__((address_space(4))) Params* kp = (const __attribute__((address_space(4))) Params*)k;
#pragma unroll
    for (int i = 0; i < 13; ++i) r.in[i] = kp->in[i];
    r.out = kp->out; r.ws = kp->ws; r.ph_lo = kp->ph_lo; r.ph_hi = kp->ph_hi;
#endif
    return r;
}
__global__ void __launch_bounds__(512, 2) k_fwd(Params p_unused) {
    extern __shared__ __attribute__((aligned(16))) unsigned char lds_raw[];
    LAS unsigned char* lds = (LAS unsigned char*)lds_raw;
    const Params p0 = params_fresh();
    { const int tid = tid_fresh(); if (tid < 4) ((LAS unsigned*)(lds + LDS_BARW))[tid] = 0u; }
    __syncthreads();
    XcdBarrier bar; bar.bar = (unsigned*)(p0.ws + WS_CTL); bar.x = 0; bar.st = nullptr;
    const int lo = p0.ph_lo, hi = p0.ph_hi;
    if (hi - lo > 1) bar = xcd_barrier_post((unsigned*)(p0.ws + WS_CTL), (volatile LAS unsigned*)(lds + LDS_BARW));
#ifndef PHMASK
#define PHMASK 0xffff
#endif
#define IN(k) (((PHMASK >> (k)) & 1) && in_rng(lo, hi, (k)))
#define SEAM(k) do { if (IN((k) + 1)) xcd_barrier(bar); } while (0)
#define PH_PTRS const Params p = params_fresh(); unsigned char* ws = p.ws; const int G = gridDim.x, cb = blockIdx.x; \
    bf16_t* S0 = (bf16_t*)(ws + WS_S0); bf16_t* S1 = (bf16_t*)(ws + WS_S1); bf16_t* S2 = (bf16_t*)(ws + WS_S2); bf16_t* S3 = (bf16_t*)(ws + WS_S3); \
    unsigned char* H8 = (unsigned char*)p.out + 64 * MiB; unsigned char* X8 = (unsigned char*)p.out + 96 * MiB; bf16_t* D0 = (bf16_t*)p.out; (void)X8; \
    LAS int* idxsrc = (LAS int*)(lds + LDS_IDX); LAS int* idxdst = idxsrc + 8 * 256; LAS int* tsm = (LAS int*)(lds + LDS_MISC); \
    (void)G; (void)cb; (void)S0; (void)S1; (void)S2; (void)S3; (void)H8; (void)D0; (void)idxsrc; (void)idxdst; (void)tsm;

    if (IN(0)) { PH_PTRS phase_prologue(p, lds); SEAM(0); }

#pragma unroll 1
    for (int L = 0; L < 2; ++L) {
        const int pb = 7 * L;
        if (L == 0) {
            if (IN(1)) {
                PH_PTRS SchedG1 S; S.o.init(4, 128, G, cb); S.WinT = (const char*)(ws + WS_WIN); S.xb = (const char*)S0; EpiG1 E{S1, 1.0f / W_SCALE};
                gm::gemm_phase<EpiG1, SchedG1, false, true>(lds, 1024, 1024u, 64u * 1024u, S, E, nullptr); SEAM(1); }
            if (IN(2)) {
                PH_PTRS SchedS1 S{G, cb, (const char*)(ws + WS_F1), (const char*)S1}; EpiS1 E{S0};
                gm::gemm_phase<EpiS1, SchedS1, false>(lds, 256, 256u, 256u, S, E, nullptr); SEAM(2); }
            if (IN(3)) {
                PH_PTRS SchedS2 S; S.o.init(64, 16, G, cb); S.F2 = (const char*)(ws + WS_F2); S.A1 = (const char*)S0; EpiS2 E{(unsigned char*)S1};
                gm::gemm_phase<EpiS2, SchedS2, false>(lds, 256, 256u, 256u, S, E, nullptr); SEAM(3); }
        } else {
            if (IN(9)) {
                PH_PTRS
                { SchedPlain S; S.o.init(128, 8, G, cb); S.A = (const char*)X8; S.B = (const char*)(ws + WS_WQKV); S.ldA = 1024u; S.ldB = 1024u; S.p16 = true; EpiRow8 E{(unsigned char*)S1, 1024, 4, (size_t)32 * MiB, 1.0f / W_SCALE, 1.0f / W_SCALE};
                  gm::gemm_phase<EpiRow8, SchedPlain, false, true>(lds, 1024, 1024u, 1024u, S, E, nullptr); }
                { SchedPlain S; S.o.init(4, 128, G, cb); S.A = (const char*)(ws + WS_WQKV) + (size_t)2048 * 1024; S.B = (const char*)X8; S.ldA = 1024u; S.ldB = 1024u; S.p16 = true; EpiRow8 E{(unsigned char*)S3, (size_t)T, 0, 0, 1.0f / W_SCALE, 1.0f / W_SCALE};
                  gm::gemm_phase<EpiRow8, SchedPlain, false, true>(lds, 1024, 1024u, 1024u, S, E, nullptr); }
                SEAM(9); }
            if (IN(10)) { PH_PTRS phase_attn(p, lds, (const unsigned char*)S1, (const unsigned char*)S1 + 32 * MiB, (const unsigned char*)S3, (unsigned char*)S0); SEAM(10); }
        }
        if (L == 0) { if (IN(4)) {
            PH_PTRS SchedPlain S; S.o.init(128, 4, G, cb); S.A = (const char*)S1; S.B = (const char*)(ws + WS_W2); S.ldA = 2048u; S.ldB = 2048u;
            EpiRow E{S0, 1024, 0, 0, 1.0f / (Y_SCALE * W2_SCALE), 1.f};
            gm::gemm_phase<EpiRow, SchedPlain, false, true>(lds, 2048, 2048u, 2048u, S, E, nullptr); SEAM(4); } }
        else { if (IN(11)) {
            PH_PTRS SchedPlain S; S.o.init(128, 4, G, cb); S.A = (const char*)S0; S.B = (const char*)(ws + WS_WO); S.ldA = 1024u; S.ldB = 1024u;
            EpiRow E{S1, 1024, 0, 0, 1.0f / (W_SCALE * O_SCALE), 1.f};
            gm::gemm_phase<EpiRow, SchedPlain, false, true>(lds, 1024, 1024u, 1024u, S, E, nullptr); SEAM(11); } }
        if (IN(5 + pb)) { PH_PTRS phase_lnA(p, lds, L, D0, L == 0 ? S0 : S1, S3, H8); SEAM(5 + pb); }
        if (IN(6 + pb)) {
            PH_PTRS const int ntile = moe_setup<1>(p, lds, L, tsm, idxsrc, idxdst);
            SchedMoe S; S.o.init(ntile, 4, G, cb); S.ts = tsm; S.A = (const char*)H8; S.W = (const char*)(ws + WS_WGU) + (size_t)L * 32 * 1024 * 1024; S.wstride = (size_t)1024 * 1024; S.ldB = 1024u; S.hsB128 = true; S.tileA = 0u;
            EpiGU E{(unsigned char*)S0, idxdst};
            gm::gemm_phase<EpiGU, SchedMoe, true, true>(lds, 1024, 1024u, 1024u, S, E, idxsrc); SEAM(6 + pb); }
        if (IN(7 + pb)) {
            PH_PTRS int ntile; if (IN(6 + pb)) { __syncthreads(); ntile = tsm[NE]; } else ntile = moe_setup<0>(p, lds, L, tsm, idxsrc, idxdst);
            SchedMoe S; S.o.init(ntile, 4, G, cb); S.ts = tsm; S.A = (const char*)S0; S.W = (const char*)(ws + WS_WD) + (size_t)L * 32 * 1024 * 512; S.wstride = (size_t)1024 * 512; S.ldB = 512u; S.hsB128 = false; S.tileA = 256u * 512u;
            EpiDown E{(unsigned char*)S1, idxdst};
            gm::gemm_phase<EpiDown, SchedMoe, false, true>(lds, 512, 512u, 512u, S, E, nullptr); SEAM(7 + pb); }
        if (IN(8 + pb)) { PH_PTRS phase_lnB(p, L, S3, (const unsigned char*)S1, L == 0 ? D0 : nullptr, X8, L == 0 ? nullptr : p.out); if (L == 0) SEAM(8); }
    }
#undef IN
#undef SEAM
#undef PH_PTRS
}

extern "C" void kernel_launch(void* const* d_in, const int* in_sizes, int n_in, void* d_out, int out_size, void* d_ws, size_t ws_size, hipStream_t stream) {
    static int grid = 0;
    if (grid == 0) {
        if (n_in != 13 || in_sizes[0] != T * DM || out_size != T * DM || ws_size < WS_END) { fprintf(stderr, "kernel_launch: unexpected shapes / workspace (%d inputs, in0 %d, out %d, ws %zu < %zu)\n", n_in, n_in > 0 ? in_sizes[0] : -1, out_size, ws_size, (size_t)WS_END); grid = -1; return; }
        int dev = 0, cus = 0, per_cu = 0;
        if (hipGetDevice(&dev) != hipSuccess || hipDeviceGetAttribute(&cus, hipDeviceAttributeMultiprocessorCount, dev) != hipSuccess) { grid = -1; return; }
        if (hipFuncSetAttribute((const void*)k_fwd, hipFuncAttributeMaxDynamicSharedMemorySize, LDS_BYTES) != hipSuccess) { fprintf(stderr, "kernel_launch: hipFuncSetAttribute failed\n"); grid = -1; return; }
        if (hipOccupancyMaxActiveBlocksPerMultiprocessor(&per_cu, (const void*)k_fwd, 512, LDS_BYTES) != hipSuccess || per_cu < 1) fprintf(stderr, "kernel_launch: occupancy query says %d\n", per_cu);
        (void)hipGetLastError();
        grid = cus;
    }
    if (grid < 0) return;
    (void)hipMemsetAsync((char*)d_ws + WS_CTL, 0, CTL_ZERO_BYTES, stream);
    Params a{};
    for (int i = 0; i < 13; ++i) a.in[i] = (const float*)d_in[i];
    a.out = (float*)d_out; a.ws = (unsigned char*)d_ws;
#if MK_N_LAUNCHES == 1
    a.ph_lo = 0; a.ph_hi = NPH;
    hipLaunchKernelGGL(k_fwd, dim3(grid), dim3(512), LDS_BYTES, stream, a);
#else
    for (int k = 0; k < NPH; ++k) { a.ph_lo = k; a.ph_hi = k + 1; const int reps = ((REPMASK >> k) & 1) ? 2 : 1;
        for (int r = 0; r < reps; ++r) hipLaunchKernelGGL(k_fwd, dim3(grid), dim3(512), LDS_BYTES, stream, a); }
#endif
}
```

```cpp
#include <hip/hip_runtime.h>
#include <cstdio>
#include <cstdint>

#ifndef MK_N_LAUNCHES
#define MK_N_LAUNCHES 1
#endif
#ifndef REPMASK
#define REPMASK 0x0
#endif

#define LAS __attribute__((address_space(3)))
typedef unsigned short bf16_t;
typedef short bf16x8 __attribute__((ext_vector_type(8)));
typedef short bf16x4 __attribute__((ext_vector_type(4)));
typedef float f32x4 __attribute__((ext_vector_type(4)));
typedef float f32x2 __attribute__((ext_vector_type(2)));
typedef unsigned u32x4 __attribute__((ext_vector_type(4)));
typedef unsigned u32x2 __attribute__((ext_vector_type(2)));

constexpr int T = 32768, DM = 1024, SEQ = 8192, NBATCH = 4, NE = 32, DEX = 512, NASG = 65536, NPH = 16;
constexpr float ALPHA = 1.41421356237309515f;
constexpr float LN_EPS = 1e-5f;
constexpr size_t MiB = (size_t)1 << 20;
constexpr size_t WS_CTL = 0, WS_GATE = 1 * MiB, WS_LIST = 2 * MiB, WS_WIN = 10 * MiB, WS_W2 = 12 * MiB, WS_F1 = 16 * MiB, WS_F2 = 17 * MiB, WS_WQKV = 21 * MiB, WS_WO = 27 * MiB,
                 WS_WGU = 30 * MiB, WS_WD = 158 * MiB, WS_S0 = 222 * MiB, WS_S1 = 286 * MiB, WS_S2 = 350 * MiB, WS_S3 = 414 * MiB, WS_END = 478 * MiB;
constexpr size_t CTL_ZERO_BYTES = 65536;
constexpr int CNT_WORD0 = 4096;
constexpr int LDS_BYTES = 159760;
constexpr int LDS_IDX = 131072, LDS_MISC = 131072 + 16384, LDS_BARW = LDS_BYTES - 16;

#define XB_TMO      128
#define XB_XCNT(j)  (256  + 64 * (j))
#define XB_XSUB(j)  (1280 + 64 * (j))
#define XB_XGEN(j)  (2304 + 64 * (j))
#define XB_TOP      3328
#define XB_TOPGEN   3392
#define XCD_BAR_WORDS 3456
#define XB_SPIN_CAP (1u << 18)

__device__ __forceinline__ unsigned xb_ld(unsigned* p)              { return __hip_atomic_load(p, __ATOMIC_RELAXED, __HIP_MEMORY_SCOPE_AGENT); }
__device__ __forceinline__ unsigned xb_add(unsigned* p, unsigned v) { return __hip_atomic_fetch_add(p, v, __ATOMIC_RELAXED, __HIP_MEMORY_SCOPE_AGENT); }
__device__ __forceinline__ unsigned xb_xcc_id() { return (unsigned)__builtin_amdgcn_s_getreg((3 << 11) | 20) & 0xFu; }
#define XB_SPIN(cond, bar) do { unsigned _sp = 0; while (cond) { __builtin_amdgcn_s_sleep(1); \
    if ((++_sp & 255u) == 0u) { if (xb_ld(&(bar)[XB_TMO])) break; if (_sp > XB_SPIN_CAP) { atomicAdd(&(bar)[XB_TMO], 1u); break; } } } } while (0)

struct XcdBarrier { unsigned* bar; unsigned x; volatile LAS unsigned* st; };

__device__ __forceinline__ XcdBarrier xcd_barrier_post(unsigned* bar, volatile LAS unsigned* st) {
    XcdBarrier b; b.bar = bar; b.x = xb_xcc_id(); b.st = st;
    if (threadIdx.x == 0) (void)xb_add(&bar[XB_XCNT(b.x)], 1u);
    return b;
}
__device__ __forceinline__ void xcd_barrier_complete(unsigned* bar, unsigned x, unsigned& nloc, unsigned& nx) {
    const unsigned G = gridDim.x * gridDim.y * gridDim.z;
    unsigned sum, cnt, mine, sp = 0u;
    for (;;) {
        sum = 0u; cnt = 0u; mine = 0u;
#pragma unroll
        for (unsigned j = 0; j < 16; ++j) { const unsigned c = xb_ld(&bar[XB_XCNT(j)]); sum += c; cnt += (c > 0u) ? 1u : 0u; mine = (j == x) ? c : mine; }
        if (sum == G) break;
        __builtin_amdgcn_s_sleep(1);
        if ((++sp & 255u) == 0u) { if (xb_ld(&bar[XB_TMO])) break; if (sp > XB_SPIN_CAP) { atomicAdd(&bar[XB_TMO], 1u); break; } }
    }
    nloc = mine > 0u ? mine : 1u; nx = cnt > 0u ? cnt : 1u;
}
__device__ __forceinline__ void xcd_barrier(const XcdBarrier& b) {
    asm volatile("s_waitcnt vmcnt(0)" ::: "memory");
    __syncthreads();
    if (threadIdx.x == 0) {
        unsigned* bar = b.bar;
        __builtin_amdgcn_s_waitcnt(0);
        unsigned nloc = b.st[0], nx = b.st[1];
        if (nloc == 0u) { xcd_barrier_complete(bar, b.x, nloc, nx); b.st[0] = nloc; b.st[1] = nx; }
        const unsigned old = xb_add(&bar[XB_XSUB(b.x)], 1u);
        const unsigned gen = old / nloc;
        if (old + 1u == (gen + 1u) * nloc) {
            __builtin_amdgcn_fence(__ATOMIC_RELEASE, "agent");
            asm volatile("s_waitcnt vmcnt(0)" ::: "memory");
            const unsigned og = xb_add(&bar[XB_TOP], 1u);
            const unsigned tg = og / nx;
            if (og + 1u == (tg + 1u) * nx) xb_add(&bar[XB_TOPGEN], 1u);
            else XB_SPIN(xb_ld(&bar[XB_TOPGEN]) == tg, bar);
            __builtin_amdgcn_fence(__ATOMIC_ACQUIRE, "agent");
            xb_add(&bar[XB_XGEN(b.x)], 1u);
            asm volatile("s_waitcnt vmcnt(0)" ::: "memory");
        } else {
            XB_SPIN(xb_ld(&bar[XB_XGEN(b.x)]) == gen, bar);
            __builtin_amdgcn_fence(__ATOMIC_ACQUIRE, "agent");
            asm volatile("s_waitcnt vmcnt(0)" ::: "memory");
        }
    }
    __syncthreads();
}

__device__ __forceinline__ unsigned cvt_pk_bf16_t(float lo, float hi) { unsigned r; asm volatile("s_nop 0\n\tv_cvt_pk_bf16_f32 %0, %1, %2" : "=v"(r) : "v"(lo), "v"(hi)); return r; }
__device__ __forceinline__ unsigned cvt_pk_bf16(float lo, float hi) { unsigned r; asm volatile("v_cvt_pk_bf16_f32 %0, %1, %2" : "=v"(r) : "v"(lo), "v"(hi)); return r; }
__device__ __forceinline__ float bf_lo(unsigned w) { return __uint_as_float(w << 16); }
__device__ __forceinline__ float bf_hi(unsigned w) { return __uint_as_float(w & 0xffff0000u); }
__device__ __forceinline__ u32x4 pack8(const f32x4 a, const f32x4 b) { u32x4 w; w.x = cvt_pk_bf16(a[0], a[1]); w.y = cvt_pk_bf16(a[2], a[3]); w.z = cvt_pk_bf16(b[0], b[1]); w.w = cvt_pk_bf16(b[2], b[3]); return w; }
__device__ __forceinline__ int tid_fresh() { int t = threadIdx.x; asm volatile("" : "+v"(t)); return t; }
__device__ __forceinline__ void bf8_to_f32(const u32x4 w, f32x4& a, f32x4& b) { a[0] = bf_lo(w.x); a[1] = bf_hi(w.x); a[2] = bf_lo(w.y); a[3] = bf_hi(w.y); b[0] = bf_lo(w.z); b[1] = bf_hi(w.z); b[2] = bf_lo(w.w); b[3] = bf_hi(w.w); }
__device__ __forceinline__ float wave_sum(float v) {
#pragma unroll
    for (int o = 32; o >= 1; o >>= 1) v += __shfl_xor(v, o);
    return v;
}

constexpr float W_SCALE = 64.0f, H_SCALE = 4.0f, O_SCALE = 16.0f, Y_SCALE = 8.0f, W2_SCALE = 256.0f, YS_SCALE = 16.0f;
__device__ __forceinline__ f32x4 fp8x4_to_f32(unsigned w) { f32x4 r; r[0] = __builtin_amdgcn_cvt_f32_fp8(w, 0); r[1] = __builtin_amdgcn_cvt_f32_fp8(w, 1); r[2] = __builtin_amdgcn_cvt_f32_fp8(w, 2); r[3] = __builtin_amdgcn_cvt_f32_fp8(w, 3); return r; }
__device__ __forceinline__ float silu_mul(float g, float up) { return g * __builtin_amdgcn_rcpf(1.0f + __expf(-g)) * up; }
__device__ __forceinline__ unsigned pk4_fp8(float a, float b, float c, float d) { unsigned r = 0; r = __builtin_amdgcn_cvt_pk_fp8_f32(a, b, r, false); r = __builtin_amdgcn_cvt_pk_fp8_f32(c, d, r, true); return r; }
namespace gm {
constexpr int BM = 256, BK = 64, HALF = 128, HTB = HALF * BK * 2, STAGE_BYTES = 8 * HTB, NXCD = 8, WGM = 16;
__device__ __forceinline__ int lds_byte(int r, int c) { const int st = (r >> 4) * 2 + (c >> 5), rr = r & 15, cc = c & 31, ob = rr * 64 + cc * 2; return st * 1024 + (ob ^ (((ob >> 9) & 1) << 5)); }
__device__ __forceinline__ void stage_rc(int b, int& R, int& C) { const int st = b / 1024, sb = b % 1024, swz = sb ^ (((sb >> 9) & 1) << 5); R = (st >> 1) * 16 + swz / 64; C = (st & 1) * 32 + (swz % 64) / 2; }
__device__ __forceinline__ int perm32(int rho) { const int n = rho >> 4, i = rho & 15; return 8 * (i >> 2) + 4 * n + (i & 3); }

__device__ __forceinline__ void glds16(const char* sbase, unsigned voff, unsigned lds_dst) {
    unsigned keep;
    asm volatile("s_mov_b32 %0, m0\n\ts_mov_b32 m0, %3\n\ts_nop 0\n\tglobal_load_lds_dwordx4 %1, %2\n\ts_mov_b32 m0, %0" : "=&s"(keep) : "v"(voff), "s"(sbase), "s"(lds_dst) : "memory");
}
struct Unit { const char* A; const char* B; unsigned hsA, hsB; int pm, pn, x0, x1; };

struct GridOrder {
    int nM, nN, nwg, G, c;
    __device__ __forceinline__ void init(int nM_, int nN_, int G_, int c_) { nM = nM_; nN = nN_; nwg = nM * nN; G = G_; c = c_; }
    __device__ __forceinline__ bool mn(int i, int& pm, int& pn) const {
        const long L = (long)i * G + c; if (L >= nwg) return false;
        int wgid = (int)L; { const int q = nwg / NXCD, r = nwg % NXCD, xcd = wgid % NXCD, off = wgid / NXCD; wgid = (xcd < r ? xcd * (q + 1) : r * (q + 1) + (xcd - r) * q) + off; }
        const int nig = WGM * nN, gid = wgid / nig, fm = gid * WGM, gsz = (nM - fm) < WGM ? (nM - fm) : WGM;
        pm = fm + ((wgid % nig) % gsz); pn = (wgid % nig) / gsz; return true;
    }
};

typedef int i32x4v __attribute__((ext_vector_type(4)));
typedef int i32x8v __attribute__((ext_vector_type(8)));
__device__ __forceinline__ i32x8v cat8(const bf16x8 a, const bf16x8 b) { const i32x4v x = __builtin_bit_cast(i32x4v, a), y = __builtin_bit_cast(i32x4v, b); return (i32x8v){x[0], x[1], x[2], x[3], y[0], y[1], y[2], y[3]}; }
template <class E, class = void> struct epi_perm16 { static constexpr bool value = false; };
template <class E> struct epi_perm16<E, decltype((void)E::PERM16)> { static constexpr bool value = E::PERM16; };
template <class Epi, class Sched, bool GATHER, bool FP8 = false, bool SP2 = true, bool ALIGN_EPI = true>
__device__ __forceinline__ void gemm_phase(LAS unsigned char* lds, const int kbytes, const unsigned ldA, const unsigned ldB, const Sched& S, const Epi& E, const LAS int* idxsrc) {
    const int tid = tid_fresh(), wid = __builtin_amdgcn_readfirstlane(tid >> 6), lane = tid & 63, wr = wid >> 2, wc = wid & 3, fr = lane & 15, fq = lane >> 4;
    int nt = kbytes / (BK * 2); asm volatile("" : "+s"(nt));
    unsigned voffA[2][2], voffBh[2][2];
#pragma unroll
    for (int i = 0; i < 2; ++i) { int R, C; stage_rc(tid * 16 + i * 8192, R, C); const int q = perm32(R & 31); const int Rb = Epi::PERM ? ((R & ~31) + q) : R;
        voffA[0][i] = (unsigned)R * ldA + (unsigned)C * 2u; voffA[1][i] = voffA[0][i];
        if constexpr (epi_perm16<Epi>::value) { const int rb0 = 64 * (R >> 5) + 16 * (q >> 3) + (q & 7); voffBh[0][i] = (unsigned)rb0 * ldB + (unsigned)C * 2u; voffBh[1][i] = (unsigned)(rb0 + 8) * ldB + (unsigned)C * 2u; }
        else { voffBh[0][i] = (unsigned)Rb * ldB + (unsigned)C * 2u; voffBh[1][i] = voffBh[0][i]; } }
    const size_t kstep = (size_t)(BK * 2);
    const unsigned ldsw = (unsigned)wid * 1024u;
    const unsigned lds0 = (unsigned)(__UINTPTR_TYPE__)lds;
    const int aoff = lds_byte(wr * 64 + fr, fq * 8), boff = lds_byte(wc * 32 + fr, fq * 8);
#define PG8_SA(b, h) (((b) * 2 + (h)) * HTB)
#define PG8_SB(b, h) ((4 + (b) * 2 + (h)) * HTB)
#define PG8_STAGE(bufoff, gbase, voff) do { _Pragma("unroll") for (int _i = 0; _i < 2; ++_i) glds16((const char*)(gbase), (voff)[_i], lds0 + (unsigned)(bufoff) + ldsw + _i * 8192u); } while (0)
#define PG8_LDA(dst, b, h) do { _Pragma("unroll") for (int m = 0; m < 4; ++m) _Pragma("unroll") for (int k = 0; k < 2; ++k) dst[m][k] = *(const LAS bf16x8*)(lds + PG8_SA(b, h) + aoff + m * 2048 + k * 1024); } while (0)
#define PG8_LDB(dst, b, h) do { _Pragma("unroll") for (int n = 0; n < 2; ++n) _Pragma("unroll") for (int k = 0; k < 2; ++k) dst[n][k] = *(const LAS bf16x8*)(lds + PG8_SB(b, h) + boff + n * 2048 + k * 1024); } while (0)
#define PG8_MMA(ai, bj, At, Bt) do { __builtin_amdgcn_s_setprio(1); _Pragma("unroll") for (int m = 0; m < 4; ++m) _Pragma("unroll") for (int n = 0; n < 2; ++n) { \
        if constexpr (FP8) { const i32x8v b8_ = cat8(Bt[n][0], Bt[n][1]), a8_ = cat8(At[m][0], At[m][1]); \
            asm volatile("s_nop 1\n\tv_mfma_scale_f32_16x16x128_f8f6f4 %0, %1, %2, %0, %3, %3 op_sel_hi:[0,0,0]" : "+v"(acc[ai][bj][m][n]) : "v"(b8_), "v"(a8_), "v"(fp8_unit_scale)); } \
        else { _Pragma("unroll") for (int k = 0; k < 2; ++k) acc[ai][bj][m][n] = __builtin_amdgcn_mfma_f32_16x16x32_bf16(Bt[n][k], At[m][k], acc[ai][bj][m][n], 0, 0, 0); } } \
        __builtin_amdgcn_s_setprio(0); } while (0)
#define PG8_WAIT_V(n) asm volatile("s_waitcnt vmcnt(" #n ")" ::: "memory")
#define PG8_WAIT_L(n) asm volatile("s_waitcnt lgkmcnt(" #n ")" ::: "memory")
#define PG8_BAR __builtin_amdgcn_s_barrier()
#define PG8_SCHED __builtin_amdgcn_sched_barrier(0)
#define PG8_VA(h) voffA[GATHER ? (h) : 0]
#define PG8_VB(h) voffBh[epi_perm16<Epi>::value ? (h) : 0]
    const int fp8_unit_scale = 0x7f7f7f7f;
    Unit cur, nxt; int ui = 0;
    if (!S.next(0, cur)) return;
    if constexpr (GATHER) {
#pragma unroll
        for (int h = 0; h < 2; ++h)
#pragma unroll
            for (int i = 0; i < 2; ++i) { int R, C; stage_rc(tid * 16 + i * 8192, R, C); voffA[h][i] = (unsigned)idxsrc[h * 128 + R] * ldA + (unsigned)C * 2u; }
    }
    f32x4 acc[2][2][4][2];
#pragma unroll
    for (int a = 0; a < 2; ++a)
#pragma unroll
        for (int b = 0; b < 2; ++b)
#pragma unroll
            for (int m = 0; m < 4; ++m)
#pragma unroll
                for (int n = 0; n < 2; ++n) acc[a][b][m][n] = (f32x4){0.f, 0.f, 0.f, 0.f};
    bf16x8 At[4][2], B0[2][2], B1[2][2];
    const char* cA = cur.A; const char* cB = cur.B; unsigned chA = cur.hsA, chB = cur.hsB;
    if constexpr (SP2) {
        PG8_STAGE(PG8_SB(0, 0), cB, PG8_VB(0)); PG8_STAGE(PG8_SB(0, 1), cB + chB, PG8_VB(1)); PG8_STAGE(PG8_SA(0, 0), cA, PG8_VA(0)); PG8_STAGE(PG8_SA(0, 1), cA + chA, PG8_VA(1));
        if (wr == 1) PG8_BAR;
        PG8_WAIT_V(2); PG8_BAR;
        PG8_STAGE(PG8_SB(1, 0), cB + kstep, PG8_VB(0)); PG8_STAGE(PG8_SA(1, 0), cA + kstep, PG8_VA(0)); PG8_STAGE(PG8_SB(1, 1), cB + chB + kstep, PG8_VB(1));
        PG8_WAIT_V(6); PG8_BAR;
    } else {
    PG8_STAGE(PG8_SB(0, 0), cB, PG8_VB(0)); PG8_STAGE(PG8_SA(0, 0), cA, PG8_VA(0)); PG8_STAGE(PG8_SB(0, 1), cB + chB, PG8_VB(1)); PG8_STAGE(PG8_SA(0, 1), cA + chA, PG8_VA(1));
    if (wr == 1) PG8_BAR;
    PG8_WAIT_V(4); PG8_BAR;
    PG8_STAGE(PG8_SB(1, 0), cB + kstep, PG8_VB(0)); PG8_STAGE(PG8_SA(1, 0), cA + kstep, PG8_VA(0)); PG8_STAGE(PG8_SB(1, 1), cB + chB + kstep, PG8_VB(1));
    PG8_WAIT_V(6); PG8_BAR;
    }
    for (;;) {
        const bool has_next = S.next(ui + 1, nxt);
        const char* nA = has_next ? nxt.A : cA; const char* nB = has_next ? nxt.B : cB; const unsigned nhA = has_next ? nxt.hsA : chA, nhB = has_next ? nxt.hsB : chB;
#pragma unroll 1
        for (int t = 0; t < nt; t += 2) {
            const bool last = (t == nt - 2);
            const char* a1 = cA + (size_t)(t + 1) * kstep;
            const char* a2 = last ? nA : cA + (size_t)(t + 2) * kstep; const char* b2 = last ? nB : cB + (size_t)(t + 2) * kstep;
            const unsigned hA2 = last ? nhA : chA, hB2 = last ? nhB : chB;
            const char* a3 = a2 + kstep; const char* b3 = b2 + kstep;
            const bool sw = GATHER && last && has_next;
            int gi[2][2];
            if constexpr (SP2) {
            PG8_LDB(B0, 0, 0); PG8_LDB(B1, 0, 1); PG8_SCHED; PG8_LDA(At, 0, 0); PG8_STAGE(PG8_SA(1, 1), a1 + chA, PG8_VA(1));
            PG8_WAIT_V(8); PG8_WAIT_L(0); PG8_BAR; PG8_MMA(0, 0, At, B0); PG8_MMA(0, 1, At, B1); PG8_BAR; PG8_SCHED;
            if constexpr (GATHER) { if (sw) {
#pragma unroll
                for (int h = 0; h < 2; ++h)
#pragma unroll
                    for (int i = 0; i < 2; ++i) { int R, C; stage_rc(tid * 16 + i * 8192, R, C); gi[h][i] = idxsrc[(ui + 1) * 256 + h * 128 + R]; } } }
            PG8_LDA(At, 0, 1); PG8_STAGE(PG8_SB(0, 0), b2, PG8_VB(0)); PG8_STAGE(PG8_SB(0, 1), b2 + hB2, PG8_VB(1));
            if constexpr (GATHER) { if (sw) {
#pragma unroll
                for (int h = 0; h < 2; ++h)
#pragma unroll
                    for (int i = 0; i < 2; ++i) { int R, C; stage_rc(tid * 16 + i * 8192, R, C); voffA[h][i] = (unsigned)gi[h][i] * ldA + (unsigned)C * 2u; } } }
            PG8_STAGE(PG8_SA(0, 0), a2, PG8_VA(0));
            PG8_WAIT_V(8); PG8_WAIT_L(0); PG8_BAR; PG8_MMA(1, 0, At, B0); PG8_MMA(1, 1, At, B1); PG8_BAR; PG8_SCHED;
            PG8_LDB(B0, 1, 0); PG8_LDB(B1, 1, 1); PG8_SCHED; PG8_LDA(At, 1, 0); PG8_STAGE(PG8_SA(0, 1), a2 + hA2, PG8_VA(1));
            PG8_WAIT_V(8); PG8_WAIT_L(0); PG8_BAR; PG8_MMA(0, 0, At, B0); PG8_MMA(0, 1, At, B1); PG8_BAR; PG8_SCHED;
            PG8_LDA(At, 1, 1); PG8_STAGE(PG8_SB(1, 0), b3, PG8_VB(0)); PG8_STAGE(PG8_SB(1, 1), b3 + hB2, PG8_VB(1)); PG8_STAGE(PG8_SA(1, 0), a3, PG8_VA(0));
            PG8_WAIT_V(8); PG8_WAIT_L(0); PG8_BAR; PG8_MMA(1, 0, At, B0); PG8_MMA(1, 1, At, B1); PG8_BAR; PG8_SCHED;
            } else {
            PG8_LDB(B0, 0, 0); PG8_SCHED; PG8_LDA(At, 0, 0); PG8_STAGE(PG8_SA(1, 1), a1 + chA, PG8_VA(1));
            PG8_WAIT_L(8); PG8_BAR; PG8_WAIT_L(0); PG8_MMA(0, 0, At, B0); PG8_BAR; PG8_SCHED;
            if constexpr (GATHER) { if (sw) {
#pragma unroll
                for (int h = 0; h < 2; ++h)
#pragma unroll
                    for (int i = 0; i < 2; ++i) { int R, C; stage_rc(tid * 16 + i * 8192, R, C); gi[h][i] = idxsrc[(ui + 1) * 256 + h * 128 + R]; } } }
            PG8_LDB(B1, 0, 1); PG8_STAGE(PG8_SB(0, 0), b2, PG8_VB(0));
            PG8_BAR; PG8_WAIT_L(0); PG8_MMA(0, 1, At, B1); PG8_BAR;
            if constexpr (GATHER) { if (sw) {
#pragma unroll
                for (int h = 0; h < 2; ++h)
#pragma unroll
                    for (int i = 0; i < 2; ++i) { int R, C; stage_rc(tid * 16 + i * 8192, R, C); voffA[h][i] = (unsigned)gi[h][i] * ldA + (unsigned)C * 2u; } } }
            PG8_LDA(At, 0, 1); PG8_STAGE(PG8_SA(0, 0), a2, PG8_VA(0));
            PG8_BAR; PG8_WAIT_L(0); PG8_MMA(1, 0, At, B0); PG8_BAR; PG8_SCHED;
            PG8_STAGE(PG8_SB(0, 1), b2 + hB2, PG8_VB(1));
            PG8_WAIT_V(6); PG8_BAR; PG8_MMA(1, 1, At, B1); PG8_BAR;
            PG8_LDB(B0, 1, 0); PG8_SCHED; PG8_LDA(At, 1, 0); PG8_STAGE(PG8_SA(0, 1), a2 + hA2, PG8_VA(1));
            PG8_WAIT_L(8); PG8_BAR; PG8_WAIT_L(0); PG8_MMA(0, 0, At, B0); PG8_BAR; PG8_SCHED;
            PG8_LDB(B1, 1, 1); PG8_STAGE(PG8_SB(1, 0), b3, PG8_VB(0));
            PG8_BAR; PG8_WAIT_L(0); PG8_MMA(0, 1, At, B1); PG8_BAR;
            PG8_LDA(At, 1, 1); PG8_STAGE(PG8_SA(1, 0), a3, PG8_VA(0));
            PG8_BAR; PG8_WAIT_L(0); PG8_MMA(1, 0, At, B0); PG8_BAR; PG8_SCHED;
            PG8_STAGE(PG8_SB(1, 1), b3 + hB2, PG8_VB(1));
            PG8_WAIT_V(6); PG8_BAR; PG8_MMA(1, 1, At, B1); PG8_BAR;
            }
        }
        if constexpr (ALIGN_EPI) { if (wr == 0) PG8_BAR; }
        if constexpr (FP8) asm volatile("s_nop 15\n\ts_nop 15" ::: "memory");
        E(acc, cur, ui, wr, wc, fr, fq);
        if (!has_next) break;
#pragma unroll
        for (int a = 0; a < 2; ++a)
#pragma unroll
            for (int b = 0; b < 2; ++b)
#pragma unroll
                for (int m = 0; m < 4; ++m)
#pragma unroll
                    for (int n = 0; n < 2; ++n) acc[a][b][m][n] = (f32x4){0.f, 0.f, 0.f, 0.f};
        cur = nxt; cA = nA; cB = nB; chA = nhA; chB = nhB; ++ui;
        if constexpr (ALIGN_EPI) { if (wr == 1) PG8_BAR; }
    }
    PG8_WAIT_V(0);
    if constexpr (!ALIGN_EPI) { if (wr == 0) PG8_BAR; }
    PG8_BAR;
#undef PG8_SA
#undef PG8_SB
#undef PG8_STAGE
#undef PG8_LDA
#undef PG8_LDB
#undef PG8_MMA
#undef PG8_WAIT_V
#undef PG8_WAIT_L
#undef PG8_BAR
#undef PG8_SCHED
#undef PG8_VA
#undef PG8_VB
}
}
using gm::Unit;

struct Params { const float* in[13]; float* out; unsigned char* ws; int ph_lo, ph_hi; };

struct SchedPlain {
    gm::GridOrder o; const char* A; const char* B; unsigned ldA, ldB; bool p16 = false;
    __device__ __forceinline__ bool next(int i, Unit& u) const { int pm, pn; if (!o.mn(i, pm, pn)) return false;
        u.pm = pm; u.pn = pn; u.x0 = 0; u.x1 = 0; u.A = A + (size_t)pm * 256 * ldA; u.hsA = 128u * ldA; u.B = B + (size_t)pn * 256 * ldB; u.hsB = p16 ? 0u : 128u * ldB; return true; }
};
struct SchedG1 {
    gm::GridOrder o; const char* WinT; const char* xb;
    __device__ __forceinline__ bool next(int i, Unit& u) const { int pm, pn; if (!o.mn(i, pm, pn)) return false;
        const int b = pn >> 5, j = pn & 31; u.pm = pm; u.pn = pn; u.x0 = b; u.x1 = j;
        u.A = WinT + (size_t)pm * 256 * 1024; u.hsA = 128u * 1024u; u.B = xb + ((size_t)(b * SEQ + 2 * j)) * 1024; u.hsB = 1024u; return true; }
};
struct SchedS1 {
    int G, c; const char* F1; const char* Ut;
    __device__ __forceinline__ bool next(int i, Unit& u) const { const int L = i * G + c; if (L >= 1024) return false;
        u.pm = 0; u.pn = L; u.x0 = 0; u.x1 = 0; u.A = F1; u.hsA = 128u * 256u; u.B = Ut + (size_t)L * 256 * 256; u.hsB = 128u * 256u; return true; }
};
struct SchedS2 {
    gm::GridOrder o; const char* F2; const char* A1;
    __device__ __forceinline__ bool next(int i, Unit& u) const { int pm, pn; if (!o.mn(i, pm, pn)) return false;
        const int g = pm, b = pn >> 2, ct = pn & 3; u.pm = g; u.pn = ct; u.x0 = b; u.x1 = g;
        u.A = F2 + (size_t)g * 256 * 256; u.hsA = 128u * 256u; u.B = A1 + ((size_t)((b * 64 + g) * 1024 + ct * 256)) * 256; u.hsB = 0u; return true; }
};
__device__ __forceinline__ int expert_of_tile(const LAS int* ts, int pm) {
    const int ln = (int)__builtin_amdgcn_mbcnt_hi(~0u, __builtin_amdgcn_mbcnt_lo(~0u, 0u));
    const int v = ts[ln & 31];
    return (int)__builtin_popcountll(__ballot((ln >= 1) && (ln < 32) && (v <= pm)));
}
struct SchedMoe {
    gm::GridOrder o; const LAS int* ts; const char* A; const char* W; size_t wstride; unsigned ldB; bool hsB128; unsigned tileA;
    __device__ __forceinline__ bool next(int i, Unit& u) const { int pm, pn; if (!o.mn(i, pm, pn)) return false;
        const int e = expert_of_tile(ts, pm);
        u.pm = pm; u.pn = pn; u.x0 = e; u.x1 = pm - ts[e]; u.A = A + (size_t)pm * tileA; u.hsA = tileA >> 1; u.B = W + (size_t)e * wstride + (size_t)pn * 256 * ldB; u.hsB = hsB128 ? 128u * ldB : 0u; return true; }
};

typedef f32x4 Acc[2][2][4][2];
struct EpiRow {
    static constexpr bool PERM = true;
    bf16_t* O; size_t ld; int split_tiles; size_t split_stride; float scale0, scale1;
    __device__ __forceinline__ void operator()(const Acc& acc, const Unit& u, int, int wr, int wc, int fr, int fq) const {
        int pn = u.pn; bf16_t* base = O; float sc = scale0;
        if (split_tiles) { const int t = pn / split_tiles; base += (size_t)t * split_stride; pn -= t * split_tiles; if (t != 0) sc = scale1; }
        const size_t row0 = (size_t)u.pm * 256 + wr * 64 + fr; const int col0 = pn * 256 + wc * 32 + 8 * fq;
#pragma unroll
        for (int ai = 0; ai < 2; ++ai)
#pragma unroll
            for (int m = 0; m < 4; ++m) { bf16_t* rowp = base + (row0 + ai * 128 + m * 16) * ld + col0;
#pragma unroll
                for (int bj = 0; bj < 2; ++bj) *(u32x4*)(rowp + bj * 128) = pack8(acc[ai][bj][m][0] * sc, acc[ai][bj][m][1] * sc); }
    }
};
struct EpiRow8 {
    static constexpr bool PERM = true, PERM16 = true;
    unsigned char* O; size_t ld; int split_tiles; size_t split_stride; float scale0, scale1;
    __device__ __forceinline__ void operator()(const Acc& acc, const Unit& u, int, int wr, int wc, int fr, int fq) const {
        int pn = u.pn; unsigned char* base = O; float sc = scale0;
        if (split_tiles) { const int t = pn / split_tiles; base += (size_t)t * split_stride; pn -= t * split_tiles; if (t != 0) sc = scale1; }
        const size_t row0 = (size_t)u.pm * 256 + wr * 64 + fr; const int col0 = pn * 256 + wc * 64 + 16 * fq;
#pragma unroll
        for (int ai = 0; ai < 2; ++ai)
#pragma unroll
            for (int m = 0; m < 4; ++m) { u32x4 w;
                { const f32x4 v = acc[ai][0][m][0] * sc; w.x = pk4_fp8(v[0], v[1], v[2], v[3]); } { const f32x4 v = acc[ai][0][m][1] * sc; w.y = pk4_fp8(v[0], v[1], v[2], v[3]); }
                { const f32x4 v = acc[ai][1][m][0] * sc; w.z = pk4_fp8(v[0], v[1], v[2], v[3]); } { const f32x4 v = acc[ai][1][m][1] * sc; w.w = pk4_fp8(v[0], v[1], v[2], v[3]); }
                *(u32x4*)(base + (row0 + ai * 128 + m * 16) * ld + col0) = w; }
    }
};
struct EpiG1 {
    static constexpr bool PERM = true;
    bf16_t* Ut; float sc;
    __device__ __forceinline__ void operator()(const Acc& acc, const Unit& u, int, int wr, int wc, int fr, int fq) const {
#pragma unroll
        for (int ai = 0; ai < 2; ++ai)
#pragma unroll
            for (int m = 0; m < 4; ++m) { const int c = u.pm * 256 + ai * 128 + wr * 64 + m * 16 + fr;
#pragma unroll
                for (int bj = 0; bj < 2; ++bj) { const int s2 = 2 * u.x1 + bj;
                    *(u32x4*)(Ut + (((size_t)(u.x0 * 1024 + c) * 64 + s2) * 128 + wc * 32 + 8 * fq)) = pack8(acc[ai][bj][m][0] * sc, acc[ai][bj][m][1] * sc); } }
    }
};
struct EpiS1 {
    static constexpr bool PERM = true;
    bf16_t* A1;
    __device__ __forceinline__ void operator()(const Acc& acc, const Unit& u, int, int wr, int wc, int fr, int fq) const {
#pragma unroll
        for (int m = 0; m < 4; ++m) { const int m1 = wr * 64 + m * 16 + fr, g = m1 >> 1, ri = m1 & 1;
#pragma unroll
            for (int bj = 0; bj < 2; ++bj) { const int nrow = u.pn * 256 + bj * 128 + wc * 32 + 8 * fq, s2 = nrow & 63, c = (nrow >> 6) & 1023, b = nrow >> 16;
                *(u32x4*)(A1 + ((size_t)((b * 64 + g) * 1024 + c) * 128 + ri * 64 + s2)) = pack8(acc[0][bj][m][0], acc[0][bj][m][1]); } }
    }
};
struct EpiS2 {
    static constexpr bool PERM = true, PERM16 = true;
    unsigned char* Y;
    __device__ __forceinline__ void operator()(const Acc& acc, const Unit& u, int, int wr, int wc, int fr, int fq) const {
        const int g = u.x1, b = u.x0;
#pragma unroll
        for (int ai = 0; ai < 2; ++ai)
#pragma unroll
            for (int m = 0; m < 4; ++m) { const int mm = wr * 64 + m * 16 + fr, k2 = mm >> 1, rip = mm & 1;
                const int k1 = ai ? (g ? 128 - g : 64) : g, k = k1 + 128 * k2;
                { const int c = u.pn * 256 + wc * 64 + 16 * fq; u32x4 w;
                    { const f32x4 v = acc[ai][0][m][0] * Y_SCALE; w.x = pk4_fp8(v[0], v[1], v[2], v[3]); } { const f32x4 v = acc[ai][0][m][1] * Y_SCALE; w.y = pk4_fp8(v[0], v[1], v[2], v[3]); }
                    { const f32x4 v = acc[ai][1][m][0] * Y_SCALE; w.z = pk4_fp8(v[0], v[1], v[2], v[3]); } { const f32x4 v = acc[ai][1][m][1] * Y_SCALE; w.w = pk4_fp8(v[0], v[1], v[2], v[3]); }
                    *(u32x4*)(Y + ((size_t)(b * SEQ + k) * 2048 + rip * 1024 + c)) = w; } }
    }
};
struct EpiGU {
    static constexpr bool PERM = true;
    unsigned char* Hb; const LAS int* idxdst;
    __device__ __forceinline__ void operator()(const Acc& acc, const Unit& u, int ui, int wr, int wc, int fr, int fq) const {
#pragma unroll
        for (int ai = 0; ai < 2; ++ai)
#pragma unroll
            for (int mp = 0; mp < 2; ++mp) { u32x2 w[2];
#pragma unroll
                for (int mm = 0; mm < 2; ++mm) { const int m = 2 * mp + mm; f32x4 h0, h1;
#pragma unroll
                    for (int j = 0; j < 4; ++j) { h0[j] = silu_mul(acc[ai][0][m][0][j] * (1.0f / W_SCALE), acc[ai][1][m][0][j] * (H_SCALE / W_SCALE)); h1[j] = silu_mul(acc[ai][0][m][1][j] * (1.0f / W_SCALE), acc[ai][1][m][1][j] * (H_SCALE / W_SCALE)); }
                    w[mm].x = pk4_fp8(h0[0], h0[1], h0[2], h0[3]); w[mm].y = pk4_fp8(h1[0], h1[1], h1[2], h1[3]); }
                const auto sx = __builtin_amdgcn_permlane16_swap(w[0].x, w[1].x, false, false); const auto sy = __builtin_amdgcn_permlane16_swap(w[0].y, w[1].y, false, false);
                const int m = 2 * mp + (fq & 1), row = ai * 128 + wr * 64 + m * 16 + fr; const int a = idxdst[ui * 256 + row];
                if (a >= 0) { u32x4 v; v.x = sx[0]; v.y = sy[0]; v.z = sx[1]; v.w = sy[1];
                    *(u32x4*)(Hb + ((size_t)(u.pm * 256 + row) * DEX + u.pn * 128 + wc * 32 + 8 * (fq & 2))) = v; } }
    }
};
struct EpiDown {
    static constexpr bool PERM = true, PERM16 = true;
    unsigned char* ys; const LAS int* idxdst;
    __device__ __forceinline__ void operator()(const Acc& acc, const Unit& u, int ui, int wr, int wc, int fr, int fq) const {
#pragma unroll
        for (int ai = 0; ai < 2; ++ai)
#pragma unroll
            for (int m = 0; m < 4; ++m) { const int a = idxdst[ui * 256 + ai * 128 + wr * 64 + m * 16 + fr];
                if (a >= 0) { constexpr float sc = YS_SCALE / (W_SCALE * H_SCALE); u32x4 w;
                    { const f32x4 v = acc[ai][0][m][0] * sc; w.x = pk4_fp8(v[0], v[1], v[2], v[3]); } { const f32x4 v = acc[ai][0][m][1] * sc; w.y = pk4_fp8(v[0], v[1], v[2], v[3]); }
                    { const f32x4 v = acc[ai][1][m][0] * sc; w.z = pk4_fp8(v[0], v[1], v[2], v[3]); } { const f32x4 v = acc[ai][1][m][1] * sc; w.w = pk4_fp8(v[0], v[1], v[2], v[3]); }
                    *(u32x4*)(ys + ((size_t)a * DM + u.pn * 256 + wc * 64 + 16 * fq)) = w; } }
    }
};

constexpr int LDS_P0CTR = 140288;
struct TileDesc { const float* src; unsigned char* dst; int C, r0, c0, dld, kind; };
__device__ __forceinline__ TileDesc tile_desc(const Params& p, int tt) {
    TileDesc d; d.kind = 3; unsigned char* ws = p.ws;
    if (tt < 256) { d.src = p.in[1]; d.C = 1024; d.r0 = (tt >> 5) * 128; d.c0 = (tt & 31) * 32; d.dst = ws + WS_WIN; d.dld = 1024; }
    else if (tt < 1024) { const int t2 = tt - 256; d.src = p.in[3]; d.C = 3072; d.r0 = (t2 / 96) * 128; d.c0 = (t2 % 96) * 32; d.dst = ws + WS_WQKV; d.dld = 1024; }
    else if (tt < 1280) { const int t2 = tt - 1024; d.src = p.in[5]; d.C = 1024; d.r0 = (t2 >> 5) * 128; d.c0 = (t2 & 31) * 32; d.dst = ws + WS_WO; d.dld = 1024; }
    else { const int t3 = tt - 1280, ee = t3 >> 7, tl = t3 & 127, mat = ee & 63; d.kind = ee >> 6;
        if (d.kind < 2) { d.src = (d.kind == 0 ? p.in[8] : p.in[9]) + (size_t)mat * 1024 * 512; d.C = 512; d.r0 = (tl >> 4) * 128; d.c0 = (tl & 15) * 32; d.dst = ws + WS_WGU + (size_t)mat * 1024 * 1024; d.dld = 1024; }
        else { d.src = p.in[10] + (size_t)mat * 512 * 1024; d.C = 1024; d.r0 = (tl >> 5) * 128; d.c0 = (tl & 31) * 32; d.dst = ws + WS_WD + (size_t)mat * 1024 * 512; d.dld = 512; } }
    return d;
}
__device__ __forceinline__ void tile_load(const TileDesc& d, f32x4 (&v)[16], int lane) {
#pragma unroll
    for (int ps = 0; ps < 16; ++ps) v[ps] = __builtin_nontemporal_load((const f32x4*)(d.src + (size_t)(d.r0 + ps * 8 + (lane >> 3)) * d.C + d.c0 + (lane & 7) * 4));
}
__device__ __forceinline__ void tile_store(const TileDesc& d, const f32x4 (&v)[16], LAS float* tile, int lane) {
#pragma unroll
    for (int ps = 0; ps < 16; ++ps) { const int row = ps * 8 + (lane >> 3), col4 = (lane & 7) * 4;
        tile[row * 33 + col4 + 0] = v[ps][0]; tile[row * 33 + col4 + 1] = v[ps][1]; tile[row * 33 + col4 + 2] = v[ps][2]; tile[row * 33 + col4 + 3] = v[ps][3]; }
    __builtin_amdgcn_fence(__ATOMIC_RELEASE, "wavefront"); __builtin_amdgcn_wave_barrier(); __builtin_amdgcn_fence(__ATOMIC_ACQUIRE, "wavefront");
#pragma unroll
    for (int ps = 0; ps < 4; ++ps) { const int n = ps * 8 + (lane >> 3), kc = (lane & 7) * 16; float a[16];
#pragma unroll
        for (int j = 0; j < 16; ++j) a[j] = tile[(kc + j) * 33 + n] * W_SCALE;
        const int nn = d.c0 + n; const int drow = (d.kind == 0 || d.kind == 1) ? (256 * (nn >> 7) + (nn & 127) + 128 * d.kind) : nn;
        u32x4 w; w.x = pk4_fp8(a[0], a[1], a[2], a[3]); w.y = pk4_fp8(a[4], a[5], a[6], a[7]); w.z = pk4_fp8(a[8], a[9], a[10], a[11]); w.w = pk4_fp8(a[12], a[13], a[14], a[15]);
        *(u32x4*)(d.dst + (size_t)drow * d.dld + d.r0 + kc) = w; }
    __builtin_amdgcn_fence(__ATOMIC_RELEASE, "wavefront"); __builtin_amdgcn_wave_barrier(); __builtin_amdgcn_fence(__ATOMIC_ACQUIRE, "wavefront");
}

__device__ __forceinline__ void transpose_share(const Params& p, LAS unsigned char* lds, int wid, int lane) {
    LAS float* tile = (LAS float*)lds + wid * (128 * 33); constexpr int NT = 1280 + 192 * 128; const int G = gridDim.x, per = (NT + G - 1) / G;
    const int lo = (int)blockIdx.x * per, hi = lo + per < NT ? lo + per : NT; LAS unsigned* ctr = (LAS unsigned*)(lds + LDS_P0CTR);
    for (;;) { unsigned g = 0u; if (lane == 0) g = __hip_atomic_fetch_add(ctr, 2u, __ATOMIC_RELAXED, __HIP_MEMORY_SCOPE_WORKGROUP);
        const int t0 = lo + (int)__builtin_amdgcn_readfirstlane(g); if (t0 >= hi) break;
        const bool two = t0 + 1 < hi; const TileDesc d0 = tile_desc(p, t0), d1 = tile_desc(p, two ? t0 + 1 : t0);
        f32x4 v0[16], v1[16]; tile_load(d0, v0, lane); tile_load(d1, v1, lane);
        tile_store(d0, v0, tile, lane); if (two) tile_store(d1, v1, tile, lane); }
}
__device__ __forceinline__ void phase_prologue(const Params& p, LAS unsigned char* lds) {
    const int tid = tid_fresh(), lane = tid & 63, wid = __builtin_amdgcn_readfirstlane(tid >> 6); unsigned char* ws = p.ws;
    if (tid == 0) *(LAS unsigned*)(lds + LDS_P0CTR) = 0u;
    __syncthreads();
    if (wid < 6) {
        { const float* x = p.in[0]; unsigned char* xb = (unsigned char*)(ws + WS_S0); bf16_t* xh = (bf16_t*)p.out; const size_t stride = (size_t)gridDim.x * 384 * 8, total = (size_t)T * DM;
          for (size_t i = ((size_t)blockIdx.x * 384 + tid) * 8; i < total; i += 4 * stride) {
              f32x4 a[4], b[4];
#pragma unroll
              for (int u = 0; u < 4; ++u) { const size_t o = i + u * stride < total ? i + u * stride : i; a[u] = __builtin_nontemporal_load((const f32x4*)(x + o)); b[u] = __builtin_nontemporal_load((const f32x4*)(x + o + 4)); }
#pragma unroll
              for (int u = 0; u < 4; ++u) if (i + u * stride < total) { u32x2 w; w.x = pk4_fp8(a[u][0], a[u][1], a[u][2], a[u][3]); w.y = pk4_fp8(b[u][0], b[u][1], b[u][2], b[u][3]); *(u32x2*)(xb + i + u * stride) = w;
                  *(u32x4*)(xh + i + u * stride) = pack8(a[u], b[u]); } } }
        transpose_share(p, lds, wid, lane);
    } else {
        const int gw = blockIdx.x * 2 + (wid - 6), gl = gw * 64 + lane;
        { bf16_t* F1 = (bf16_t*)(ws + WS_F1); bf16_t* F2 = (bf16_t*)(ws + WS_F2);
          { const int idx = gl; const int m1 = idx >> 7, s1 = idx & 127; float v = 0.f;
            if (m1 < 128) { const int g = m1 >> 1, ri = m1 & 1;
                if (g == 0) v = ri ? ((s1 & 1) ? -1.f : 1.f) : 1.f;
                else { const float ph = (float)((s1 * g) & 127) * (1.0f / 128.0f); v = ri ? -__builtin_amdgcn_sinf(ph) : __builtin_amdgcn_cosf(ph); } }
            F1[idx] = (bf16_t)(cvt_pk_bf16(v, 0.f) & 0xffffu); }
          const float sc = 0.011048543456039806f;
          for (int idx = gl; idx < 64 * 256 * 128; idx += 32768) { const int g = idx >> 15, m2 = (idx >> 7) & 255, kk = idx & 127;
              const int hsel = m2 >> 7, k2 = (m2 & 127) >> 1, rip = m2 & 1, slot = kk >> 6, s2 = kk & 63;
              const int k1 = hsel ? (g ? 128 - g : 64) : g, k = k1 + 128 * k2;
              const float ph = (float)((s2 * k) & 8191) * (1.0f / 8192.0f); const float cs = __builtin_amdgcn_cosf(ph), sn = __builtin_amdgcn_sinf(ph);
              float v;
              if (g == 0) { v = (slot == hsel) ? (rip ? -sn : cs) : 0.f; }
              else if (hsel == 0) { v = rip ? (slot ? cs : -sn) : (slot ? sn : cs); }
              else { v = rip ? (slot ? -cs : -sn) : (slot ? -sn : cs); }
              F2[idx] = (bf16_t)(cvt_pk_bf16(v * sc, 0.f) & 0xffffu); } }
        { const float* wout = p.in[2]; unsigned char* W2 = (unsigned char*)(ws + WS_W2); LAS unsigned char* bt = lds + wid * 16896; const int r8 = lane >> 3, c4 = (lane & 7) * 4, fr = lane & 15, fq = lane >> 4;
#pragma unroll 1
          for (int item = gw; item < 512; item += 2 * (int)gridDim.x) { const int gp = item >> 7, n0 = ((item >> 2) & 31) * 32, cq = item & 3;
              const float* wsrc = wout + (size_t)(gp * 256 + 32 * r8) * 1024 + n0 + c4;
#pragma unroll
              for (int half = 0; half < 2; ++half) { f32x4 wv[16];
#pragma unroll
                  for (int it = 0; it < 16; ++it) wv[it] = *(const f32x4*)(wsrc + (size_t)(half * 16 + it) * 1024);
#pragma unroll
                  for (int j = 0; j < 4; ++j)
#pragma unroll
                      for (int q = 0; q < 2; ++q) { u32x4 w; w.x = cvt_pk_bf16(wv[8 * q][j], wv[8 * q + 1][j]); w.y = cvt_pk_bf16(wv[8 * q + 2][j], wv[8 * q + 3][j]); w.z = cvt_pk_bf16(wv[8 * q + 4][j], wv[8 * q + 5][j]); w.w = cvt_pk_bf16(wv[8 * q + 6][j], wv[8 * q + 7][j]);
                          *(LAS u32x4*)(bt + (c4 + j) * 528 + (32 * r8 + half * 16 + 8 * q) * 2) = w; } }
              __builtin_amdgcn_fence(__ATOMIC_RELEASE, "wavefront"); __builtin_amdgcn_wave_barrier(); __builtin_amdgcn_fence(__ATOMIC_ACQUIRE, "wavefront");
              f32x4 acc[4][2][2];
#pragma unroll
              for (int ct = 0; ct < 4; ++ct)
#pragma unroll
                  for (int tr = 0; tr < 2; ++tr) { acc[ct][tr][0] = (f32x4){0.f, 0.f, 0.f, 0.f}; acc[ct][tr][1] = (f32x4){0.f, 0.f, 0.f, 0.f}; }
#pragma unroll 2
              for (int ks = 0; ks < 8; ++ks) { bf16x8 bf[2];
#pragma unroll
                  for (int nt = 0; nt < 2; ++nt) bf[nt] = *(const LAS bf16x8*)(bt + (nt * 16 + fr) * 528 + (ks * 32 + 8 * fq) * 2);
#pragma unroll
                  for (int ct = 0; ct < 4; ++ct) { const int c = cq * 64 + ct * 16 + fr; u32x4 ca, sa;
#pragma unroll
                      for (int e2 = 0; e2 < 4; ++e2) { const int k2a = ks * 32 + 8 * fq + 2 * e2; const float ph0 = (float)((c * k2a) & 255) * (1.0f / 256.0f), ph1 = (float)((c * (k2a + 1)) & 255) * (1.0f / 256.0f);
                          ca[e2] = cvt_pk_bf16_t(__builtin_amdgcn_cosf(ph0), __builtin_amdgcn_cosf(ph1)); sa[e2] = cvt_pk_bf16_t(__builtin_amdgcn_sinf(ph0), __builtin_amdgcn_sinf(ph1)); }
#pragma unroll
                      for (int nt = 0; nt < 2; ++nt) { acc[ct][0][nt] = __builtin_amdgcn_mfma_f32_16x16x32_bf16(__builtin_bit_cast(bf16x8, ca), bf[nt], acc[ct][0][nt], 0, 0, 0);
                          acc[ct][1][nt] = __builtin_amdgcn_mfma_f32_16x16x32_bf16(__builtin_bit_cast(bf16x8, sa), bf[nt], acc[ct][1][nt], 0, 0, 0); } } }
#pragma unroll
              for (int ct = 0; ct < 4; ++ct)
#pragma unroll
                  for (int tr = 0; tr < 2; ++tr)
#pragma unroll
                      for (int nt = 0; nt < 2; ++nt) { const f32x4 v = acc[ct][tr][nt] * (0.0625f * W2_SCALE); const int n = n0 + nt * 16 + fr, c = cq * 64 + ct * 16 + 4 * fq;
                          *(unsigned*)(W2 + (size_t)n * 2048 + tr * 1024 + gp * 256 + c) = pk4_fp8(v[0], v[1], v[2], v[3]); }
              __builtin_amdgcn_fence(__ATOMIC_RELEASE, "wavefront"); __builtin_amdgcn_wave_barrier(); __builtin_amdgcn_fence(__ATOMIC_ACQUIRE, "wavefront"); } }
        transpose_share(p, lds, wid, lane);
    }
    __syncthreads();
}

typedef _Float16 f16x8 __attribute__((ext_vector_type(8)));
typedef _Float16 f16x4 __attribute__((ext_vector_type(4)));
constexpr int LA_HT = 0, LA_RED = 65536, LA_SEL = 65536 + 32768, LA_ASG = LA_SEL + 8192, LA_MISC = LA_ASG + 1024;
__device__ __forceinline__ void phase_lnA(const Params& p, LAS unsigned char* lds, const int L, const bf16_t* res16, const bf16_t* ybuf, bf16_t* hb, unsigned char* h8) {
    const int tid = tid_fresh(), lane = tid & 63, wid = __builtin_amdgcn_readfirstlane(tid >> 6), fr = lane & 15, fq = lane >> 4;
    unsigned char* ws = p.ws;
    LAS unsigned char* ht = lds + LA_HT;
    LAS float* red = (LAS float*)(lds + LA_RED);
    LAS float* selL = (LAS float*)(lds + LA_SEL);
    LAS int* asgE = (LAS int*)(lds + LA_ASG);
    LAS int* misc = (LAS int*)(lds + LA_MISC);
    f16x8 wf[2][4];
    { const float* wrg = p.in[6];
#pragma unroll
      for (int eb = 0; eb < 2; ++eb)
#pragma unroll
          for (int sx = 0; sx < 4; ++sx)
#pragma unroll
              for (int j = 0; j < 8; ++j) wf[eb][sx][j] = (_Float16)wrg[(size_t)(128 * wid + 32 * sx + 8 * fq + j) * 32 + fr + 16 * eb]; }
    const float* lg = p.in[11] + (L * 2 + 0) * 1024; const float* lb = p.in[12] + (L * 2 + 0) * 1024;
    f32x4 gv[4], bv[4];
#pragma unroll
    for (int k = 0; k < 4; ++k) { gv[k] = *(const f32x4*)(lg + 512 * (k >> 1) + 8 * lane + 4 * (k & 1)); bv[k] = *(const f32x4*)(lb + 512 * (k >> 1) + 8 * lane + 4 * (k & 1)); }
    const float br = p.in[7][tid & 31];
    float* gates = (float*)(ws + WS_GATE);
    const int tok0 = blockIdx.x * 128;
#ifndef LNA_REP
#define LNA_REP 1
#endif
    u32x4 rx16[4][2], ryw[4][2];
#define LA_LOAD(gg) do { _Pragma("unroll") for (int tk = 0; tk < 4; ++tk) { const size_t rowo_ = (size_t)(tok0 + (gg) * 32 + 4 * wid + tk) * DM; _Pragma("unroll") for (int jj = 0; jj < 2; ++jj) { const size_t co_ = rowo_ + 512 * jj + 8 * lane; \
        rx16[tk][jj] = *(const u32x4*)(res16 + co_); ryw[tk][jj] = *(const u32x4*)(ybuf + co_); } } } while (0)
    LA_LOAD(0);
#pragma unroll 1
    for (int g_ = 0; g_ < 4 * LNA_REP; ++g_) { const int g = g_ & 3;
        f32x4 hv[4][4];
#pragma unroll
        for (int tk = 0; tk < 4; ++tk) {
#pragma unroll
            for (int jj = 0; jj < 2; ++jj) { f32x4 xa, xb2, ya, yb; bf8_to_f32(rx16[tk][jj], xa, xb2); bf8_to_f32(ryw[tk][jj], ya, yb);
                hv[tk][2 * jj] = ALPHA * xa + ya; hv[tk][2 * jj + 1] = ALPHA * xb2 + yb; } }
        float sm[4], qv[4];
#pragma unroll
        for (int tk = 0; tk < 4; ++tk) { float s = 0.f;
#pragma unroll
            for (int j = 0; j < 4; ++j) s += (hv[tk][j][0] + hv[tk][j][1]) + (hv[tk][j][2] + hv[tk][j][3]);
            sm[tk] = s; }
#pragma unroll
        for (int o = 32; o >= 1; o >>= 1) {
#pragma unroll
            for (int tk = 0; tk < 4; ++tk) sm[tk] += __shfl_xor(sm[tk], o); }
#pragma unroll
        for (int tk = 0; tk < 4; ++tk) { sm[tk] *= (1.0f / 1024.0f); float q = 0.f;
#pragma unroll
            for (int j = 0; j < 4; ++j) { const f32x4 d = hv[tk][j] - sm[tk]; q += (d[0] * d[0] + d[1] * d[1]) + (d[2] * d[2] + d[3] * d[3]); }
            qv[tk] = q; }
#pragma unroll
        for (int o = 32; o >= 1; o >>= 1) {
#pragma unroll
            for (int tk = 0; tk < 4; ++tk) qv[tk] += __shfl_xor(qv[tk], o); }
#pragma unroll
        for (int tk = 0; tk < 4; ++tk) { const int ts = 4 * wid + tk; const size_t rowo = (size_t)(tok0 + g * 32 + ts) * DM; const float rstd = 1.0f / sqrtf(qv[tk] * (1.0f / 1024.0f) + LN_EPS);
#pragma unroll
            for (int jj = 0; jj < 2; ++jj) { const size_t co = rowo + 512 * jj + 8 * lane;
                const f32x4 h0 = (hv[tk][2 * jj] - sm[tk]) * rstd * gv[2 * jj] + bv[2 * jj], h1 = (hv[tk][2 * jj + 1] - sm[tk]) * rstd * gv[2 * jj + 1] + bv[2 * jj + 1];
                *(u32x4*)(hb + co) = pack8(h0, h1);
                u32x2 w8; w8.x = pk4_fp8(h0[0], h0[1], h0[2], h0[3]); w8.y = pk4_fp8(h1[0], h1[1], h1[2], h1[3]); *(u32x2*)(h8 + co) = w8;
                const f16x8 hh = (f16x8){(_Float16)h0[0], (_Float16)h0[1], (_Float16)h0[2], (_Float16)h0[3], (_Float16)h1[0], (_Float16)h1[1], (_Float16)h1[2], (_Float16)h1[3]};
                const int chunk = (64 * jj + lane) ^ (ts & 15);
                *(LAS f16x8*)(ht + ts * 2048 + chunk * 16) = hh; } }
        if (g_ + 1 < 4 * LNA_REP) LA_LOAD((g_ + 1) & 3);
        __syncthreads();
#pragma unroll
        for (int tb = 0; tb < 2; ++tb) { f32x4 d0 = (f32x4){0.f, 0.f, 0.f, 0.f}, d1 = d0;
#pragma unroll
          for (int sx = 0; sx < 4; ++sx) { const int chunk = (16 * wid + 4 * sx + fq) ^ fr; const f16x8 hf = *(const LAS f16x8*)(ht + (16 * tb + fr) * 2048 + chunk * 16);
              d0 = __builtin_amdgcn_mfma_f32_16x16x32_f16(wf[0][sx], hf, d0, 0, 0, 0); d1 = __builtin_amdgcn_mfma_f32_16x16x32_f16(wf[1][sx], hf, d1, 0, 0, 0); }
          *(LAS f32x4*)(red + wid * 1024 + (16 * tb + fr) * 32 + 4 * fq) = d0; *(LAS f32x4*)(red + wid * 1024 + (16 * tb + fr) * 32 + 16 + 4 * fq) = d1; }
        __syncthreads();
#pragma unroll
        for (int u = 0; u < 2; ++u) { const int ix = tid + 512 * u; float lgt = 0.f;
#pragma unroll
          for (int w = 0; w < 8; ++w) lgt += red[w * 1024 + ix];
          const float sc = 1.0f / (1.0f + __expf(-lgt)); selL[ix] = sc + br; selL[1024 + ix] = sc; }
        __syncthreads();
        if (lane < 4) { const int tq = 4 * wid + lane; const LAS f32x4* sel4 = (const LAS f32x4*)(selL + tq * 32); float best = -3.0e38f; int bg = 0, b1 = 0, b2 = 0;
            f32x4 sv[8];
#pragma unroll
            for (int q = 0; q < 8; ++q) sv[q] = sel4[q];
#pragma unroll
            for (int gg = 0; gg < 4; ++gg) { float m1 = -3.0e38f, m2 = -3.0e38f; int i1 = 0, i2 = 0;
#pragma unroll
                for (int j = 0; j < 8; ++j) { const float v = sv[gg * 2 + (j >> 2)][j & 3]; const bool gt1 = v > m1, gt2 = v > m2;
                    m2 = gt1 ? m1 : (gt2 ? v : m2); i2 = gt1 ? i1 : (gt2 ? j : i2); m1 = gt1 ? v : m1; i1 = gt1 ? j : i1; }
                const float gs = m1 + m2; if (gs > best) { best = gs; bg = gg; b1 = i1; b2 = i2; } }
            const int e1 = bg * 8 + b1, e2 = bg * 8 + b2; const float s1 = selL[1024 + tq * 32 + e1], s2 = selL[1024 + tq * 32 + e2], inv = 1.0f / (s1 + s2);
            const int tl = g * 32 + tq; asgE[2 * tl] = e1; asgE[2 * tl + 1] = e2;
            const int t = tok0 + tl; gates[2 * t] = s1 * inv; gates[2 * t + 1] = s2 * inv; }
    }
    __syncthreads();
#undef LA_LOAD
    int my_e = 0, my_rank = 0; LAS int* cntW = misc + 32;
    if (tid < 256) { my_e = asgE[tid]; unsigned long long mym = 0ull; int cw = 0;
#pragma unroll
        for (int e = 0; e < 32; ++e) { const unsigned long long m = __ballot(my_e == e); if (my_e == e) mym = m; if (lane == e) cw = (int)__builtin_popcountll(m); }
        my_rank = (int)__builtin_popcountll(mym & ((1ull << lane) - 1ull));
        if (lane < 32) cntW[wid * 32 + lane] = cw; }
    __syncthreads();
    if (tid < 256) { for (int w = 0; w < 3; ++w) if (w < wid) my_rank += cntW[w * 32 + my_e]; }
    if (tid < 32) { const int c = cntW[tid] + cntW[32 + tid] + cntW[64 + tid] + cntW[96 + tid];
        unsigned* cnt = (unsigned*)(ws + WS_CTL) + CNT_WORD0 + (L * 32 + tid) * 64;
        misc[tid] = (int)__hip_atomic_fetch_add(cnt, (unsigned)c, __ATOMIC_RELAXED, __HIP_MEMORY_SCOPE_AGENT); }
    __syncthreads();
    if (tid < 256) { int* list = (int*)(ws + WS_LIST); list[(size_t)my_e * NASG + misc[my_e] + my_rank] = blockIdx.x * 256 + tid; }
    __syncthreads();
}

__device__ __forceinline__ void phase_lnB(const Params& p, const int L, const bf16_t* hb, const unsigned char* ys, bf16_t* xb_out, unsigned char* x8_out, float* f_out) {
    const int tid = tid_fresh(), lane = tid & 63, wid = tid >> 6;
    const float* lg = p.in[11] + (L * 2 + 1) * 1024; const float* lb = p.in[12] + (L * 2 + 1) * 1024;
    const float* gates = (const float*)(p.ws + WS_GATE);
    f32x4 gv[4], bv[4];
#pragma unroll
    for (int k = 0; k < 4; ++k) { gv[k] = *(const f32x4*)(lg + 512 * (k >> 1) + 8 * lane + 4 * (k & 1)); bv[k] = *(const f32x4*)(lb + 512 * (k >> 1) + 8 * lane + 4 * (k & 1)); }
    const int tok0 = blockIdx.x * 128 + wid * 16;
    u32x4 rh[2][2]; u32x2 ry0[2][2], ry1[2][2]; f32x2 rg[2];
#define LB_LOAD(tt) do { _Pragma("unroll") for (int u_ = 0; u_ < 2; ++u_) { const int t_ = (tt) + u_; const size_t ro_ = (size_t)t_ * DM; rg[u_] = *(const f32x2*)(gates + 2 * t_); _Pragma("unroll") for (int jj = 0; jj < 2; ++jj) { \
        const size_t co_ = 512 * jj + 8 * lane; rh[u_][jj] = *(const u32x4*)(hb + ro_ + co_); ry0[u_][jj] = *(const u32x2*)(ys + (size_t)(2 * t_) * DM + co_); ry1[u_][jj] = *(const u32x2*)(ys + (size_t)(2 * t_ + 1) * DM + co_); } } } while (0)
    LB_LOAD(tok0);
#pragma unroll 1
    for (int it = 0; it < 8; ++it) {
        u32x4 ch[2][2]; u32x2 cy0[2][2], cy1[2][2]; f32x2 cg[2];
#pragma unroll
        for (int u = 0; u < 2; ++u) { cg[u] = rg[u];
#pragma unroll
            for (int jj = 0; jj < 2; ++jj) { ch[u][jj] = rh[u][jj]; cy0[u][jj] = ry0[u][jj]; cy1[u][jj] = ry1[u][jj]; } }
        if (it < 7) LB_LOAD(tok0 + 2 * it + 2);
#pragma unroll
        for (int u = 0; u < 2; ++u) { const int t = tok0 + 2 * it + u; const size_t rowo = (size_t)t * DM; const float g0 = cg[u].x * (1.0f / YS_SCALE), g1 = cg[u].y * (1.0f / YS_SCALE);
            f32x4 v[4]; float s = 0.f;
#pragma unroll
            for (int jj = 0; jj < 2; ++jj) { f32x4 ha, hb2; bf8_to_f32(ch[u][jj], ha, hb2);
                const f32x4 ya = fp8x4_to_f32(cy0[u][jj].x), yb = fp8x4_to_f32(cy0[u][jj].y), za = fp8x4_to_f32(cy1[u][jj].x), zb = fp8x4_to_f32(cy1[u][jj].y);
                const f32x4 w0 = ALPHA * ha + g0 * ya + g1 * za, w1 = ALPHA * hb2 + g0 * yb + g1 * zb;
                v[2 * jj] = w0; v[2 * jj + 1] = w1; s += ((w0[0] + w0[1]) + (w0[2] + w0[3])) + ((w1[0] + w1[1]) + (w1[2] + w1[3])); }
            const float mean = wave_sum(s) * (1.0f / 1024.0f); float q = 0.f;
#pragma unroll
            for (int k = 0; k < 4; ++k) { const f32x4 d = v[k] - mean; q += (d[0] * d[0] + d[1] * d[1]) + (d[2] * d[2] + d[3] * d[3]); }
            const float rstd = 1.0f / sqrtf(wave_sum(q) * (1.0f / 1024.0f) + LN_EPS);
#pragma unroll
            for (int jj = 0; jj < 2; ++jj) { const size_t co = 512 * jj + 8 * lane;
                const f32x4 o0 = (v[2 * jj] - mean) * rstd * gv[2 * jj] + bv[2 * jj], o1 = (v[2 * jj + 1] - mean) * rstd * gv[2 * jj + 1] + bv[2 * jj + 1];
                if (f_out) { *(f32x4*)(f_out + rowo + co) = o0; *(f32x4*)(f_out + rowo + co + 4) = o1; }
                if (xb_out) { *(u32x4*)(xb_out + rowo + co) = pack8(o0, o1);
                    u32x2 w8; w8.x = pk4_fp8(o0[0], o0[1], o0[2], o0[3]); w8.y = pk4_fp8(o1[0], o1[1], o1[2], o1[3]); *(u32x2*)(x8_out + rowo + co) = w8; } } }
    }
#undef LB_LOAD
}

__device__ __forceinline__ void glds4(const char* sbase, unsigned voff, unsigned lds_dst) {
    unsigned keep;
    asm volatile("s_mov_b32 %0, m0\n\ts_mov_b32 m0, %3\n\ts_nop 0\n\tglobal_load_lds_dword %1, %2\n\ts_mov_b32 m0, %0" : "=&s"(keep) : "v"(voff), "s"(sbase), "s"(lds_dst) : "memory");
}
constexpr int A8_K = 0, A8_V = 81920, A8_RP = 122880, A8_KBUF = 40960;
__device__ __forceinline__ long mk64(unsigned lo, unsigned hi) { return (long)(((unsigned long long)hi << 32) | (unsigned long long)lo); }
__device__ __forceinline__ void phase_attn(const Params& p, LAS unsigned char* lds, const unsigned char* q8, const unsigned char* k8, const unsigned char* vt8, unsigned char* ob) {
    const int tid = tid_fresh(), lane = tid & 63, wid = __builtin_amdgcn_readfirstlane(tid >> 6), fr = lane & 15, fq = lane >> 4;
    const unsigned lds0 = (unsigned)(__UINTPTR_TYPE__)lds;
    const int item = (gridDim.x == 256) ? (int)((blockIdx.x & 7) * 32 + (blockIdx.x >> 3)) : (int)blockIdx.x, b = item >> 6, r0 = (item & 63) * 2;
    const int rsU = min(max(r0 - 4, 0), 118);
    const int r = r0 + (wid >> 2), jq = wid & 3;
    const int rs = min(max(r - 4, 0), 120), c0 = min(max(16 * jq - 8, 0), 32), lrow0 = rs - rsU;
    unsigned offK; { const int tokl = tid >> 2, pc = tid & 3, lc = pc ^ ((tokl >> 2) & 3); offK = (unsigned)(tokl * DM + lc * 16); }
    unsigned offV[5];
#pragma unroll
    for (int k = 0; k < 5; ++k) { const int q = k * 512 + tid, d = q / 40, pc = q - d * 40, lc = pc ^ (d & 7); offV[k] = (unsigned)(d * T + lc * 16); }
    const unsigned offR = (unsigned)min(wid * 64 + lane, 464) * 4u;
    const char* kbase0 = (const char*)k8 + ((size_t)(b * SEQ + rsU * 64) * DM);
    const char* vbase0 = (const char*)vt8 + ((size_t)(b * SEQ + rsU * 64));
    const char* rbase0 = (const char*)p.in[4];
    const size_t tokq = (size_t)b * SEQ + r * 64 + 16 * jq + fr;
    const char* qrow = (const char*)q8 + tokq * DM + 8 * fq;
#define AT_ISSUE_A(h, buf) do { const char* kb_ = kbase0 + (h) * 64; _Pragma("unroll") for (int k = 0; k < 5; ++k) gm::glds16(kb_ + (size_t)k * 131072, offK, lds0 + A8_K + (buf) * A8_KBUF + k * 8192 + wid * 1024); \
        glds4(rbase0 + (h) * 1860, offR, lds0 + A8_RP + (buf) * 2048 + wid * 256); } while (0)
#define AT_ISSUE_B(h) do { const char* vb_ = vbase0 + (size_t)(h) * 64 * T; _Pragma("unroll") for (int k = 0; k < 5; ++k) gm::glds16(vb_, offV[k], lds0 + A8_V + k * 8192 + wid * 1024); } while (0)
#define AT_LDQ(h, q0, q1) do { asm volatile("global_load_dwordx2 %0, %2, off\n\tglobal_load_dwordx2 %1, %2, off offset:32" : "=&v"(q0), "=&v"(q1) : "v"(qrow + (h) * 64) : "memory"); } while (0)
    const int swzk = ((c0 >> 2) + (fr >> 2)) & 3;
    const int kofs0 = (lrow0 * 64 + c0 + fr) * 64 + ((((fq >> 1) ^ swzk)) << 4) + (fq & 1) * 8, kofs1 = (lrow0 * 64 + c0 + fr) * 64 + (((((fq >> 1) ^ swzk)) ^ 2) << 4) + (fq & 1) * 8;
    int vo[8][2];
#pragma unroll
    for (int i = 0; i < 8; ++i)
#pragma unroll
        for (int hf = 0; hf < 2; ++hf) { const int tokoff = (lrow0 + i) * 64 + c0 + 4 * fq + 16 * hf; vo[i][hf] = fr * 640 + (((tokoff >> 4) ^ (fr & 7)) << 4) + (tokoff & 15); }
    const int qc = 16 * jq + fr, cs = min(max(qc - 8, 0), 48);
    long qn0, qn1;
    AT_LDQ(0, qn0, qn1);
    AT_ISSUE_A(0, 0); AT_ISSUE_B(0);
#pragma unroll 1
    for (int h = 0; h < 16; ++h) {
        const int hn = h < 15 ? h + 1 : 15, kb = h & 1;
        asm volatile("s_waitcnt vmcnt(5)" : "+v"(qn0), "+v"(qn1) :: "memory");
        const long q0 = qn0, q1 = qn1;
        __builtin_amdgcn_s_barrier();
        AT_LDQ(hn, qn0, qn1);
        AT_ISSUE_A(hn, kb ^ 1);
        f32x4 s[16];
#pragma unroll
        for (int kbi = 0; kbi < 16; ++kbi) { const int i = kbi >> 1, half = kbi & 1;
            const long k0 = *(const LAS long*)(lds + A8_K + kb * A8_KBUF + kofs0 + i * 4096 + half * 1024), k1 = *(const LAS long*)(lds + A8_K + kb * A8_KBUF + kofs1 + i * 4096 + half * 1024);
            f32x4 a = (f32x4){0.f, 0.f, 0.f, 0.f};
            a = __builtin_amdgcn_mfma_f32_16x16x32_fp8_fp8(k0, q0, a, 0, 0, 0); a = __builtin_amdgcn_mfma_f32_16x16x32_fp8_fp8(k1, q1, a, 0, 0, 0); s[kbi] = a; }
        const LAS float* rp = (const LAS float*)(lds + A8_RP + kb * 2048);
        float mx = -3.0e38f; const int thr = cs - c0;
#pragma unroll
        for (int i = 0; i < 8; ++i) { const int ri = rs + i - r + 7;
#pragma unroll
            for (int j = 0; j < 4; ++j) { const int pos = 4 * fq + j; const bool sel0 = pos >= thr; const int ci = min(max(c0 + pos - qc + 15 + (sel0 ? 0 : 16), 0), 30);
                float bvv = rp[ri * 31 + ci]; asm volatile("" : "+v"(bvv)); const float v = (sel0 ? s[2 * i][j] : s[2 * i + 1][j]) * 0.125f + bvv; s[2 * i][j] = v; mx = fmaxf(mx, v); } }
        mx = fmaxf(mx, __shfl_xor(mx, 16)); mx = fmaxf(mx, __shfl_xor(mx, 32));
        const float mxp = mx - 4.1588830833596715f;
        float sum = 0.f;
#pragma unroll
        for (int i = 0; i < 8; ++i)
#pragma unroll
            for (int j = 0; j < 4; ++j) { const int pos = 4 * fq + j; const bool sel0 = pos >= thr; const float e = __expf(s[2 * i][j] - mxp); sum += e; s[2 * i][j] = sel0 ? e : 0.f; s[2 * i + 1][j] = sel0 ? 0.f : e; }
        sum += __shfl_xor(sum, 16); sum += __shfl_xor(sum, 32);
        asm volatile("s_waitcnt vmcnt(8)" ::: "memory");
        __builtin_amdgcn_s_barrier();
        f32x4 oacc[4];
#pragma unroll
        for (int db = 0; db < 4; ++db) oacc[db] = (f32x4){0.f, 0.f, 0.f, 0.f};
#pragma unroll
        for (int i = 0; i < 8; ++i) { const long pf = mk64(pk4_fp8(s[2 * i][0], s[2 * i][1], s[2 * i][2], s[2 * i][3]), pk4_fp8(s[2 * i + 1][0], s[2 * i + 1][1], s[2 * i + 1][2], s[2 * i + 1][3]));
#pragma unroll
            for (int db = 0; db < 4; ++db) { const unsigned lo = *(const LAS unsigned*)(lds + A8_V + vo[i][0] + db * 10240), hi = *(const LAS unsigned*)(lds + A8_V + vo[i][1] + db * 10240);
                oacc[db] = __builtin_amdgcn_mfma_f32_16x16x32_fp8_fp8(mk64(lo, hi), pf, oacc[db], 0, 0, 0); } }
        asm volatile("s_waitcnt lgkmcnt(0)" ::: "memory");
        __builtin_amdgcn_s_barrier();
        AT_ISSUE_B(hn);
        const float inv = O_SCALE / sum;
#pragma unroll
        for (int db = 0; db < 4; ++db) *(unsigned*)(ob + tokq * DM + h * 64 + 16 * db + 4 * fq) = pk4_fp8(oacc[db][0] * inv, oacc[db][1] * inv, oacc[db][2] * inv, oacc[db][3] * inv);
    }
    asm volatile("s_waitcnt vmcnt(0)" ::: "memory");
    __builtin_amdgcn_s_barrier();
#undef AT_ISSUE_A
#undef AT_ISSUE_B
#undef AT_LDQ
}

template <int SRC_SHIFT>
__device__ __forceinline__ int moe_setup(const Params& p, LAS unsigned char* lds, const int L, LAS int* ts, LAS int* idxsrc, LAS int* idxdst) {
    const int tid = tid_fresh(), lane = tid & 63; unsigned char* ws = p.ws;
    LAS int* cn = ts + 40;
    if (tid < 64) {
        const int c = (int)__hip_atomic_load((unsigned*)(ws + WS_CTL) + CNT_WORD0 + (L * 32 + (lane & 31)) * 64, __ATOMIC_RELAXED, __HIP_MEMORY_SCOPE_AGENT);
        const int nt = (c + 255) >> 8; int incl = nt;
#pragma unroll
        for (int o = 1; o < 32; o <<= 1) { const int up = __shfl_up(incl, o); if ((lane & 31) >= o) incl += up; }
        if (lane < 32) { cn[lane] = c; ts[lane] = incl - nt; if (lane == 31) ts[32] = incl; } }
    __syncthreads();
    const int ntile = ts[NE];
    gm::GridOrder o; o.init(ntile, 4, gridDim.x, blockIdx.x);
    const int* list = (const int*)(ws + WS_LIST);
#pragma unroll
    for (int k = 0; k < 4; ++k) { const int ui = 2 * k + (tid >> 8), r = tid & 255; int pm = 0, pn = 0; const bool ok_u = o.mn(ui, pm, pn);
        const int e = expert_of_tile(ts, ok_u ? pm : 0);
        if (ok_u) { const int j = pm - ts[e], ce = cn[e]; const int pos = j * 256 + r; const bool ok = pos < ce; const int a = list[(size_t)e * NASG + (ok ? pos : j * 256)];
            idxsrc[ui * 256 + r] = a >> SRC_SHIFT; idxdst[ui * 256 + r] = ok ? a : -1; } }
    __syncthreads();
    return ntile;
}

__device__ __forceinline__ bool in_rng(int lo, int hi, int k) { asm volatile("" : "+s"(lo), "+s"(hi)); return lo <= k && k < hi; }
__device__ __forceinline__ Params params_fresh() {
    Params r{};
#if defined(__HIP_DEVICE_COMPILE__)
    auto k = __builtin_amdgcn_kernarg_segment_ptr(); asm volatile("" : "+s"(k));
    const __attribute__((address_space(4))) Params* kp = (const __attribute__((address_space(4))) Params*)k;
#pragma unroll
    for (int i = 0; i < 13; ++i) r.in[i] = kp->in[i];
    r.out = kp->out; r.ws = kp->ws; r.ph_lo = kp->ph_lo; r.ph_hi = kp->ph_hi;
#endif
    return r;
}
__global__ void __launch_bounds__(512, 2) k_fwd(Params p_unused) {
    extern __shared__ __attribute__((aligned(16))) unsigned char lds_raw[];
    LAS unsigned char* lds = (LAS unsigned char*)lds_raw;
    const Params p0 = params_fresh();
    { const int tid = tid_fresh(); if (tid < 4) ((LAS unsigned*)(lds + LDS_BARW))[tid] = 0u; }
    __syncthreads();
    XcdBarrier bar; bar.bar = (unsigned*)(p0.ws + WS_CTL); bar.x = 0; bar.st = nullptr;
    const int lo = p0.ph_lo, hi = p0.ph_hi;
    if (hi - lo > 1) bar = xcd_barrier_post((unsigned*)(p0.ws + WS_CTL), (volatile LAS unsigned*)(lds + LDS_BARW));
#ifndef PHMASK
#define PHMASK 0xffff
#endif
#define IN(k) (((PHMASK >> (k)) & 1) && in_rng(lo, hi, (k)))
#define SEAM(k) do { if (IN((k) + 1)) xcd_barrier(bar); } while (0)
#define PH_PTRS const Params p = params_fresh(); unsigned char* ws = p.ws; const int G = gridDim.x, cb = blockIdx.x; \
    bf16_t* S0 = (bf16_t*)(ws + WS_S0); bf16_t* S1 = (bf16_t*)(ws + WS_S1); bf16_t* S2 = (bf16_t*)(ws + WS_S2); bf16_t* S3 = (bf16_t*)(ws + WS_S3); \
    unsigned char* H8 = (unsigned char*)p.out + 64 * MiB; unsigned char* X8 = (unsigned char*)p.out + 96 * MiB; bf16_t* D0 = (bf16_t*)p.out; (void)X8; \
    LAS int* idxsrc = (LAS int*)(lds + LDS_IDX); LAS int* idxdst = idxsrc + 8 * 256; LAS int* tsm = (LAS int*)(lds + LDS_MISC); \
    (void)G; (void)cb; (void)S0; (void)S1; (void)S2; (void)S3; (void)H8; (void)D0; (void)idxsrc; (void)idxdst; (void)tsm;

    if (IN(0)) { PH_PTRS phase_prologue(p, lds); SEAM(0); }

#pragma unroll 1
    for (int L = 0; L < 2; ++L) {
        const int pb = 7 * L;
        if (L == 0) {
            if (IN(1)) {
                PH_PTRS SchedG1 S; S.o.init(4, 128, G, cb); S.WinT = (const char*)(ws + WS_WIN); S.xb = (const char*)S0; EpiG1 E{S1, 1.0f / W_SCALE};
                gm::gemm_phase<EpiG1, SchedG1, false, true>(lds, 1024, 1024u, 64u * 1024u, S, E, nullptr); SEAM(1); }
            if (IN(2)) {
                PH_PTRS SchedS1 S{G, cb, (const char*)(ws + WS_F1), (const char*)S1}; EpiS1 E{S0};
                gm::gemm_phase<EpiS1, SchedS1, false>(lds, 256, 256u, 256u, S, E, nullptr); SEAM(2); }
            if (IN(3)) {
                PH_PTRS SchedS2 S; S.o.init(64, 16, G, cb); S.F2 = (const char*)(ws + WS_F2); S.A1 = (const char*)S0; EpiS2 E{(unsigned char*)S1};
                gm::gemm_phase<EpiS2, SchedS2, false>(lds, 256, 256u, 256u, S, E, nullptr); SEAM(3); }
        } else {
            if (IN(9)) {
                PH_PTRS
                { SchedPlain S; S.o.init(128, 8, G, cb); S.A = (const char*)X8; S.B = (const char*)(ws + WS_WQKV); S.ldA = 1024u; S.ldB = 1024u; S.p16 = true; EpiRow8 E{(unsigned char*)S1, 1024, 4, (size_t)32 * MiB, 1.0f / W_SCALE, 1.0f / W_SCALE};
                  gm::gemm_phase<EpiRow8, SchedPlain, false, true>(lds, 1024, 1024u, 1024u, S, E, nullptr); }
                { SchedPlain S; S.o.init(4, 128, G, cb); S.A = (const char*)(ws + WS_WQKV) + (size_t)2048 * 1024; S.B = (const char*)X8; S.ldA = 1024u; S.ldB = 1024u; S.p16 = true; EpiRow8 E{(unsigned char*)S3, (size_t)T, 0, 0, 1.0f / W_SCALE, 1.0f / W_SCALE};
                  gm::gemm_phase<EpiRow8, SchedPlain, false, true>(lds, 1024, 1024u, 1024u, S, E, nullptr); }
                SEAM(9); }
            if (IN(10)) { PH_PTRS phase_attn(p, lds, (const unsigned char*)S1, (const unsigned char*)S1 + 32 * MiB, (const unsigned char*)S3, (unsigned char*)S0); SEAM(10); }
        }
        if (L == 0) { if (IN(4)) {
            PH_PTRS SchedPlain S; S.o.init(128, 4, G, cb); S.A = (const char*)S1; S.B = (const char*)(ws + WS_W2); S.ldA = 2048u; S.ldB = 2048u;
            EpiRow E{S0, 1024, 0, 0, 1.0f / (Y_SCALE * W2_SCALE), 1.f};
            gm::gemm_phase<EpiRow, SchedPlain, false, true>(lds, 2048, 2048u, 2048u, S, E, nullptr); SEAM(4); } }
        else { if (IN(11)) {
            PH_PTRS SchedPlain S; S.o.init(128, 4, G, cb); S.A = (const char*)S0; S.B = (const char*)(ws + WS_WO); S.ldA = 1024u; S.ldB = 1024u;
            EpiRow E{S1, 1024, 0, 0, 1.0f / (W_SCALE * O_SCALE), 1.f};
            gm::gemm_phase<EpiRow, SchedPlain, false, true>(lds, 1024, 1024u, 1024u, S, E, nullptr); SEAM(11); } }
        if (IN(5 + pb)) { PH_PTRS phase_lnA(p, lds, L, D0, L == 0 ? S0 : S1, S3, H8); SEAM(5 + pb); }
        if (IN(6 + pb)) {
            PH_PTRS const int ntile = moe_setup<1>(p, lds, L, tsm, idxsrc, idxdst);
            SchedMoe S; S.o.init(ntile, 4, G, cb); S.ts = tsm; S.A = (const char*)H8; S.W = (const char*)(ws + WS_WGU) + (size_t)L * 32 * 1024 * 1024; S.wstride = (size_t)1024 * 1024; S.ldB = 1024u; S.hsB128 = true; S.tileA = 0u;
            EpiGU E{(unsigned char*)S0, idxdst};
            gm::gemm_phase<EpiGU, SchedMoe, true, true>(lds, 1024, 1024u, 1024u, S, E, idxsrc); SEAM(6 + pb); }
        if (IN(7 + pb)) {
            PH_PTRS int ntile; if (IN(6 + pb)) { __syncthreads(); ntile = tsm[NE]; } else ntile = moe_setup<0>(p, lds, L, tsm, idxsrc, idxdst);
            SchedMoe S; S.o.init(ntile, 4, G, cb); S.ts = tsm; S.A = (const char*)S0; S.W = (const char*)(ws + WS_WD) + (size_t)L * 32 * 1024 * 512; S.wstride = (size_t)1024 * 512; S.ldB = 512u; S.hsB128 = false; S.tileA = 256u * 512u;
            EpiDown E{(unsigned char*)S1, idxdst};
            gm::gemm_phase<EpiDown, SchedMoe, false, true>(lds, 512, 512u, 512u, S, E, nullptr); SEAM(7 + pb); }
        if (IN(8 + pb)) { PH_PTRS phase_lnB(p, L, S3, (const unsigned char*)S1, L == 0 ? D0 : nullptr, X8, L == 0 ? nullptr : p.out); if (L == 0) SEAM(8); }
    }
#undef IN
#undef SEAM
#undef PH_PTRS
}

extern "C" void kernel_launch(void* const* d_in, const int* in_sizes, int n_in, void* d_out, int out_size, void* d_ws, size_t ws_size, hipStream_t stream) {
    static int grid = 0;
    if (grid == 0) {
        if (n_in != 13 || in_sizes[0] != T * DM || out_size != T * DM || ws_size < WS_END) { fprintf(stderr, "kernel_launch: unexpected shapes / workspace (%d inputs, in0 %d, out %d, ws %zu < %zu)\n", n_in, n_in > 0 ? in_sizes[0] : -1, out_size, ws_size, (size_t)WS_END); grid = -1; return; }
        int dev = 0, cus = 0, per_cu = 0;
        if (hipGetDevice(&dev) != hipSuccess || hipDeviceGetAttribute(&cus, hipDeviceAttributeMultiprocessorCount, dev) != hipSuccess) { grid = -1; return; }
        if (hipFuncSetAttribute((const void*)k_fwd, hipFuncAttributeMaxDynamicSharedMemorySize, LDS_BYTES) != hipSuccess) { fprintf(stderr, "kernel_launch: hipFuncSetAttribute failed\n"); grid = -1; return; }
        if (hipOccupancyMaxActiveBlocksPerMultiprocessor(&per_cu, (const void*)k_fwd, 512, LDS_BYTES) != hipSuccess || per_cu < 1) fprintf(stderr, "kernel_launch: occupancy query says %d\n", per_cu);
        (void)hipGetLastError();
        grid = cus;
    }
    if (grid < 0) return;
    (void)hipMemsetAsync((char*)d_ws + WS_CTL, 0, CTL_ZERO_BYTES, stream);
    Params a{};
    for (int i = 0; i < 13; ++i) a.in[i] = (const float*)d_in[i];
    a.out = (float*)d_out; a.ws = (unsigned char*)d_ws;
#if MK_N_LAUNCHES == 1
    a.ph_lo = 0; a.ph_hi = NPH;
    hipLaunchKernelGGL(k_fwd, dim3(grid), dim3(512), LDS_BYTES, stream, a);
#else
    for (int k = 0; k < NPH; ++k) { a.ph_lo = k; a.ph_hi = k + 1; const int reps = ((REPMASK >> k) & 1) ? 2 : 1;
        for (int r = 0; r < reps; ++r) hipLaunchKernelGGL(k_fwd, dim3(grid), dim3(512), LDS_BYTES, stream, a); }
#endif
}
```

```cpp
#include <hip/hip_runtime.h>
#include <cstdio>
#include <cstdint>

#ifndef MK_N_LAUNCHES
#define MK_N_LAUNCHES 1
#endif
#ifndef REPMASK
#define REPMASK 0x0
#endif

#define LAS __attribute__((address_space(3)))
typedef unsigned short bf16_t;
typedef short bf16x8 __attribute__((ext_vector_type(8)));
typedef short bf16x4 __attribute__((ext_vector_type(4)));
typedef float f32x4 __attribute__((ext_vector_type(4)));
typedef float f32x2 __attribute__((ext_vector_type(2)));
typedef unsigned u32x4 __attribute__((ext_vector_type(4)));
typedef unsigned u32x2 __attribute__((ext_vector_type(2)));

constexpr int T = 32768, DM = 1024, SEQ = 8192, NBATCH = 4, NE = 32, DEX = 512, NASG = 65536, NPH = 16;
constexpr float ALPHA = 1.41421356237309515f;
constexpr float LN_EPS = 1e-5f;
constexpr size_t MiB = (size_t)1 << 20;
constexpr size_t WS_CTL = 0, WS_GATE = 1 * MiB, WS_LIST = 2 * MiB, WS_WIN = 10 * MiB, WS_W2 = 12 * MiB, WS_F1 = 16 * MiB, WS_F2 = 17 * MiB, WS_WQKV = 21 * MiB, WS_WO = 27 * MiB,
                 WS_WGU = 30 * MiB, WS_WD = 158 * MiB, WS_S0 = 222 * MiB, WS_S1 = 286 * MiB, WS_S2 = 350 * MiB, WS_S3 = 414 * MiB, WS_END = 478 * MiB;
constexpr size_t CTL_ZERO_BYTES = 65536;
constexpr int CNT_WORD0 = 4096;
constexpr int LDS_BYTES = 159760;
constexpr int LDS_IDX = 131072, LDS_MISC = 131072 + 16384, LDS_BARW = LDS_BYTES - 16;

#define XB_TMO      128
#define XB_XCNT(j)  (256  + 64 * (j))
#define XB_XSUB(j)  (1280 + 64 * (j))
#define XB_XGEN(j)  (2304 + 64 * (j))
#define XB_TOP      3328
#define XB_TOPGEN   3392
#define XCD_BAR_WORDS 3456
#define XB_SPIN_CAP (1u << 18)

__device__ __forceinline__ unsigned xb_ld(unsigned* p)              { return __hip_atomic_load(p, __ATOMIC_RELAXED, __HIP_MEMORY_SCOPE_AGENT); }
__device__ __forceinline__ unsigned xb_add(unsigned* p, unsigned v) { return __hip_atomic_fetch_add(p, v, __ATOMIC_RELAXED, __HIP_MEMORY_SCOPE_AGENT); }
__device__ __forceinline__ unsigned xb_xcc_id() { return (unsigned)__builtin_amdgcn_s_getreg((3 << 11) | 20) & 0xFu; }
#define XB_SPIN(cond, bar) do { unsigned _sp = 0; while (cond) { __builtin_amdgcn_s_sleep(1); \
    if ((++_sp & 255u) == 0u) { if (xb_ld(&(bar)[XB_TMO])) break; if (_sp > XB_SPIN_CAP) { atomicAdd(&(bar)[XB_TMO], 1u); break; } } } } while (0)

struct XcdBarrier { unsigned* bar; unsigned x; volatile LAS unsigned* st; };

__device__ __forceinline__ XcdBarrier xcd_barrier_post(unsigned* bar, volatile LAS unsigned* st) {
    XcdBarrier b; b.bar = bar; b.x = xb_xcc_id(); b.st = st;
    if (threadIdx.x == 0) (void)xb_add(&bar[XB_XCNT(b.x)], 1u);
    return b;
}
__device__ __forceinline__ void xcd_barrier_complete(unsigned* bar, unsigned x, unsigned& nloc, unsigned& nx) {
    const unsigned G = gridDim.x * gridDim.y * gridDim.z;
    unsigned sum, cnt, mine, sp = 0u;
    for (;;) {
        sum = 0u; cnt = 0u; mine = 0u;
#pragma unroll
        for (unsigned j = 0; j < 16; ++j) { const unsigned c = xb_ld(&bar[XB_XCNT(j)]); sum += c; cnt += (c > 0u) ? 1u : 0u; mine = (j == x) ? c : mine; }
        if (sum == G) break;
        __builtin_amdgcn_s_sleep(1);
        if ((++sp & 255u) == 0u) { if (xb_ld(&bar[XB_TMO])) break; if (sp > XB_SPIN_CAP) { atomicAdd(&bar[XB_TMO], 1u); break; } }
    }
    nloc = mine > 0u ? mine : 1u; nx = cnt > 0u ? cnt : 1u;
}
__device__ __forceinline__ void xcd_barrier(const XcdBarrier& b) {
    asm volatile("s_waitcnt vmcnt(0)" ::: "memory");
    __syncthreads();
    if (threadIdx.x == 0) {
        unsigned* bar = b.bar;
        __builtin_amdgcn_s_waitcnt(0);
        unsigned nloc = b.st[0], nx = b.st[1];
        if (nloc == 0u) { xcd_barrier_complete(bar, b.x, nloc, nx); b.st[0] = nloc; b.st[1] = nx; }
        __builtin_amdgcn_fence(__ATOMIC_ACQUIRE, "agent");
        const unsigned old = xb_add(&bar[XB_XSUB(b.x)], 1u);
        const unsigned gen = old / nloc;
        if (old + 1u == (gen + 1u) * nloc) {
            __builtin_amdgcn_fence(__ATOMIC_RELEASE, "agent");
            asm volatile("s_waitcnt vmcnt(0)" ::: "memory");
            const unsigned og = xb_add(&bar[XB_TOP], 1u);
            const unsigned tg = og / nx;
            if (og + 1u == (tg + 1u) * nx) xb_add(&bar[XB_TOPGEN], 1u);
            else XB_SPIN(xb_ld(&bar[XB_TOPGEN]) == tg, bar);
            xb_add(&bar[XB_XGEN(b.x)], 1u);
        } else {
            XB_SPIN(xb_ld(&bar[XB_XGEN(b.x)]) == gen, bar);
            asm volatile("s_waitcnt vmcnt(0)" ::: "memory");
        }
    }
    __syncthreads();
}

__device__ __forceinline__ void xcd_barrier_local(const XcdBarrier& b) {
    asm volatile("s_waitcnt vmcnt(0)" ::: "memory");
    __syncthreads();
    if (threadIdx.x == 0) {
        unsigned* bar = b.bar;
        __builtin_amdgcn_s_waitcnt(0);
        const unsigned nloc = b.st[0];
        __builtin_amdgcn_fence(__ATOMIC_ACQUIRE, "agent");
        const unsigned old = xb_add(&bar[XB_XSUB(b.x)], 1u);
        const unsigned gen = old / nloc;
        if (old + 1u == (gen + 1u) * nloc) xb_add(&bar[XB_XGEN(b.x)], 1u);
        else { XB_SPIN(xb_ld(&bar[XB_XGEN(b.x)]) == gen, bar); asm volatile("s_waitcnt vmcnt(0)" ::: "memory"); }
    }
    __syncthreads();
}

__device__ __forceinline__ unsigned cvt_pk_bf16_t(float lo, float hi) { unsigned r; asm volatile("s_nop 0\n\tv_cvt_pk_bf16_f32 %0, %1, %2" : "=v"(r) : "v"(lo), "v"(hi)); return r; }
__device__ __forceinline__ unsigned cvt_pk_bf16(float lo, float hi) { unsigned r; asm volatile("v_cvt_pk_bf16_f32 %0, %1, %2" : "=v"(r) : "v"(lo), "v"(hi)); return r; }
__device__ __forceinline__ float bf_lo(unsigned w) { return __uint_as_float(w << 16); }
__device__ __forceinline__ float bf_hi(unsigned w) { return __uint_as_float(w & 0xffff0000u); }
__device__ __forceinline__ u32x4 pack8(const f32x4 a, const f32x4 b) { u32x4 w; w.x = cvt_pk_bf16(a[0], a[1]); w.y = cvt_pk_bf16(a[2], a[3]); w.z = cvt_pk_bf16(b[0], b[1]); w.w = cvt_pk_bf16(b[2], b[3]); return w; }
__device__ __forceinline__ int tid_fresh() { int t = threadIdx.x; asm volatile("" : "+v"(t)); return t; }
__device__ __forceinline__ void bf8_to_f32(const u32x4 w, f32x4& a, f32x4& b) { a[0] = bf_lo(w.x); a[1] = bf_hi(w.x); a[2] = bf_lo(w.y); a[3] = bf_hi(w.y); b[0] = bf_lo(w.z); b[1] = bf_hi(w.z); b[2] = bf_lo(w.w); b[3] = bf_hi(w.w); }
__device__ __forceinline__ float wave_sum(float v) {
#pragma unroll
    for (int o = 32; o >= 1; o >>= 1) v += __shfl_xor(v, o);
    return v;
}

constexpr float W_SCALE = 64.0f, H_SCALE = 4.0f, O_SCALE = 16.0f, Y_SCALE = 8.0f, W2_SCALE = 256.0f, YS_SCALE = 16.0f;
__device__ __forceinline__ f32x4 fp8x4_to_f32(unsigned w) { f32x4 r; r[0] = __builtin_amdgcn_cvt_f32_fp8(w, 0); r[1] = __builtin_amdgcn_cvt_f32_fp8(w, 1); r[2] = __builtin_amdgcn_cvt_f32_fp8(w, 2); r[3] = __builtin_amdgcn_cvt_f32_fp8(w, 3); return r; }
__device__ __forceinline__ float silu_mul(float g, float up) { return g * __builtin_amdgcn_rcpf(1.0f + __expf(-g)) * up; }
__device__ __forceinline__ unsigned pk4_fp8(float a, float b, float c, float d) { unsigned r = 0; r = __builtin_amdgcn_cvt_pk_fp8_f32(a, b, r, false); r = __builtin_amdgcn_cvt_pk_fp8_f32(c, d, r, true); return r; }
namespace gm {
constexpr int BM = 256, BK = 64, HALF = 128, HTB = HALF * BK * 2, STAGE_BYTES = 8 * HTB, NXCD = 8, WGM = 16;
__device__ __forceinline__ int lds_byte(int r, int c) { const int st = (r >> 4) * 2 + (c >> 5), rr = r & 15, cc = c & 31, ob = rr * 64 + cc * 2; return st * 1024 + (ob ^ (((ob >> 9) & 1) << 5)); }
__device__ __forceinline__ void stage_rc(int b, int& R, int& C) { const int st = b / 1024, sb = b % 1024, swz = sb ^ (((sb >> 9) & 1) << 5); R = (st >> 1) * 16 + swz / 64; C = (st & 1) * 32 + (swz % 64) / 2; }
__device__ __forceinline__ int perm32(int rho) { const int n = rho >> 4, i = rho & 15; return 8 * (i >> 2) + 4 * n + (i & 3); }

__device__ __forceinline__ void glds16(const char* sbase, unsigned voff, unsigned lds_dst) {
    unsigned keep;
    asm volatile("s_mov_b32 %0, m0\n\ts_mov_b32 m0, %3\n\ts_nop 0\n\tglobal_load_lds_dwordx4 %1, %2\n\ts_mov_b32 m0, %0" : "=&s"(keep) : "v"(voff), "s"(sbase), "s"(lds_dst) : "memory");
}
struct Unit { const char* A; const char* B; unsigned hsA, hsB; int pm, pn, x0, x1; };

struct GridOrder {
    int nM, nN, nwg, G, c;
    __device__ __forceinline__ void init(int nM_, int nN_, int G_, int c_) { nM = nM_; nN = nN_; nwg = nM * nN; G = G_; c = c_; }
    __device__ __forceinline__ bool mn(int i, int& pm, int& pn) const {
        const long L = (long)i * G + c; if (L >= nwg) return false;
        int wgid = (int)L; { const int q = nwg / NXCD, r = nwg % NXCD, xcd = wgid % NXCD, off = wgid / NXCD; wgid = (xcd < r ? xcd * (q + 1) : r * (q + 1) + (xcd - r) * q) + off; }
        const int nig = WGM * nN, gid = wgid / nig, fm = gid * WGM, gsz = (nM - fm) < WGM ? (nM - fm) : WGM;
        pm = fm + ((wgid % nig) % gsz); pn = (wgid % nig) / gsz; return true;
    }
};

typedef int i32x4v __attribute__((ext_vector_type(4)));
typedef int i32x8v __attribute__((ext_vector_type(8)));
__device__ __forceinline__ i32x8v cat8(const bf16x8 a, const bf16x8 b) { const i32x4v x = __builtin_bit_cast(i32x4v, a), y = __builtin_bit_cast(i32x4v, b); return (i32x8v){x[0], x[1], x[2], x[3], y[0], y[1], y[2], y[3]}; }
template <class E, class = void> struct epi_perm16 { static constexpr bool value = false; };
template <class E> struct epi_perm16<E, decltype((void)E::PERM16)> { static constexpr bool value = E::PERM16; };
template <class Epi, class Sched, bool GATHER, bool FP8 = false, bool SP2 = true, bool ALIGN_EPI = true>
__device__ __forceinline__ void gemm_phase(LAS unsigned char* lds, const int kbytes, const unsigned ldA, const unsigned ldB, const Sched& S, const Epi& E, const LAS int* idxsrc) {
    const int tid = tid_fresh(), wid = __builtin_amdgcn_readfirstlane(tid >> 6), lane = tid & 63, wr = wid >> 2, wc = wid & 3, fr = lane & 15, fq = lane >> 4;
    int nt = kbytes / (BK * 2); asm volatile("" : "+s"(nt));
    unsigned voffA[2][2], voffBh[2][2];
#pragma unroll
    for (int i = 0; i < 2; ++i) { int R, C; stage_rc(tid * 16 + i * 8192, R, C); const int q = perm32(R & 31); const int Rb = Epi::PERM ? ((R & ~31) + q) : R;
        voffA[0][i] = (unsigned)R * ldA + (unsigned)C * 2u; voffA[1][i] = voffA[0][i];
        if constexpr (epi_perm16<Epi>::value) { const int rb0 = 64 * (R >> 5) + 16 * (q >> 3) + (q & 7); voffBh[0][i] = (unsigned)rb0 * ldB + (unsigned)C * 2u; voffBh[1][i] = (unsigned)(rb0 + 8) * ldB + (unsigned)C * 2u; }
        else { voffBh[0][i] = (unsigned)Rb * ldB + (unsigned)C * 2u; voffBh[1][i] = voffBh[0][i]; } }
    const size_t kstep = (size_t)(BK * 2);
    const unsigned ldsw = (unsigned)wid * 1024u;
    const unsigned lds0 = (unsigned)(__UINTPTR_TYPE__)lds;
    const int aoff = lds_byte(wr * 64 + fr, fq * 8), boff = lds_byte(wc * 32 + fr, fq * 8);
#define PG8_SA(b, h) (((b) * 2 + (h)) * HTB)
#define PG8_SB(b, h) ((4 + (b) * 2 + (h)) * HTB)
#define PG8_STAGE(bufoff, gbase, voff) do { _Pragma("unroll") for (int _i = 0; _i < 2; ++_i) glds16((const char*)(gbase), (voff)[_i], lds0 + (unsigned)(bufoff) + ldsw + _i * 8192u); } while (0)
#define PG8_LDA(dst, b, h) do { _Pragma("unroll") for (int m = 0; m < 4; ++m) _Pragma("unroll") for (int k = 0; k < 2; ++k) dst[m][k] = *(const LAS bf16x8*)(lds + PG8_SA(b, h) + aoff + m * 2048 + k * 1024); } while (0)
#define PG8_LDB(dst, b, h) do { _Pragma("unroll") for (int n = 0; n < 2; ++n) _Pragma("unroll") for (int k = 0; k < 2; ++k) dst[n][k] = *(const LAS bf16x8*)(lds + PG8_SB(b, h) + boff + n * 2048 + k * 1024); } while (0)
#define PG8_MMA(ai, bj, At, Bt) do { __builtin_amdgcn_s_setprio(1); _Pragma("unroll") for (int m = 0; m < 4; ++m) _Pragma("unroll") for (int n = 0; n < 2; ++n) { \
        if constexpr (FP8) { const i32x8v b8_ = cat8(Bt[n][0], Bt[n][1]), a8_ = cat8(At[m][0], At[m][1]); \
            asm volatile("s_nop 1\n\tv_mfma_scale_f32_16x16x128_f8f6f4 %0, %1, %2, %0, %3, %3 op_sel_hi:[0,0,0]" : "+v"(acc[ai][bj][m][n]) : "v"(b8_), "v"(a8_), "v"(fp8_unit_scale)); } \
        else { _Pragma("unroll") for (int k = 0; k < 2; ++k) acc[ai][bj][m][n] = __builtin_amdgcn_mfma_f32_16x16x32_bf16(Bt[n][k], At[m][k], acc[ai][bj][m][n], 0, 0, 0); } } \
        __builtin_amdgcn_s_setprio(0); } while (0)
#define PG8_WAIT_V(n) asm volatile("s_waitcnt vmcnt(" #n ")" ::: "memory")
#define PG8_WAIT_L(n) asm volatile("s_waitcnt lgkmcnt(" #n ")" ::: "memory")
#define PG8_BAR __builtin_amdgcn_s_barrier()
#define PG8_SCHED __builtin_amdgcn_sched_barrier(0)
#define PG8_VA(h) voffA[GATHER ? (h) : 0]
#define PG8_VB(h) voffBh[epi_perm16<Epi>::value ? (h) : 0]
    const int fp8_unit_scale = 0x7f7f7f7f;
    Unit cur, nxt; int ui = 0;
    if (!S.next(0, cur)) return;
    if constexpr (GATHER) {
#pragma unroll
        for (int h = 0; h < 2; ++h)
#pragma unroll
            for (int i = 0; i < 2; ++i) { int R, C; stage_rc(tid * 16 + i * 8192, R, C); voffA[h][i] = (unsigned)idxsrc[h * 128 + R] * ldA + (unsigned)C * 2u; }
    }
    f32x4 acc[2][2][4][2];
#pragma unroll
    for (int a = 0; a < 2; ++a)
#pragma unroll
        for (int b = 0; b < 2; ++b)
#pragma unroll
            for (int m = 0; m < 4; ++m)
#pragma unroll
                for (int n = 0; n < 2; ++n) acc[a][b][m][n] = (f32x4){0.f, 0.f, 0.f, 0.f};
    bf16x8 At[4][2], B0[2][2], B1[2][2];
    const char* cA = cur.A; const char* cB = cur.B; unsigned chA = cur.hsA, chB = cur.hsB;
    if constexpr (SP2) {
        PG8_STAGE(PG8_SB(0, 0), cB, PG8_VB(0)); PG8_STAGE(PG8_SB(0, 1), cB + chB, PG8_VB(1)); PG8_STAGE(PG8_SA(0, 0), cA, PG8_VA(0)); PG8_STAGE(PG8_SA(0, 1), cA + chA, PG8_VA(1));
        if (wr == 1) PG8_BAR;
        PG8_WAIT_V(2); PG8_BAR;
        PG8_STAGE(PG8_SB(1, 0), cB + kstep, PG8_VB(0)); PG8_STAGE(PG8_SA(1, 0), cA + kstep, PG8_VA(0)); PG8_STAGE(PG8_SB(1, 1), cB + chB + kstep, PG8_VB(1));
        PG8_WAIT_V(6); PG8_BAR;
    } else {
    PG8_STAGE(PG8_SB(0, 0), cB, PG8_VB(0)); PG8_STAGE(PG8_SA(0, 0), cA, PG8_VA(0)); PG8_STAGE(PG8_SB(0, 1), cB + chB, PG8_VB(1)); PG8_STAGE(PG8_SA(0, 1), cA + chA, PG8_VA(1));
    if (wr == 1) PG8_BAR;
    PG8_WAIT_V(4); PG8_BAR;
    PG8_STAGE(PG8_SB(1, 0), cB + kstep, PG8_VB(0)); PG8_STAGE(PG8_SA(1, 0), cA + kstep, PG8_VA(0)); PG8_STAGE(PG8_SB(1, 1), cB + chB + kstep, PG8_VB(1));
    PG8_WAIT_V(6); PG8_BAR;
    }
    for (;;) {
        const bool has_next = S.next(ui + 1, nxt);
        const char* nA = has_next ? nxt.A : cA; const char* nB = has_next ? nxt.B : cB; const unsigned nhA = has_next ? nxt.hsA : chA, nhB = has_next ? nxt.hsB : chB;
#pragma unroll 1
        for (int t = 0; t < nt; t += 2) {
            const bool last = (t == nt - 2);
            const char* a1 = cA + (size_t)(t + 1) * kstep;
            const char* a2 = last ? nA : cA + (size_t)(t + 2) * kstep; const char* b2 = last ? nB : cB + (size_t)(t + 2) * kstep;
            const unsigned hA2 = last ? nhA : chA, hB2 = last ? nhB : chB;
            const char* a3 = a2 + kstep; const char* b3 = b2 + kstep;
            const bool sw = GATHER && last && has_next;
            int gi[2][2];
            if constexpr (SP2) {
            PG8_LDB(B0, 0, 0); PG8_LDB(B1, 0, 1); PG8_SCHED; PG8_LDA(At, 0, 0); PG8_STAGE(PG8_SA(1, 1), a1 + chA, PG8_VA(1));
            PG8_WAIT_V(8); PG8_WAIT_L(0); PG8_BAR; PG8_MMA(0, 0, At, B0); PG8_MMA(0, 1, At, B1); PG8_BAR; PG8_SCHED;
            if constexpr (GATHER) { if (sw) {
#pragma unroll
                for (int h = 0; h < 2; ++h)
#pragma unroll
                    for (int i = 0; i < 2; ++i) { int R, C; stage_rc(tid * 16 + i * 8192, R, C); gi[h][i] = idxsrc[(ui + 1) * 256 + h * 128 + R]; } } }
            PG8_LDA(At, 0, 1); PG8_STAGE(PG8_SB(0, 0), b2, PG8_VB(0)); PG8_STAGE(PG8_SB(0, 1), b2 + hB2, PG8_VB(1));
            if constexpr (GATHER) { if (sw) {
#pragma unroll
                for (int h = 0; h < 2; ++h)
#pragma unroll
                    for (int i = 0; i < 2; ++i) { int R, C; stage_rc(tid * 16 + i * 8192, R, C); voffA[h][i] = (unsigned)gi[h][i] * ldA + (unsigned)C * 2u; } } }
            PG8_STAGE(PG8_SA(0, 0), a2, PG8_VA(0));
            PG8_WAIT_V(8); PG8_WAIT_L(0); PG8_BAR; PG8_MMA(1, 0, At, B0); PG8_MMA(1, 1, At, B1); PG8_BAR; PG8_SCHED;
            PG8_LDB(B0, 1, 0); PG8_LDB(B1, 1, 1); PG8_SCHED; PG8_LDA(At, 1, 0); PG8_STAGE(PG8_SA(0, 1), a2 + hA2, PG8_VA(1));
            PG8_WAIT_V(8); PG8_WAIT_L(0); PG8_BAR; PG8_MMA(0, 0, At, B0); PG8_MMA(0, 1, At, B1); PG8_BAR; PG8_SCHED;
            PG8_LDA(At, 1, 1); PG8_STAGE(PG8_SB(1, 0), b3, PG8_VB(0)); PG8_STAGE(PG8_SB(1, 1), b3 + hB2, PG8_VB(1)); PG8_STAGE(PG8_SA(1, 0), a3, PG8_VA(0));
            PG8_WAIT_V(8); PG8_WAIT_L(0); PG8_BAR; PG8_MMA(1, 0, At, B0); PG8_MMA(1, 1, At, B1); PG8_BAR; PG8_SCHED;
            } else {
            PG8_LDB(B0, 0, 0); PG8_SCHED; PG8_LDA(At, 0, 0); PG8_STAGE(PG8_SA(1, 1), a1 + chA, PG8_VA(1));
            PG8_WAIT_L(8); PG8_BAR; PG8_WAIT_L(0); PG8_MMA(0, 0, At, B0); PG8_BAR; PG8_SCHED;
            if constexpr (GATHER) { if (sw) {
#pragma unroll
                for (int h = 0; h < 2; ++h)
#pragma unroll
                    for (int i = 0; i < 2; ++i) { int R, C; stage_rc(tid * 16 + i * 8192, R, C); gi[h][i] = idxsrc[(ui + 1) * 256 + h * 128 + R]; } } }
            PG8_LDB(B1, 0, 1); PG8_STAGE(PG8_SB(0, 0), b2, PG8_VB(0));
            PG8_BAR; PG8_WAIT_L(0); PG8_MMA(0, 1, At, B1); PG8_BAR;
            if constexpr (GATHER) { if (sw) {
#pragma unroll
                for (int h = 0; h < 2; ++h)
#pragma unroll
                    for (int i = 0; i < 2; ++i) { int R, C; stage_rc(tid * 16 + i * 8192, R, C); voffA[h][i] = (unsigned)gi[h][i] * ldA + (unsigned)C * 2u; } } }
            PG8_LDA(At, 0, 1); PG8_STAGE(PG8_SA(0, 0), a2, PG8_VA(0));
            PG8_BAR; PG8_WAIT_L(0); PG8_MMA(1, 0, At, B0); PG8_BAR; PG8_SCHED;
            PG8_STAGE(PG8_SB(0, 1), b2 + hB2, PG8_VB(1));
            PG8_WAIT_V(6); PG8_BAR; PG8_MMA(1, 1, At, B1); PG8_BAR;
            PG8_LDB(B0, 1, 0); PG8_SCHED; PG8_LDA(At, 1, 0); PG8_STAGE(PG8_SA(0, 1), a2 + hA2, PG8_VA(1));
            PG8_WAIT_L(8); PG8_BAR; PG8_WAIT_L(0); PG8_MMA(0, 0, At, B0); PG8_BAR; PG8_SCHED;
            PG8_LDB(B1, 1, 1); PG8_STAGE(PG8_SB(1, 0), b3, PG8_VB(0));
            PG8_BAR; PG8_WAIT_L(0); PG8_MMA(0, 1, At, B1); PG8_BAR;
            PG8_LDA(At, 1, 1); PG8_STAGE(PG8_SA(1, 0), a3, PG8_VA(0));
            PG8_BAR; PG8_WAIT_L(0); PG8_MMA(1, 0, At, B0); PG8_BAR; PG8_SCHED;
            PG8_STAGE(PG8_SB(1, 1), b3 + hB2, PG8_VB(1));
            PG8_WAIT_V(6); PG8_BAR; PG8_MMA(1, 1, At, B1); PG8_BAR;
            }
        }
        if constexpr (ALIGN_EPI) { if (wr == 0) PG8_BAR; }
        if constexpr (FP8) asm volatile("s_nop 15\n\ts_nop 15" ::: "memory");
        E(acc, cur, ui, wr, wc, fr, fq);
        if (!has_next) break;
#pragma unroll
        for (int a = 0; a < 2; ++a)
#pragma unroll
            for (int b = 0; b < 2; ++b)
#pragma unroll
                for (int m = 0; m < 4; ++m)
#pragma unroll
                    for (int n = 0; n < 2; ++n) acc[a][b][m][n] = (f32x4){0.f, 0.f, 0.f, 0.f};
        cur = nxt; cA = nA; cB = nB; chA = nhA; chB = nhB; ++ui;
        if constexpr (ALIGN_EPI) { if (wr == 1) PG8_BAR; }
    }
    PG8_WAIT_V(0);
    if constexpr (!ALIGN_EPI) { if (wr == 0) PG8_BAR; }
    PG8_BAR;
#undef PG8_SA
#undef PG8_SB
#undef PG8_STAGE
#undef PG8_LDA
#undef PG8_LDB
#undef PG8_MMA
#undef PG8_WAIT_V
#undef PG8_WAIT_L
#undef PG8_BAR
#undef PG8_SCHED
#undef PG8_VA
#undef PG8_VB
}
}
using gm::Unit;

struct Params { const float* in[13]; float* out; unsigned char* ws; int ph_lo, ph_hi; };

struct SchedPlain {
    gm::GridOrder o; const char* A; const char* B; unsigned ldA, ldB; bool p16 = false;
    __device__ __forceinline__ bool next(int i, Unit& u) const { int pm, pn; if (!o.mn(i, pm, pn)) return false;
        u.pm = pm; u.pn = pn; u.x0 = 0; u.x1 = 0; u.A = A + (size_t)pm * 256 * ldA; u.hsA = 128u * ldA; u.B = B + (size_t)pn * 256 * ldB; u.hsB = p16 ? 0u : 128u * ldB; return true; }
};
struct SchedG1 {
    gm::GridOrder o; const char* WinT; const char* xb;
    __device__ __forceinline__ bool next(int i, Unit& u) const { int pm, pn;
        if (o.G == 256) { const int lw = i * 32 + (o.c >> 3); if (lw >= 64) return false; const int P = 2 * (o.c & 7) + (lw >> 5); pm = P & 3; pn = (P >> 2) * 32 + (lw & 31); }
        else if (!o.mn(i, pm, pn)) return false;
        const int b = pn >> 5, j = pn & 31; u.pm = pm; u.pn = pn; u.x0 = b; u.x1 = j;
        u.A = WinT + (size_t)pm * 256 * 1024; u.hsA = 128u * 1024u; u.B = xb + ((size_t)(b * SEQ + 2 * j)) * 1024; u.hsB = 1024u; return true; }
};
struct SchedS1 {
    int G, c; const char* F1; const char* Ut;
    __device__ __forceinline__ bool next(int i, Unit& u) const { int L = i * G + c; if (L >= 1024) return false;
        if (G == 256) { const int lw = i * 32 + (c >> 3), P = 2 * (c & 7) + (lw >> 6); L = (P >> 2) * 256 + 64 * (P & 3) + (lw & 63); }
        u.pm = 0; u.pn = L; u.x0 = 0; u.x1 = 0; u.A = F1; u.hsA = 128u * 256u; u.B = Ut + (size_t)L * 256 * 256; u.hsB = 128u * 256u; return true; }
};
struct SchedS2 {
    gm::GridOrder o; const char* F2; const char* A1;
    __device__ __forceinline__ bool next(int i, Unit& u) const { int pm, pn;
        if (o.G == 256) { const int lw = i * 32 + (o.c >> 3); if (lw >= 128) return false; pn = 2 * (o.c & 7) + (lw >> 6); pm = lw & 63; }
        else if (!o.mn(i, pm, pn)) return false;
        const int g = pm, b = pn >> 2, ct = pn & 3; u.pm = g; u.pn = ct; u.x0 = b; u.x1 = g;
        u.A = F2 + (size_t)g * 256 * 256; u.hsA = 128u * 256u; u.B = A1 + ((size_t)((b * 64 + g) * 1024 + ct * 256)) * 256; u.hsB = 0u; return true; }
};
__device__ __forceinline__ int expert_of_tile(const LAS int* ts, int pm) {
    const int ln = (int)__builtin_amdgcn_mbcnt_hi(~0u, __builtin_amdgcn_mbcnt_lo(~0u, 0u));
    const int v = ts[ln & 31];
    return (int)__builtin_popcountll(__ballot((ln >= 1) && (ln < 32) && (v <= pm)));
}
struct SchedMoe {
    gm::GridOrder o; const LAS int* ts; const char* A; const char* W; size_t wstride; unsigned ldB; bool hsB128; unsigned tileA;
    __device__ __forceinline__ bool next(int i, Unit& u) const { int pm, pn; if (!o.mn(i, pm, pn)) return false;
        const int e = expert_of_tile(ts, pm);
        u.pm = pm; u.pn = pn; u.x0 = e; u.x1 = pm - ts[e]; u.A = A + (size_t)pm * tileA; u.hsA = tileA >> 1; u.B = W + (size_t)e * wstride + (size_t)pn * 256 * ldB; u.hsB = hsB128 ? 128u * ldB : 0u; return true; }
};

typedef f32x4 Acc[2][2][4][2];
struct EpiRow {
    static constexpr bool PERM = true;
    bf16_t* O; size_t ld; int split_tiles; size_t split_stride; float scale0, scale1;
    __device__ __forceinline__ void operator()(const Acc& acc, const Unit& u, int, int wr, int wc, int fr, int fq) const {
        int pn = u.pn; bf16_t* base = O; float sc = scale0;
        if (split_tiles) { const int t = pn / split_tiles; base += (size_t)t * split_stride; pn -= t * split_tiles; if (t != 0) sc = scale1; }
        const size_t row0 = (size_t)u.pm * 256 + wr * 64 + fr; const int col0 = pn * 256 + wc * 32 + 8 * fq;
#pragma unroll
        for (int ai = 0; ai < 2; ++ai)
#pragma unroll
            for (int m = 0; m < 4; ++m) { bf16_t* rowp = base + (row0 + ai * 128 + m * 16) * ld + col0;
#pragma unroll
                for (int bj = 0; bj < 2; ++bj) *(u32x4*)(rowp + bj * 128) = pack8(acc[ai][bj][m][0] * sc, acc[ai][bj][m][1] * sc); }
    }
};
struct EpiRow8 {
    static constexpr bool PERM = true, PERM16 = true;
    unsigned char* O; size_t ld; int split_tiles; size_t split_stride; float scale0, scale1;
    __device__ __forceinline__ void operator()(const Acc& acc, const Unit& u, int, int wr, int wc, int fr, int fq) const {
        int pn = u.pn; unsigned char* base = O; float sc = scale0;
        if (split_tiles) { const int t = pn / split_tiles; base += (size_t)t * split_stride; pn -= t * split_tiles; if (t != 0) sc = scale1; }
        const size_t row0 = (size_t)u.pm * 256 + wr * 64 + fr; const int col0 = pn * 256 + wc * 64 + 16 * fq;
#pragma unroll
        for (int ai = 0; ai < 2; ++ai)
#pragma unroll
            for (int m = 0; m < 4; ++m) { u32x4 w;
                { const f32x4 v = acc[ai][0][m][0] * sc; w.x = pk4_fp8(v[0], v[1], v[2], v[3]); } { const f32x4 v = acc[ai][0][m][1] * sc; w.y = pk4_fp8(v[0], v[1], v[2], v[3]); }
                { const f32x4 v = acc[ai][1][m][0] * sc; w.z = pk4_fp8(v[0], v[1], v[2], v[3]); } { const f32x4 v = acc[ai][1][m][1] * sc; w.w = pk4_fp8(v[0], v[1], v[2], v[3]); }
                *(u32x4*)(base + (row0 + ai * 128 + m * 16) * ld + col0) = w; }
    }
};
struct EpiG1 {
    static constexpr bool PERM = true;
    bf16_t* Ut; float sc;
    __device__ __forceinline__ void operator()(const Acc& acc, const Unit& u, int, int wr, int wc, int fr, int fq) const {
#pragma unroll
        for (int ai = 0; ai < 2; ++ai)
#pragma unroll
            for (int m = 0; m < 4; ++m) { const int c = u.pm * 256 + ai * 128 + wr * 64 + m * 16 + fr;
#pragma unroll
                for (int bj = 0; bj < 2; ++bj) { const int s2 = 2 * u.x1 + bj;
                    *(u32x4*)(Ut + (((size_t)(u.x0 * 1024 + c) * 64 + s2) * 128 + wc * 32 + 8 * fq)) = pack8(acc[ai][bj][m][0] * sc, acc[ai][bj][m][1] * sc); } }
    }
};
struct EpiS1 {
    static constexpr bool PERM = true;
    bf16_t* A1;
    __device__ __forceinline__ void operator()(const Acc& acc, const Unit& u, int, int wr, int wc, int fr, int fq) const {
#pragma unroll
        for (int m = 0; m < 4; ++m) { const int m1 = wr * 64 + m * 16 + fr, g = m1 >> 1, ri = m1 & 1;
#pragma unroll
            for (int bj = 0; bj < 2; ++bj) { const int nrow = u.pn * 256 + bj * 128 + wc * 32 + 8 * fq, s2 = nrow & 63, c = (nrow >> 6) & 1023, b = nrow >> 16;
                *(u32x4*)(A1 + ((size_t)((b * 64 + g) * 1024 + c) * 128 + ri * 64 + s2)) = pack8(acc[0][bj][m][0], acc[0][bj][m][1]); } }
    }
};
struct EpiS2 {
    static constexpr bool PERM = true, PERM16 = true;
    unsigned char* Y;
    __device__ __forceinline__ void operator()(const Acc& acc, const Unit& u, int, int wr, int wc, int fr, int fq) const {
        const int g = u.x1, b = u.x0;
#pragma unroll
        for (int ai = 0; ai < 2; ++ai)
#pragma unroll
            for (int m = 0; m < 4; ++m) { const int mm = wr * 64 + m * 16 + fr, k2 = mm >> 1, rip = mm & 1;
                const int k1 = ai ? (g ? 128 - g : 64) : g, k = k1 + 128 * k2;
                { const int c = u.pn * 256 + wc * 64 + 16 * fq; u32x4 w;
                    { const f32x4 v = acc[ai][0][m][0] * Y_SCALE; w.x = pk4_fp8(v[0], v[1], v[2], v[3]); } { const f32x4 v = acc[ai][0][m][1] * Y_SCALE; w.y = pk4_fp8(v[0], v[1], v[2], v[3]); }
                    { const f32x4 v = acc[ai][1][m][0] * Y_SCALE; w.z = pk4_fp8(v[0], v[1], v[2], v[3]); } { const f32x4 v = acc[ai][1][m][1] * Y_SCALE; w.w = pk4_fp8(v[0], v[1], v[2], v[3]); }
                    *(u32x4*)(Y + ((size_t)(b * SEQ + k) * 2048 + rip * 1024 + c)) = w; } }
    }
};
struct EpiGU {
    static constexpr bool PERM = true;
    unsigned char* Hb; const LAS int* idxdst;
    __device__ __forceinline__ void operator()(const Acc& acc, const Unit& u, int ui, int wr, int wc, int fr, int fq) const {
#pragma unroll
        for (int ai = 0; ai < 2; ++ai)
#pragma unroll
            for (int mp = 0; mp < 2; ++mp) { u32x2 w[2];
#pragma unroll
                for (int mm = 0; mm < 2; ++mm) { const int m = 2 * mp + mm; f32x4 h0, h1;
#pragma unroll
                    for (int j = 0; j < 4; ++j) { h0[j] = silu_mul(acc[ai][0][m][0][j] * (1.0f / W_SCALE), acc[ai][1][m][0][j] * (H_SCALE / W_SCALE)); h1[j] = silu_mul(acc[ai][0][m][1][j] * (1.0f / W_SCALE), acc[ai][1][m][1][j] * (H_SCALE / W_SCALE)); }
                    w[mm].x = pk4_fp8(h0[0], h0[1], h0[2], h0[3]); w[mm].y = pk4_fp8(h1[0], h1[1], h1[2], h1[3]); }
                const auto sx = __builtin_amdgcn_permlane16_swap(w[0].x, w[1].x, false, false); const auto sy = __builtin_amdgcn_permlane16_swap(w[0].y, w[1].y, false, false);
                const int m = 2 * mp + (fq & 1), row = ai * 128 + wr * 64 + m * 16 + fr; const int a = idxdst[ui * 256 + row];
                if (a >= 0) { u32x4 v; v.x = sx[0]; v.y = sy[0]; v.z = sx[1]; v.w = sy[1];
                    *(u32x4*)(Hb + ((size_t)(u.pm * 256 + row) * DEX + u.pn * 128 + wc * 32 + 8 * (fq & 2))) = v; } }
    }
};
struct EpiDown {
    static constexpr bool PERM = true, PERM16 = true;
    unsigned char* ys; const LAS int* idxdst;
    __device__ __forceinline__ void operator()(const Acc& acc, const Unit& u, int ui, int wr, int wc, int fr, int fq) const {
#pragma unroll
        for (int ai = 0; ai < 2; ++ai)
#pragma unroll
            for (int m = 0; m < 4; ++m) { const int a = idxdst[ui * 256 + ai * 128 + wr * 64 + m * 16 + fr];
                if (a >= 0) { constexpr float sc = YS_SCALE / (W_SCALE * H_SCALE); u32x4 w;
                    { const f32x4 v = acc[ai][0][m][0] * sc; w.x = pk4_fp8(v[0], v[1], v[2], v[3]); } { const f32x4 v = acc[ai][0][m][1] * sc; w.y = pk4_fp8(v[0], v[1], v[2], v[3]); }
                    { const f32x4 v = acc[ai][1][m][0] * sc; w.z = pk4_fp8(v[0], v[1], v[2], v[3]); } { const f32x4 v = acc[ai][1][m][1] * sc; w.w = pk4_fp8(v[0], v[1], v[2], v[3]); }
                    *(u32x4*)(ys + ((size_t)a * DM + u.pn * 256 + wc * 64 + 16 * fq)) = w; } }
    }
};

constexpr int LDS_P0CTR = 140288;
struct TileDesc { const float* src; unsigned char* dst; int C, r0, c0, dld, kind; };
__device__ __forceinline__ TileDesc tile_desc(const Params& p, int tt) {
    TileDesc d; d.kind = 3; unsigned char* ws = p.ws;
    if (tt < 256) { d.src = p.in[1]; d.C = 1024; d.r0 = (tt >> 5) * 128; d.c0 = (tt & 31) * 32; d.dst = ws + WS_WIN; d.dld = 1024; }
    else if (tt < 1024) { const int t2 = tt - 256; d.src = p.in[3]; d.C = 3072; d.r0 = (t2 / 96) * 128; d.c0 = (t2 % 96) * 32; d.dst = ws + WS_WQKV; d.dld = 1024; }
    else if (tt < 1280) { const int t2 = tt - 1024; d.src = p.in[5]; d.C = 1024; d.r0 = (t2 >> 5) * 128; d.c0 = (t2 & 31) * 32; d.dst = ws + WS_WO; d.dld = 1024; }
    else { const int t3 = tt - 1280, ee = t3 >> 7, tl = t3 & 127, mat = ee & 63; d.kind = ee >> 6;
        if (d.kind < 2) { d.src = (d.kind == 0 ? p.in[8] : p.in[9]) + (size_t)mat * 1024 * 512; d.C = 512; d.r0 = (tl >> 4) * 128; d.c0 = (tl & 15) * 32; d.dst = ws + WS_WGU + (size_t)mat * 1024 * 1024; d.dld = 1024; }
        else { d.src = p.in[10] + (size_t)mat * 512 * 1024; d.C = 1024; d.r0 = (tl >> 5) * 128; d.c0 = (tl & 31) * 32; d.dst = ws + WS_WD + (size_t)mat * 1024 * 512; d.dld = 512; } }
    return d;
}
__device__ __forceinline__ void tile_load(const TileDesc& d, f32x4 (&v)[16], int lane) {
#pragma unroll
    for (int ps = 0; ps < 16; ++ps) v[ps] = __builtin_nontemporal_load((const f32x4*)(d.src + (size_t)(d.r0 + ps * 8 + (lane >> 3)) * d.C + d.c0 + (lane & 7) * 4));
}
__device__ __forceinline__ void tile_store(const TileDesc& d, const f32x4 (&v)[16], LAS float* tile, int lane) {
#pragma unroll
    for (int ps = 0; ps < 16; ++ps) { const int row = ps * 8 + (lane >> 3), col4 = (lane & 7) * 4;
        tile[row * 33 + col4 + 0] = v[ps][0]; tile[row * 33 + col4 + 1] = v[ps][1]; tile[row * 33 + col4 + 2] = v[ps][2]; tile[row * 33 + col4 + 3] = v[ps][3]; }
    __builtin_amdgcn_fence(__ATOMIC_RELEASE, "wavefront"); __builtin_amdgcn_wave_barrier(); __builtin_amdgcn_fence(__ATOMIC_ACQUIRE, "wavefront");
#pragma unroll
    for (int ps = 0; ps < 4; ++ps) { const int n = ps * 8 + (lane >> 3), kc = (lane & 7) * 16; float a[16];
#pragma unroll
        for (int j = 0; j < 16; ++j) a[j] = tile[(kc + j) * 33 + n] * W_SCALE;
        const int nn = d.c0 + n; const int drow = (d.kind == 0 || d.kind == 1) ? (256 * (nn >> 7) + (nn & 127) + 128 * d.kind) : nn;
        u32x4 w; w.x = pk4_fp8(a[0], a[1], a[2], a[3]); w.y = pk4_fp8(a[4], a[5], a[6], a[7]); w.z = pk4_fp8(a[8], a[9], a[10], a[11]); w.w = pk4_fp8(a[12], a[13], a[14], a[15]);
        __builtin_nontemporal_store(w, (u32x4*)(d.dst + (size_t)drow * d.dld + d.r0 + kc)); }
    __builtin_amdgcn_fence(__ATOMIC_RELEASE, "wavefront"); __builtin_amdgcn_wave_barrier(); __builtin_amdgcn_fence(__ATOMIC_ACQUIRE, "wavefront");
}

__device__ __forceinline__ int p0_tile(int i) { if (i < 1280) return i; const int j = i - 1280; return 1280 + (((j >> 12) * 64 + ((j >> 7) & 31)) << 7) + (j & 127); }
__device__ __forceinline__ void transpose_share(const Params& p, LAS unsigned char* lds, int wid, int lane) {
    LAS float* tile = (LAS float*)lds + wid * (128 * 33); const int G = gridDim.x; const bool split = G == 256; const int NT = split ? 1280 + 96 * 128 : 1280 + 192 * 128, per = (NT + G - 1) / G;
    const int lo = (int)blockIdx.x * per, hi = lo + per < NT ? lo + per : NT; LAS unsigned* ctr = (LAS unsigned*)(lds + LDS_P0CTR);
    for (;;) { unsigned g = 0u; if (lane == 0) g = __hip_atomic_fetch_add(ctr, 2u, __ATOMIC_RELAXED, __HIP_MEMORY_SCOPE_WORKGROUP);
        const int t0 = lo + (int)__builtin_amdgcn_readfirstlane(g); if (t0 >= hi) break;
        const bool two = t0 + 1 < hi; const int u0 = split ? p0_tile(t0) : t0, u1 = two ? (split ? p0_tile(t0 + 1) : t0 + 1) : u0; const TileDesc d0 = tile_desc(p, u0), d1 = tile_desc(p, u1);
        f32x4 v0[16], v1[16]; tile_load(d0, v0, lane); tile_load(d1, v1, lane);
        tile_store(d0, v0, tile, lane); if (two) tile_store(d1, v1, tile, lane); }
}
__device__ __forceinline__ void phase_prologue(const Params& p, LAS unsigned char* lds) {
    const int tid = tid_fresh(), lane = tid & 63, wid = __builtin_amdgcn_readfirstlane(tid >> 6); unsigned char* ws = p.ws;
    if (tid == 0) *(LAS unsigned*)(lds + LDS_P0CTR) = 0u;
    __syncthreads();
    if (wid < 6) {
        { const float* x = p.in[0]; unsigned char* xb = (unsigned char*)(ws + WS_S0); bf16_t* xh = (bf16_t*)p.out; const size_t stride = (size_t)gridDim.x * 384 * 8, total = (size_t)T * DM;
          for (size_t i = ((size_t)blockIdx.x * 384 + tid) * 8; i < total; i += 4 * stride) {
              f32x4 a[4], b[4];
#pragma unroll
              for (int u = 0; u < 4; ++u) { const size_t o = i + u * stride < total ? i + u * stride : i; a[u] = __builtin_nontemporal_load((const f32x4*)(x + o)); b[u] = __builtin_nontemporal_load((const f32x4*)(x + o + 4)); }
#pragma unroll
              for (int u = 0; u < 4; ++u) if (i + u * stride < total) { u32x2 w; w.x = pk4_fp8(a[u][0], a[u][1], a[u][2], a[u][3]); w.y = pk4_fp8(b[u][0], b[u][1], b[u][2], b[u][3]); *(u32x2*)(xb + i + u * stride) = w;
                  __builtin_nontemporal_store(pack8(a[u], b[u]), (u32x4*)(xh + i + u * stride)); } } }
        transpose_share(p, lds, wid, lane);
    } else {
        const int gw = blockIdx.x * 2 + (wid - 6), gl = gw * 64 + lane;
        { bf16_t* F1 = (bf16_t*)(ws + WS_F1); bf16_t* F2 = (bf16_t*)(ws + WS_F2);
          { const int idx = gl; const int m1 = idx >> 7, s1 = idx & 127; float v = 0.f;
            if (m1 < 128) { const int g = m1 >> 1, ri = m1 & 1;
                if (g == 0) v = ri ? ((s1 & 1) ? -1.f : 1.f) : 1.f;
                else { const float ph = (float)((s1 * g) & 127) * (1.0f / 128.0f); v = ri ? -__builtin_amdgcn_sinf(ph) : __builtin_amdgcn_cosf(ph); } }
            F1[idx] = (bf16_t)(cvt_pk_bf16(v, 0.f) & 0xffffu); }
          const float sc = 0.011048543456039806f;
          for (int idx = gl; idx < 64 * 256 * 128; idx += 32768) { const int g = idx >> 15, m2 = (idx >> 7) & 255, kk = idx & 127;
              const int hsel = m2 >> 7, k2 = (m2 & 127) >> 1, rip = m2 & 1, slot = kk >> 6, s2 = kk & 63;
              const int k1 = hsel ? (g ? 128 - g : 64) : g, k = k1 + 128 * k2;
              const float ph = (float)((s2 * k) & 8191) * (1.0f / 8192.0f); const float cs = __builtin_amdgcn_cosf(ph), sn = __builtin_amdgcn_sinf(ph);
              float v;
              if (g == 0) { v = (slot == hsel) ? (rip ? -sn : cs) : 0.f; }
              else if (hsel == 0) { v = rip ? (slot ? cs : -sn) : (slot ? sn : cs); }
              else { v = rip ? (slot ? -cs : -sn) : (slot ? -sn : cs); }
              F2[idx] = (bf16_t)(cvt_pk_bf16(v * sc, 0.f) & 0xffffu); } }
        { const float* wout = p.in[2]; unsigned char* W2 = (unsigned char*)(ws + WS_W2); LAS unsigned char* bt = lds + wid * 16896; const int r8 = lane >> 3, c4 = (lane & 7) * 4, fr = lane & 15, fq = lane >> 4;
#pragma unroll 1
          for (int item = gw; item < 512; item += 2 * (int)gridDim.x) { const int gp = item >> 7, n0 = ((item >> 2) & 31) * 32, cq = item & 3;
              const float* wsrc = wout + (size_t)(gp * 256 + 32 * r8) * 1024 + n0 + c4;
#pragma unroll
              for (int half = 0; half < 2; ++half) { f32x4 wv[16];
#pragma unroll
                  for (int it = 0; it < 16; ++it) wv[it] = *(const f32x4*)(wsrc + (size_t)(half * 16 + it) * 1024);
#pragma unroll
                  for (int j = 0; j < 4; ++j)
#pragma unroll
                      for (int q = 0; q < 2; ++q) { u32x4 w; w.x = cvt_pk_bf16(wv[8 * q][j], wv[8 * q + 1][j]); w.y = cvt_pk_bf16(wv[8 * q + 2][j], wv[8 * q + 3][j]); w.z = cvt_pk_bf16(wv[8 * q + 4][j], wv[8 * q + 5][j]); w.w = cvt_pk_bf16(wv[8 * q + 6][j], wv[8 * q + 7][j]);
                          *(LAS u32x4*)(bt + (c4 + j) * 528 + (32 * r8 + half * 16 + 8 * q) * 2) = w; } }
              __builtin_amdgcn_fence(__ATOMIC_RELEASE, "wavefront"); __builtin_amdgcn_wave_barrier(); __builtin_amdgcn_fence(__ATOMIC_ACQUIRE, "wavefront");
              f32x4 acc[4][2][2];
#pragma unroll
              for (int ct = 0; ct < 4; ++ct)
#pragma unroll
                  for (int tr = 0; tr < 2; ++tr) { acc[ct][tr][0] = (f32x4){0.f, 0.f, 0.f, 0.f}; acc[ct][tr][1] = (f32x4){0.f, 0.f, 0.f, 0.f}; }
#pragma unroll 2
              for (int ks = 0; ks < 8; ++ks) { bf16x8 bf[2];
#pragma unroll
                  for (int nt = 0; nt < 2; ++nt) bf[nt] = *(const LAS bf16x8*)(bt + (nt * 16 + fr) * 528 + (ks * 32 + 8 * fq) * 2);
#pragma unroll
                  for (int ct = 0; ct < 4; ++ct) { const int c = cq * 64 + ct * 16 + fr; u32x4 ca, sa;
#pragma unroll
                      for (int e2 = 0; e2 < 4; ++e2) { const int k2a = ks * 32 + 8 * fq + 2 * e2; const float ph0 = (float)((c * k2a) & 255) * (1.0f / 256.0f), ph1 = (float)((c * (k2a + 1)) & 255) * (1.0f / 256.0f);
                          ca[e2] = cvt_pk_bf16_t(__builtin_amdgcn_cosf(ph0), __builtin_amdgcn_cosf(ph1)); sa[e2] = cvt_pk_bf16_t(__builtin_amdgcn_sinf(ph0), __builtin_amdgcn_sinf(ph1)); }
#pragma unroll
                      for (int nt = 0; nt < 2; ++nt) { acc[ct][0][nt] = __builtin_amdgcn_mfma_f32_16x16x32_bf16(__builtin_bit_cast(bf16x8, ca), bf[nt], acc[ct][0][nt], 0, 0, 0);
                          acc[ct][1][nt] = __builtin_amdgcn_mfma_f32_16x16x32_bf16(__builtin_bit_cast(bf16x8, sa), bf[nt], acc[ct][1][nt], 0, 0, 0); } } }
#pragma unroll
              for (int ct = 0; ct < 4; ++ct)
#pragma unroll
                  for (int tr = 0; tr < 2; ++tr)
#pragma unroll
                      for (int nt = 0; nt < 2; ++nt) { const f32x4 v = acc[ct][tr][nt] * (0.0625f * W2_SCALE); const int n = n0 + nt * 16 + fr, c = cq * 64 + ct * 16 + 4 * fq;
                          *(unsigned*)(W2 + (size_t)n * 2048 + tr * 1024 + gp * 256 + c) = pk4_fp8(v[0], v[1], v[2], v[3]); }
              __builtin_amdgcn_fence(__ATOMIC_RELEASE, "wavefront"); __builtin_amdgcn_wave_barrier(); __builtin_amdgcn_fence(__ATOMIC_ACQUIRE, "wavefront"); } }
        transpose_share(p, lds, wid, lane);
    }
    __syncthreads();
}

typedef _Float16 f16x8 __attribute__((ext_vector_type(8)));
typedef _Float16 f16x4 __attribute__((ext_vector_type(4)));
constexpr int LA_HT = 0, LA_RED = 65536, LA_SEL = 65536 + 32768, LA_ASG = LA_SEL + 8192, LA_MISC = LA_ASG + 1024;
__device__ __forceinline__ void phase_lnA(const Params& p, LAS unsigned char* lds, const int L, const bf16_t* res16, const bf16_t* ybuf, bf16_t* hb, unsigned char* h8) {
    const int tid = tid_fresh(), lane = tid & 63, wid = __builtin_amdgcn_readfirstlane(tid >> 6), fr = lane & 15, fq = lane >> 4;
    unsigned char* ws = p.ws;
    LAS unsigned char* ht = lds + LA_HT;
    LAS float* red = (LAS float*)(lds + LA_RED);
    LAS float* selL = (LAS float*)(lds + LA_SEL);
    LAS int* asgE = (LAS int*)(lds + LA_ASG);
    LAS int* misc = (LAS int*)(lds + LA_MISC);
    f16x8 wf[2][4];
    { const float* wrg = p.in[6];
#pragma unroll
      for (int eb = 0; eb < 2; ++eb)
#pragma unroll
          for (int sx = 0; sx < 4; ++sx)
#pragma unroll
              for (int j = 0; j < 8; ++j) wf[eb][sx][j] = (_Float16)wrg[(size_t)(128 * wid + 32 * sx + 8 * fq + j) * 32 + fr + 16 * eb]; }
    const float* lg = p.in[11] + (L * 2 + 0) * 1024; const float* lb = p.in[12] + (L * 2 + 0) * 1024;
    f32x4 gv[4], bv[4];
#pragma unroll
    for (int k = 0; k < 4; ++k) { gv[k] = *(const f32x4*)(lg + 512 * (k >> 1) + 8 * lane + 4 * (k & 1)); bv[k] = *(const f32x4*)(lb + 512 * (k >> 1) + 8 * lane + 4 * (k & 1)); }
    const float br = p.in[7][tid & 31];
    float* gates = (float*)(ws + WS_GATE);
    const int tb = (gridDim.x == 256) ? (int)((blockIdx.x & 7) * 32 + (blockIdx.x >> 3)) : (int)blockIdx.x;
    const int tok0 = tb * 128;
#ifndef LNA_REP
#define LNA_REP 1
#endif
    u32x4 rx16[4][2], ryw[4][2];
#define LA_LOAD(gg) do { _Pragma("unroll") for (int tk = 0; tk < 4; ++tk) { const size_t rowo_ = (size_t)(tok0 + (gg) * 32 + 4 * wid + tk) * DM; _Pragma("unroll") for (int jj = 0; jj < 2; ++jj) { const size_t co_ = rowo_ + 512 * jj + 8 * lane; \
        rx16[tk][jj] = *(const u32x4*)(res16 + co_); ryw[tk][jj] = *(const u32x4*)(ybuf + co_); } } } while (0)
    LA_LOAD(0);
#pragma unroll 1
    for (int g_ = 0; g_ < 4 * LNA_REP; ++g_) { const int g = g_ & 3;
        f32x4 hv[4][4];
#pragma unroll
        for (int tk = 0; tk < 4; ++tk) {
#pragma unroll
            for (int jj = 0; jj < 2; ++jj) { f32x4 xa, xb2, ya, yb; bf8_to_f32(rx16[tk][jj], xa, xb2); bf8_to_f32(ryw[tk][jj], ya, yb);
                hv[tk][2 * jj] = ALPHA * xa + ya; hv[tk][2 * jj + 1] = ALPHA * xb2 + yb; } }
        float sm[4], qv[4];
#pragma unroll
        for (int tk = 0; tk < 4; ++tk) { float s = 0.f;
#pragma unroll
            for (int j = 0; j < 4; ++j) s += (hv[tk][j][0] + hv[tk][j][1]) + (hv[tk][j][2] + hv[tk][j][3]);
            sm[tk] = s; }
#pragma unroll
        for (int o = 32; o >= 1; o >>= 1) {
#pragma unroll
            for (int tk = 0; tk < 4; ++tk) sm[tk] += __shfl_xor(sm[tk], o); }
#pragma unroll
        for (int tk = 0; tk < 4; ++tk) { sm[tk] *= (1.0f / 1024.0f); float q = 0.f;
#pragma unroll
            for (int j = 0; j < 4; ++j) { const f32x4 d = hv[tk][j] - sm[tk]; q += (d[0] * d[0] + d[1] * d[1]) + (d[2] * d[2] + d[3] * d[3]); }
            qv[tk] = q; }
#pragma unroll
        for (int o = 32; o >= 1; o >>= 1) {
#pragma unroll
            for (int tk = 0; tk < 4; ++tk) qv[tk] += __shfl_xor(qv[tk], o); }
#pragma unroll
        for (int tk = 0; tk < 4; ++tk) { const int ts = 4 * wid + tk; const size_t rowo = (size_t)(tok0 + g * 32 + ts) * DM; const float rstd = 1.0f / sqrtf(qv[tk] * (1.0f / 1024.0f) + LN_EPS);
#pragma unroll
            for (int jj = 0; jj < 2; ++jj) { const size_t co = rowo + 512 * jj + 8 * lane;
                const f32x4 h0 = (hv[tk][2 * jj] - sm[tk]) * rstd * gv[2 * jj] + bv[2 * jj], h1 = (hv[tk][2 * jj + 1] - sm[tk]) * rstd * gv[2 * jj + 1] + bv[2 * jj + 1];
                __builtin_nontemporal_store(pack8(h0, h1), (u32x4*)(hb + co));
                u32x2 w8; w8.x = pk4_fp8(h0[0], h0[1], h0[2], h0[3]); w8.y = pk4_fp8(h1[0], h1[1], h1[2], h1[3]); *(u32x2*)(h8 + co) = w8;
                const f16x8 hh = (f16x8){(_Float16)h0[0], (_Float16)h0[1], (_Float16)h0[2], (_Float16)h0[3], (_Float16)h1[0], (_Float16)h1[1], (_Float16)h1[2], (_Float16)h1[3]};
                const int chunk = (64 * jj + lane) ^ (ts & 15);
                *(LAS f16x8*)(ht + ts * 2048 + chunk * 16) = hh; } }
        if (g_ + 1 < 4 * LNA_REP) LA_LOAD((g_ + 1) & 3);
        __syncthreads();
#pragma unroll
        for (int tb = 0; tb < 2; ++tb) { f32x4 d0 = (f32x4){0.f, 0.f, 0.f, 0.f}, d1 = d0;
#pragma unroll
          for (int sx = 0; sx < 4; ++sx) { const int chunk = (16 * wid + 4 * sx + fq) ^ fr; const f16x8 hf = *(const LAS f16x8*)(ht + (16 * tb + fr) * 2048 + chunk * 16);
              d0 = __builtin_amdgcn_mfma_f32_16x16x32_f16(wf[0][sx], hf, d0, 0, 0, 0); d1 = __builtin_amdgcn_mfma_f32_16x16x32_f16(wf[1][sx], hf, d1, 0, 0, 0); }
          *(LAS f32x4*)(red + wid * 1024 + (16 * tb + fr) * 32 + 4 * fq) = d0; *(LAS f32x4*)(red + wid * 1024 + (16 * tb + fr) * 32 + 16 + 4 * fq) = d1; }
        __syncthreads();
#pragma unroll
        for (int u = 0; u < 2; ++u) { const int ix = tid + 512 * u; float lgt = 0.f;
#pragma unroll
          for (int w = 0; w < 8; ++w) lgt += red[w * 1024 + ix];
          const float sc = 1.0f / (1.0f + __expf(-lgt)); selL[ix] = sc + br; selL[1024 + ix] = sc; }
        __syncthreads();
        if (lane < 4) { const int tq = 4 * wid + lane; const LAS f32x4* sel4 = (const LAS f32x4*)(selL + tq * 32); float best = -3.0e38f; int bg = 0, b1 = 0, b2 = 0;
            f32x4 sv[8];
#pragma unroll
            for (int q = 0; q < 8; ++q) sv[q] = sel4[q];
#pragma unroll
            for (int gg = 0; gg < 4; ++gg) { float m1 = -3.0e38f, m2 = -3.0e38f; int i1 = 0, i2 = 0;
#pragma unroll
                for (int j = 0; j < 8; ++j) { const float v = sv[gg * 2 + (j >> 2)][j & 3]; const bool gt1 = v > m1, gt2 = v > m2;
                    m2 = gt1 ? m1 : (gt2 ? v : m2); i2 = gt1 ? i1 : (gt2 ? j : i2); m1 = gt1 ? v : m1; i1 = gt1 ? j : i1; }
                const float gs = m1 + m2; if (gs > best) { best = gs; bg = gg; b1 = i1; b2 = i2; } }
            const int e1 = bg * 8 + b1, e2 = bg * 8 + b2; const float s1 = selL[1024 + tq * 32 + e1], s2 = selL[1024 + tq * 32 + e2], inv = 1.0f / (s1 + s2);
            const int tl = g * 32 + tq; asgE[2 * tl] = e1; asgE[2 * tl + 1] = e2;
            const int t = tok0 + tl; gates[2 * t] = s1 * inv; gates[2 * t + 1] = s2 * inv; }
    }
    __syncthreads();
#undef LA_LOAD
    int my_e = 0, my_rank = 0; LAS int* cntW = misc + 32;
    if (tid < 256) { my_e = asgE[tid]; unsigned long long mym = 0ull; int cw = 0;
#pragma unroll
        for (int e = 0; e < 32; ++e) { const unsigned long long m = __ballot(my_e == e); if (my_e == e) mym = m; if (lane == e) cw = (int)__builtin_popcountll(m); }
        my_rank = (int)__builtin_popcountll(mym & ((1ull << lane) - 1ull));
        if (lane < 32) cntW[wid * 32 + lane] = cw; }
    __syncthreads();
    if (tid < 256) { for (int w = 0; w < 3; ++w) if (w < wid) my_rank += cntW[w * 32 + my_e]; }
    if (tid < 32) { const int c = cntW[tid] + cntW[32 + tid] + cntW[64 + tid] + cntW[96 + tid];
        unsigned* cnt = (unsigned*)(ws + WS_CTL) + CNT_WORD0 + (L * 32 + tid) * 64;
        misc[tid] = (int)__hip_atomic_fetch_add(cnt, (unsigned)c, __ATOMIC_RELAXED, __HIP_MEMORY_SCOPE_AGENT); }
    __syncthreads();
    if (tid < 256) { int* list = (int*)(ws + WS_LIST); list[(size_t)my_e * NASG + misc[my_e] + my_rank] = tb * 256 + tid; }
    __syncthreads();
}

__device__ __forceinline__ void phase_lnB(const Params& p, const int L, const bf16_t* hb, const unsigned char* ys, bf16_t* xb_out, unsigned char* x8_out, float* f_out) {
    const int tid = tid_fresh(), lane = tid & 63, wid = tid >> 6;
    const float* lg = p.in[11] + (L * 2 + 1) * 1024; const float* lb = p.in[12] + (L * 2 + 1) * 1024;
    const float* gates = (const float*)(p.ws + WS_GATE);
    f32x4 gv[4], bv[4];
#pragma unroll
    for (int k = 0; k < 4; ++k) { gv[k] = *(const f32x4*)(lg + 512 * (k >> 1) + 8 * lane + 4 * (k & 1)); bv[k] = *(const f32x4*)(lb + 512 * (k >> 1) + 8 * lane + 4 * (k & 1)); }
    const int tb = (gridDim.x == 256) ? (int)((blockIdx.x & 7) * 32 + (blockIdx.x >> 3)) : (int)blockIdx.x;
    const int tok0 = tb * 128 + wid * 16;
    u32x4 rh[2][2]; u32x2 ry0[2][2], ry1[2][2]; f32x2 rg[2];
#define LB_LOAD(tt) do { _Pragma("unroll") for (int u_ = 0; u_ < 2; ++u_) { const int t_ = (tt) + u_; const size_t ro_ = (size_t)t_ * DM; rg[u_] = *(const f32x2*)(gates + 2 * t_); _Pragma("unroll") for (int jj = 0; jj < 2; ++jj) { \
        const size_t co_ = 512 * jj + 8 * lane; rh[u_][jj] = *(const u32x4*)(hb + ro_ + co_); ry0[u_][jj] = *(const u32x2*)(ys + (size_t)(2 * t_) * DM + co_); ry1[u_][jj] = *(const u32x2*)(ys + (size_t)(2 * t_ + 1) * DM + co_); } } } while (0)
    LB_LOAD(tok0);
#pragma unroll 1
    for (int it = 0; it < 8; ++it) {
        u32x4 ch[2][2]; u32x2 cy0[2][2], cy1[2][2]; f32x2 cg[2];
#pragma unroll
        for (int u = 0; u < 2; ++u) { cg[u] = rg[u];
#pragma unroll
            for (int jj = 0; jj < 2; ++jj) { ch[u][jj] = rh[u][jj]; cy0[u][jj] = ry0[u][jj]; cy1[u][jj] = ry1[u][jj]; } }
        if (it < 7) LB_LOAD(tok0 + 2 * it + 2);
#pragma unroll
        for (int u = 0; u < 2; ++u) { const int t = tok0 + 2 * it + u; const size_t rowo = (size_t)t * DM; const float g0 = cg[u].x * (1.0f / YS_SCALE), g1 = cg[u].y * (1.0f / YS_SCALE);
            f32x4 v[4]; float s = 0.f;
#pragma unroll
            for (int jj = 0; jj < 2; ++jj) { f32x4 ha, hb2; bf8_to_f32(ch[u][jj], ha, hb2);
                const f32x4 ya = fp8x4_to_f32(cy0[u][jj].x), yb = fp8x4_to_f32(cy0[u][jj].y), za = fp8x4_to_f32(cy1[u][jj].x), zb = fp8x4_to_f32(cy1[u][jj].y);
                const f32x4 w0 = ALPHA * ha + g0 * ya + g1 * za, w1 = ALPHA * hb2 + g0 * yb + g1 * zb;
                v[2 * jj] = w0; v[2 * jj + 1] = w1; s += ((w0[0] + w0[1]) + (w0[2] + w0[3])) + ((w1[0] + w1[1]) + (w1[2] + w1[3])); }
            const float mean = wave_sum(s) * (1.0f / 1024.0f); float q = 0.f;
#pragma unroll
            for (int k = 0; k < 4; ++k) { const f32x4 d = v[k] - mean; q += (d[0] * d[0] + d[1] * d[1]) + (d[2] * d[2] + d[3] * d[3]); }
            const float rstd = 1.0f / sqrtf(wave_sum(q) * (1.0f / 1024.0f) + LN_EPS);
#pragma unroll
            for (int jj = 0; jj < 2; ++jj) { const size_t co = 512 * jj + 8 * lane;
                const f32x4 o0 = (v[2 * jj] - mean) * rstd * gv[2 * jj] + bv[2 * jj], o1 = (v[2 * jj + 1] - mean) * rstd * gv[2 * jj + 1] + bv[2 * jj + 1];
                if (f_out) { *(f32x4*)(f_out + rowo + co) = o0; *(f32x4*)(f_out + rowo + co + 4) = o1; }
                if (xb_out) { *(u32x4*)(xb_out + rowo + co) = pack8(o0, o1);
                    u32x2 w8; w8.x = pk4_fp8(o0[0], o0[1], o0[2], o0[3]); w8.y = pk4_fp8(o1[0], o1[1], o1[2], o1[3]); *(u32x2*)(x8_out + rowo + co) = w8; } } }
    }
#undef LB_LOAD
}

__device__ __forceinline__ void glds4(const char* sbase, unsigned voff, unsigned lds_dst) {
    unsigned keep;
    asm volatile("s_mov_b32 %0, m0\n\ts_mov_b32 m0, %3\n\ts_nop 0\n\tglobal_load_lds_dword %1, %2\n\ts_mov_b32 m0, %0" : "=&s"(keep) : "v"(voff), "s"(sbase), "s"(lds_dst) : "memory");
}
constexpr int A8_K = 0, A8_V = 81920, A8_RP = 122880, A8_KBUF = 40960;
__device__ __forceinline__ long mk64(unsigned lo, unsigned hi) { return (long)(((unsigned long long)hi << 32) | (unsigned long long)lo); }
__device__ __forceinline__ void phase_attn(const Params& p, LAS unsigned char* lds, const unsigned char* q8, const unsigned char* k8, const unsigned char* vt8, unsigned char* ob) {
    const int tid = tid_fresh(), lane = tid & 63, wid = __builtin_amdgcn_readfirstlane(tid >> 6), fr = lane & 15, fq = lane >> 4;
    const unsigned lds0 = (unsigned)(__UINTPTR_TYPE__)lds;
    const int item = (gridDim.x == 256) ? (int)((blockIdx.x & 7) * 32 + (blockIdx.x >> 3)) : (int)blockIdx.x, b = item >> 6, r0 = (item & 63) * 2;
    const int rsU = min(max(r0 - 4, 0), 118);
    const int r = r0 + (wid >> 2), jq = wid & 3;
    const int rs = min(max(r - 4, 0), 120), c0 = min(max(16 * jq - 8, 0), 32), lrow0 = rs - rsU;
    unsigned offK; { const int tokl = tid >> 2, pc = tid & 3, lc = pc ^ ((tokl >> 2) & 3); offK = (unsigned)(tokl * DM + lc * 16); }
    unsigned offV[5];
#pragma unroll
    for (int k = 0; k < 5; ++k) { const int q = k * 512 + tid, d = q / 40, pc = q - d * 40, lc = pc ^ (d & 7); offV[k] = (unsigned)(d * T + lc * 16); }
    const unsigned offR = (unsigned)min(wid * 64 + lane, 464) * 4u;
    const char* kbase0 = (const char*)k8 + ((size_t)(b * SEQ + rsU * 64) * DM);
    const char* vbase0 = (const char*)vt8 + ((size_t)(b * SEQ + rsU * 64));
    const char* rbase0 = (const char*)p.in[4];
    const size_t tokq = (size_t)b * SEQ + r * 64 + 16 * jq + fr;
    const char* qrow = (const char*)q8 + tokq * DM + 8 * fq;
#define AT_ISSUE_A(h, buf) do { const char* kb_ = kbase0 + (h) * 64; _Pragma("unroll") for (int k = 0; k < 5; ++k) gm::glds16(kb_ + (size_t)k * 131072, offK, lds0 + A8_K + (buf) * A8_KBUF + k * 8192 + wid * 1024); \
        glds4(rbase0 + (h) * 1860, offR, lds0 + A8_RP + (buf) * 2048 + wid * 256); } while (0)
#define AT_ISSUE_B(h) do { const char* vb_ = vbase0 + (size_t)(h) * 64 * T; _Pragma("unroll") for (int k = 0; k < 5; ++k) gm::glds16(vb_, offV[k], lds0 + A8_V + k * 8192 + wid * 1024); } while (0)
#define AT_LDQ(h, q0, q1) do { asm volatile("global_load_dwordx2 %0, %2, off\n\tglobal_load_dwordx2 %1, %2, off offset:32" : "=&v"(q0), "=&v"(q1) : "v"(qrow + (h) * 64) : "memory"); } while (0)
    const int swzk = ((c0 >> 2) + (fr >> 2)) & 3;
    const int kofs0 = (lrow0 * 64 + c0 + fr) * 64 + ((((fq >> 1) ^ swzk)) << 4) + (fq & 1) * 8, kofs1 = (lrow0 * 64 + c0 + fr) * 64 + (((((fq >> 1) ^ swzk)) ^ 2) << 4) + (fq & 1) * 8;
    int vo[8][2];
#pragma unroll
    for (int i = 0; i < 8; ++i)
#pragma unroll
        for (int hf = 0; hf < 2; ++hf) { const int tokoff = (lrow0 + i) * 64 + c0 + 4 * fq + 16 * hf; vo[i][hf] = fr * 640 + (((tokoff >> 4) ^ (fr & 7)) << 4) + (tokoff & 15); }
    const int qc = 16 * jq + fr, cs = min(max(qc - 8, 0), 48);
    const bool bgw = wid < 6 && gridDim.x == 256; f32x4 bg[8];
#pragma unroll
    for (int j = 0; j < 8; ++j) bg[j] = (f32x4){0.f, 0.f, 0.f, 0.f};
    const char* bg_src = (const char*)p.in[8]; unsigned bg_off = 0u, bg_rowb = 2048u; unsigned char* bg_dst = p.ws; unsigned bg_dld = 1024u; int bg_nc0 = 0, bg_kind = 0;
    if (bgw) { const int gs = (int)blockIdx.x * 6 + wid, m = gs >> 4, si = gs & 15, kind = m >> 5, e = m & 31; const bool dn = kind == 2; const int kblk = dn ? si >> 2 : si >> 1, nch = dn ? si & 3 : si & 1;
        const int C = dn ? 1024 : 512, br_ = lane >> 3, bq_ = lane & 7; bg_rowb = (unsigned)C * 4u; bg_off = (unsigned)(8 * br_ * C + 4 * bq_) * 4u; bg_nc0 = nch * 8; bg_kind = kind;
        bg_src = (const char*)((kind == 0 ? p.in[8] : kind == 1 ? p.in[9] : p.in[10]) + (size_t)(32 + e) * 1024 * 512 + (size_t)(kblk * 128) * C + nch * 256);
        if (dn) { bg_dld = 512u; bg_dst = p.ws + WS_WD + ((size_t)(32 + e) << 19) + (size_t)(4 * bq_) * 512 + kblk * 128 + 8 * br_; }
        else { bg_dld = 1024u; bg_dst = p.ws + WS_WGU + ((size_t)(32 + e) << 20) + (size_t)(4 * bq_) * 1024 + kblk * 128 + 8 * br_; } }
#define AT_BG_LOAD(h) do { const char* sb_ = bg_src + (size_t)((h) & 1) * 64 * bg_rowb + (size_t)((h) >> 1) * 128; _Pragma("unroll") for (int j = 0; j < 8; ++j) \
        asm volatile("global_load_dwordx4 %0, %1, %2 nt" : "=&v"(bg[j]) : "v"(bg_off + (unsigned)j * bg_rowb), "s"(sb_) : "memory"); } while (0)
    long qn0, qn1;
    AT_LDQ(0, qn0, qn1);
    AT_ISSUE_A(0, 0); AT_ISSUE_B(0);
    asm volatile("s_waitcnt vmcnt(5)" ::: "memory");
#pragma unroll 1
    for (int h = 0; h < 16; ++h) {
        const int hn = h < 15 ? h + 1 : 15, kb = h & 1;
        if (bgw) asm volatile("s_waitcnt vmcnt(13)" : "+v"(qn0), "+v"(qn1) :: "memory"); else asm volatile("s_waitcnt vmcnt(9)" : "+v"(qn0), "+v"(qn1) :: "memory");
        const long q0 = qn0, q1 = qn1;
        __builtin_amdgcn_s_barrier();
        AT_LDQ(hn, qn0, qn1);
        AT_ISSUE_A(hn, kb ^ 1);
        f32x4 s[16];
#pragma unroll
        for (int kbi = 0; kbi < 16; ++kbi) { const int i = kbi >> 1, half = kbi & 1;
            const long k0 = *(const LAS long*)(lds + A8_K + kb * A8_KBUF + kofs0 + i * 4096 + half * 1024), k1 = *(const LAS long*)(lds + A8_K + kb * A8_KBUF + kofs1 + i * 4096 + half * 1024);
            f32x4 a = (f32x4){0.f, 0.f, 0.f, 0.f};
            a = __builtin_amdgcn_mfma_f32_16x16x32_fp8_fp8(k0, q0, a, 0, 0, 0); a = __builtin_amdgcn_mfma_f32_16x16x32_fp8_fp8(k1, q1, a, 0, 0, 0); s[kbi] = a; }
        const LAS float* rp = (const LAS float*)(lds + A8_RP + kb * 2048);
        float mx = -3.0e38f; const int thr = cs - c0;
#pragma unroll
        for (int i = 0; i < 8; ++i) { const int ri = rs + i - r + 7;
#pragma unroll
            for (int j = 0; j < 4; ++j) { const int pos = 4 * fq + j; const bool sel0 = pos >= thr; const int ci = min(max(c0 + pos - qc + 15 + (sel0 ? 0 : 16), 0), 30);
                float bvv = rp[ri * 31 + ci]; asm volatile("" : "+v"(bvv)); const float v = (sel0 ? s[2 * i][j] : s[2 * i + 1][j]) * 0.125f + bvv; s[2 * i][j] = v; mx = fmaxf(mx, v); } }
        mx = fmaxf(mx, __shfl_xor(mx, 16)); mx = fmaxf(mx, __shfl_xor(mx, 32));
        const float mxp = mx - 4.1588830833596715f;
        float sum = 0.f;
#pragma unroll
        for (int i = 0; i < 8; ++i)
#pragma unroll
            for (int j = 0; j < 4; ++j) { const int pos = 4 * fq + j; const bool sel0 = pos >= thr; const float e = __expf(s[2 * i][j] - mxp); sum += e; s[2 * i][j] = sel0 ? e : 0.f; s[2 * i + 1][j] = sel0 ? 0.f : e; }
        sum += __shfl_xor(sum, 16); sum += __shfl_xor(sum, 32);
        if (bgw) { AT_BG_LOAD(h); asm volatile("s_waitcnt vmcnt(16)" ::: "memory"); } else asm volatile("s_waitcnt vmcnt(8)" ::: "memory");
        __builtin_amdgcn_s_barrier();
        f32x4 oacc[4];
#pragma unroll
        for (int db = 0; db < 4; ++db) oacc[db] = (f32x4){0.f, 0.f, 0.f, 0.f};
#pragma unroll
        for (int i = 0; i < 8; ++i) { const long pf = mk64(pk4_fp8(s[2 * i][0], s[2 * i][1], s[2 * i][2], s[2 * i][3]), pk4_fp8(s[2 * i + 1][0], s[2 * i + 1][1], s[2 * i + 1][2], s[2 * i + 1][3]));
#pragma unroll
            for (int db = 0; db < 4; ++db) { const unsigned lo = *(const LAS unsigned*)(lds + A8_V + vo[i][0] + db * 10240), hi = *(const LAS unsigned*)(lds + A8_V + vo[i][1] + db * 10240);
                oacc[db] = __builtin_amdgcn_mfma_f32_16x16x32_fp8_fp8(mk64(lo, hi), pf, oacc[db], 0, 0, 0); } }
        asm volatile("s_waitcnt lgkmcnt(0)" ::: "memory");
        __builtin_amdgcn_s_barrier();
        AT_ISSUE_B(hn);
        const float inv = O_SCALE / sum;
#pragma unroll
        for (int db = 0; db < 4; ++db) *(unsigned*)(ob + tokq * DM + h * 64 + 16 * db + 4 * fq) = pk4_fp8(oacc[db][0] * inv, oacc[db][1] * inv, oacc[db][2] * inv, oacc[db][3] * inv);
        if (bgw) { asm volatile("s_waitcnt vmcnt(9)" : "+v"(bg[0]), "+v"(bg[1]), "+v"(bg[2]), "+v"(bg[3]), "+v"(bg[4]), "+v"(bg[5]), "+v"(bg[6]), "+v"(bg[7]) :: "memory");
            const int nc_ = bg_nc0 + (h >> 1); unsigned char* bgd = bg_dst + (size_t)(bg_kind == 2 ? 32 * nc_ : 256 * (nc_ >> 2) + 32 * (nc_ & 3) + 128 * bg_kind) * bg_dld + 64 * (h & 1);
#pragma unroll
            for (int c = 0; c < 4; ++c) { u32x2 w; w.x = pk4_fp8(bg[0][c] * W_SCALE, bg[1][c] * W_SCALE, bg[2][c] * W_SCALE, bg[3][c] * W_SCALE); w.y = pk4_fp8(bg[4][c] * W_SCALE, bg[5][c] * W_SCALE, bg[6][c] * W_SCALE, bg[7][c] * W_SCALE);
                __builtin_nontemporal_store(w, (u32x2*)(bgd + (size_t)c * bg_dld)); } }
    }
    asm volatile("s_waitcnt vmcnt(0)" ::: "memory");
    __builtin_amdgcn_s_barrier();
#undef AT_ISSUE_A
#undef AT_ISSUE_B
#undef AT_LDQ
#undef AT_BG_LOAD
}

template <int SRC_SHIFT>
__device__ __forceinline__ int moe_setup(const Params& p, LAS unsigned char* lds, const int L, LAS int* ts, LAS int* idxsrc, LAS int* idxdst) {
    const int tid = tid_fresh(), lane = tid & 63; unsigned char* ws = p.ws;
    LAS int* cn = ts + 40;
    if (tid < 64) {
        const int c = (int)__hip_atomic_load((unsigned*)(ws + WS_CTL) + CNT_WORD0 + (L * 32 + (lane & 31)) * 64, __ATOMIC_RELAXED, __HIP_MEMORY_SCOPE_AGENT);
        const int nt = (c + 255) >> 8; int incl = nt;
#pragma unroll
        for (int o = 1; o < 32; o <<= 1) { const int up = __shfl_up(incl, o); if ((lane & 31) >= o) incl += up; }
        if (lane < 32) { cn[lane] = c; ts[lane] = incl - nt; if (lane == 31) ts[32] = incl; } }
    __syncthreads();
    const int ntile = ts[NE];
    gm::GridOrder o; o.init(ntile, 4, gridDim.x, blockIdx.x);
    const int* list = (const int*)(ws + WS_LIST);
#pragma unroll
    for (int k = 0; k < 4; ++k) { const int ui = 2 * k + (tid >> 8), r = tid & 255; int pm = 0, pn = 0; const bool ok_u = o.mn(ui, pm, pn);
        const int e = expert_of_tile(ts, ok_u ? pm : 0);
        if (ok_u) { const int j = pm - ts[e], ce = cn[e]; const int pos = j * 256 + r; const bool ok = pos < ce; const int a = list[(size_t)e * NASG + (ok ? pos : j * 256)];
            idxsrc[ui * 256 + r] = a >> SRC_SHIFT; idxdst[ui * 256 + r] = ok ? a : -1; } }
    __syncthreads();
    return ntile;
}

__device__ __forceinline__ bool in_rng(int lo, int hi, int k) { asm volatile("" : "+s"(lo), "+s"(hi)); return lo <= k && k < hi; }
__device__ __forceinline__ Params params_fresh() {
    Params r{};
#if defined(__HIP_DEVICE_COMPILE__)
    auto k = __builtin_amdgcn_kernarg_segment_ptr(); asm volatile("" : "+s"(k));
    const __attribute__((address_space(4))) Params* kp = (const __attribute__((address_space(4))) Params*)k;
#pragma unroll
    for (int i = 0; i < 13; ++i) r.in[i] = kp->in[i];
    r.out = kp->out; r.ws = kp->ws; r.ph_lo = kp->ph_lo; r.ph_hi = kp->ph_hi;
#endif
    return r;
}
__global__ void __launch_bounds__(512, 2) k_fwd(Params p_unused) {
    extern __shared__ __attribute__((aligned(16))) unsigned char lds_raw[];
    LAS unsigned char* lds = (LAS unsigned char*)lds_raw;
    const Params p0 = params_fresh();
    { const int tid = tid_fresh(); if (tid < 4) ((LAS unsigned*)(lds + LDS_BARW))[tid] = 0u; }
    __syncthreads();
    XcdBarrier bar; bar.bar = (unsigned*)(p0.ws + WS_CTL); bar.x = 0; bar.st = nullptr;
    const int lo = p0.ph_lo, hi = p0.ph_hi;
    if (hi - lo > 1) bar = xcd_barrier_post((unsigned*)(p0.ws + WS_CTL), (volatile LAS unsigned*)(lds + LDS_BARW));
#ifndef PHMASK
#define PHMASK 0xffff
#endif
#define IN(k) (((PHMASK >> (k)) & 1) && in_rng(lo, hi, (k)))
#define SEAM(k) do { if (IN((k) + 1)) xcd_barrier(bar); } while (0)
#define SEAML(k) do { if (IN((k) + 1)) { if (*(volatile LAS unsigned*)(lds + LDS_BARW + 8) != 0u) xcd_barrier_local(bar); else xcd_barrier(bar); } } while (0)
#define PH_PTRS const Params p = params_fresh(); unsigned char* ws = p.ws; const int G = gridDim.x, cb = blockIdx.x; \
    bf16_t* S0 = (bf16_t*)(ws + WS_S0); bf16_t* S1 = (bf16_t*)(ws + WS_S1); bf16_t* S2 = (bf16_t*)(ws + WS_S2); bf16_t* S3 = (bf16_t*)(ws + WS_S3); \
    unsigned char* H8 = (unsigned char*)p.out + 64 * MiB; unsigned char* X8 = (unsigned char*)p.out + 96 * MiB; bf16_t* D0 = (bf16_t*)p.out; (void)X8; \
    LAS int* idxsrc = (LAS int*)(lds + LDS_IDX); LAS int* idxdst = idxsrc + 8 * 256; LAS int* tsm = (LAS int*)(lds + LDS_MISC); \
    (void)G; (void)cb; (void)S0; (void)S1; (void)S2; (void)S3; (void)H8; (void)D0; (void)idxsrc; (void)idxdst; (void)tsm;

    if (hi - lo > 1 && threadIdx.x == 0 && (gridDim.x != 256 || bar.x != (blockIdx.x & 7u))) atomicOr((unsigned*)(p0.ws + WS_CTL) + 13000, 1u);
    if (IN(0)) { PH_PTRS phase_prologue(p, lds); SEAM(0);
        if (IN(1)) { if (threadIdx.x == 0) { const unsigned bad = __hip_atomic_load((unsigned*)(ws + WS_CTL) + 13000, __ATOMIC_RELAXED, __HIP_MEMORY_SCOPE_AGENT);
                *(volatile LAS unsigned*)(lds + LDS_BARW + 8) = (bad == 0u && *(volatile LAS unsigned*)(lds + LDS_BARW) == 32u) ? 1u : 0u; }
            __syncthreads(); } }

#pragma unroll 1
    for (int L = 0; L < 2; ++L) {
        const int pb = 7 * L;
        if (L == 0) {
            if (IN(1)) {
                PH_PTRS SchedG1 S; S.o.init(4, 128, G, cb); S.WinT = (const char*)(ws + WS_WIN); S.xb = (const char*)S0; EpiG1 E{S1, 1.0f / W_SCALE};
                gm::gemm_phase<EpiG1, SchedG1, false, true>(lds, 1024, 1024u, 64u * 1024u, S, E, nullptr); SEAML(1); }
            if (IN(2)) {
                PH_PTRS SchedS1 S{G, cb, (const char*)(ws + WS_F1), (const char*)S1}; EpiS1 E{S3};
                gm::gemm_phase<EpiS1, SchedS1, false>(lds, 256, 256u, 256u, S, E, nullptr); SEAM(2); }
            if (IN(3)) {
                PH_PTRS SchedS2 S; S.o.init(64, 16, G, cb); S.F2 = (const char*)(ws + WS_F2); S.A1 = (const char*)S3; EpiS2 E{(unsigned char*)S1};
                gm::gemm_phase<EpiS2, SchedS2, false>(lds, 256, 256u, 256u, S, E, nullptr); SEAM(3); }
        } else {
            if (IN(9)) {
                PH_PTRS
                { SchedPlain S; S.o.init(128, 8, G, cb); S.A = (const char*)X8; S.B = (const char*)(ws + WS_WQKV); S.ldA = 1024u; S.ldB = 1024u; S.p16 = true; EpiRow8 E{(unsigned char*)S0, 1024, 4, (size_t)32 * MiB, 1.0f / W_SCALE, 1.0f / W_SCALE};
                  gm::gemm_phase<EpiRow8, SchedPlain, false, true>(lds, 1024, 1024u, 1024u, S, E, nullptr); }
                { SchedPlain S; S.o.init(4, 128, G, cb); S.A = (const char*)(ws + WS_WQKV) + (size_t)2048 * 1024; S.B = (const char*)X8; S.ldA = 1024u; S.ldB = 1024u; S.p16 = true; EpiRow8 E{H8, (size_t)T, 0, 0, 1.0f / W_SCALE, 1.0f / W_SCALE};
                  gm::gemm_phase<EpiRow8, SchedPlain, false, true>(lds, 1024, 1024u, 1024u, S, E, nullptr); }
                SEAM(9); }
            if (IN(10)) { PH_PTRS phase_attn(p, lds, (const unsigned char*)S0, (const unsigned char*)S0 + 32 * MiB, (const unsigned char*)H8, (unsigned char*)S1); SEAML(10); }
        }
        if (L == 0) { if (IN(4)) {
            PH_PTRS SchedPlain S; S.o.init(128, 4, G, cb); S.A = (const char*)S1; S.B = (const char*)(ws + WS_W2); S.ldA = 2048u; S.ldB = 2048u;
            EpiRow E{S0, 1024, 0, 0, 1.0f / (Y_SCALE * W2_SCALE), 1.f};
            gm::gemm_phase<EpiRow, SchedPlain, false, true>(lds, 2048, 2048u, 2048u, S, E, nullptr); SEAML(4); } }
        else { if (IN(11)) {
            PH_PTRS SchedPlain S; S.o.init(128, 4, G, cb); S.A = (const char*)S1; S.B = (const char*)(ws + WS_WO); S.ldA = 1024u; S.ldB = 1024u;
            EpiRow E{S3, 1024, 0, 0, 1.0f / (W_SCALE * O_SCALE), 1.f};
            gm::gemm_phase<EpiRow, SchedPlain, false, true>(lds, 1024, 1024u, 1024u, S, E, nullptr); SEAML(11); } }
        if (IN(5 + pb)) { PH_PTRS phase_lnA(p, lds, L, D0, L == 0 ? S0 : S3, S3, L == 0 ? H8 : X8); SEAM(5 + pb); }
        if (IN(6 + pb)) {
            PH_PTRS const int ntile = moe_setup<1>(p, lds, L, tsm, idxsrc, idxdst);
            SchedMoe S; S.o.init(ntile, 4, G, cb); S.ts = tsm; S.A = (const char*)(L == 0 ? H8 : X8); S.W = (const char*)(ws + WS_WGU) + (size_t)L * 32 * 1024 * 1024; S.wstride = (size_t)1024 * 1024; S.ldB = 1024u; S.hsB128 = true; S.tileA = 0u;
            EpiGU E{(unsigned char*)S0, idxdst};
            gm::gemm_phase<EpiGU, SchedMoe, true, true>(lds, 1024, 1024u, 1024u, S, E, idxsrc); SEAM(6 + pb); }
        if (IN(7 + pb)) {
            PH_PTRS int ntile; if (IN(6 + pb)) { __syncthreads(); ntile = tsm[NE]; } else ntile = moe_setup<0>(p, lds, L, tsm, idxsrc, idxdst);
            SchedMoe S; S.o.init(ntile, 4, G, cb); S.ts = tsm; S.A = (const char*)S0; S.W = (const char*)(ws + WS_WD) + (size_t)L * 32 * 1024 * 512; S.wstride = (size_t)1024 * 512; S.ldB = 512u; S.hsB128 = false; S.tileA = 256u * 512u;
            EpiDown E{(unsigned char*)S1, idxdst};
            gm::gemm_phase<EpiDown, SchedMoe, false, true>(lds, 512, 512u, 512u, S, E, nullptr); SEAM(7 + pb); }
        if (IN(8 + pb)) { PH_PTRS phase_lnB(p, L, S3, (const unsigned char*)S1, L == 0 ? D0 : nullptr, X8, L == 0 ? nullptr : p.out); if (L == 0) SEAML(8); }
    }
#undef IN
#undef SEAM
#undef PH_PTRS
}

extern "C" void kernel_launch(void* const* d_in, const int* in_sizes, int n_in, void* d_out, int out_size, void* d_ws, size_t ws_size, hipStream_t stream) {
    static int grid = 0;
    if (grid == 0) {
        if (n_in != 13 || in_sizes[0] != T * DM || out_size != T * DM || ws_size < WS_END) { fprintf(stderr, "kernel_launch: unexpected shapes / workspace (%d inputs, in0 %d, out %d, ws %zu < %zu)\n", n_in, n_in > 0 ? in_sizes[0] : -1, out_size, ws_size, (size_t)WS_END); grid = -1; return; }
        int dev = 0, cus = 0, per_cu = 0;
        if (hipGetDevice(&dev) != hipSuccess || hipDeviceGetAttribute(&cus, hipDeviceAttributeMultiprocessorCount, dev) != hipSuccess) { grid = -1; return; }
        if (hipFuncSetAttribute((const void*)k_fwd, hipFuncAttributeMaxDynamicSharedMemorySize, LDS_BYTES) != hipSuccess) { fprintf(stderr, "kernel_launch: hipFuncSetAttribute failed\n"); grid = -1; return; }
        if (hipOccupancyMaxActiveBlocksPerMultiprocessor(&per_cu, (const void*)k_fwd, 512, LDS_BYTES) != hipSuccess || per_cu < 1) fprintf(stderr, "kernel_launch: occupancy query says %d\n", per_cu);
        (void)hipGetLastError();
        grid = cus;
    }
    if (grid < 0) return;
    (void)hipMemsetAsync((char*)d_ws + WS_CTL, 0, CTL_ZERO_BYTES, stream);
    Params a{};
    for (int i = 0; i < 13; ++i) a.in[i] = (const float*)d_in[i];
    a.out = (float*)d_out; a.ws = (unsigned char*)d_ws;
#if MK_N_LAUNCHES == 1
    a.ph_lo = 0; a.ph_hi = NPH;
    hipLaunchKernelGGL(k_fwd, dim3(grid), dim3(512), LDS_BYTES, stream, a);
#else
    for (int k = 0; k < NPH; ++k) { a.ph_lo = k; a.ph_hi = k + 1; const int reps = ((REPMASK >> k) & 1) ? 2 : 1;
        for (int r = 0; r < reps; ++r) hipLaunchKernelGGL(k_fwd, dim3(grid), dim3(512), LDS_BYTES, stream, a); }
#endif
}
```
